# Optimizing an MI355X kernel written in HIP

```python
import math
import jax, jax.numpy as jnp
from jax import lax
import numpy as np

D_MODEL = 1024
BATCH = 2
SEQ = 16384
DEPTH = 2

GRID_W = 64
CTX_LEN = 256
N_MOD = 6
EPS = 1e-6

N_POOL_GROUPS = 4
POOL_GROUP_DIM = D_MODEL // 16
POOL_WIDTH = N_POOL_GROUPS * POOL_GROUP_DIM
POOL_WINDOWS = (2, 4, 8, 16)
N_FNO_GROUPS = 4
FNO_GROUP_DIM = D_MODEL // 16
FNO_WIDTH = N_FNO_GROUPS * FNO_GROUP_DIM
N_HEADS = 8
QK_NOPE = 64
QK_ROPE = 32
V_DIM = 64
Q_LORA = 384
KV_LORA = 256
ATTN_WIDTH = N_HEADS * V_DIM
MIX_WIDTH = POOL_WIDTH + FNO_WIDTH + ATTN_WIDTH
COL_FNO = POOL_WIDTH
COL_Q = COL_FNO + FNO_WIDTH
COL_KV = COL_Q + Q_LORA
COL_KR = COL_KV + KV_LORA
IN_WIDTH = COL_KR + QK_ROPE
ROPE_AXIS_DIM = QK_ROPE // 2
ROPE_FREQS = ROPE_AXIS_DIM // 2
ROPE_THETA = 10000.0
SOFTMAX_SCALE = (QK_NOPE + QK_ROPE) ** -0.5
Q_BLOCK = 128
N_EXPERTS = 64
TOP_K = 8
N_EXPERT_GROUPS = 8
TOPK_GROUPS = 4
EXPERTS_PER_GROUP = N_EXPERTS // N_EXPERT_GROUPS
D_EXPERT = 256
D_SHARED = 256
ROUTED_SCALE = 2.5
EXPERT_BLOCK = 128
BLOCKS_PER_STEP = 8

kernel_name = "hybrid_pool_fourier_mla_moe_dit"


def rmsnorm(x, g):
    xf = x.astype(jnp.float32)
    y = xf * lax.rsqrt(jnp.mean(xf * xf, axis=-1, keepdims=True) + EPS)
    return y.astype(x.dtype) * g


def modulate(h, shift, scale):
    return h * (1.0 + scale) + shift


def axial_rope_tables(n_tokens):
    rows = n_tokens // GRID_W
    row = jnp.repeat(jnp.arange(rows, dtype=jnp.float32), GRID_W)
    col = jnp.tile(jnp.arange(GRID_W, dtype=jnp.float32), rows)
    inv_freq = ROPE_THETA ** (-jnp.arange(ROPE_FREQS, dtype=jnp.float32) * 2.0 / ROPE_AXIS_DIM)
    ang = jnp.stack([row[:, None] * inv_freq, col[:, None] * inv_freq], axis=1)
    return jnp.cos(ang), jnp.sin(ang)


def rope2d(x, cos, sin):
    xr = x.reshape(x.shape[:-1] + (2, 2, ROPE_FREQS))
    x1, x2 = xr[..., 0, :], xr[..., 1, :]
    cos, sin = cos.astype(x.dtype), sin.astype(x.dtype)
    out = jnp.stack([x1 * cos - x2 * sin, x2 * cos + x1 * sin], axis=-2)
    return out.reshape(x.shape)


def pool_mixer(u, w_pool, pool_scale):
    B, L, _ = u.shape
    ug = u.astype(jnp.float32).reshape(B, L, N_POOL_GROUPS, POOL_GROUP_DIM)
    cs = jnp.concatenate([jnp.zeros((B, 1, N_POOL_GROUPS, POOL_GROUP_DIM), jnp.float32),
                          jnp.cumsum(ug, axis=1)], axis=1)
    half = jnp.array(POOL_WINDOWS, jnp.int32) // 2
    t = jnp.arange(L, dtype=jnp.int32)[:, None]
    lo = jnp.clip(t - half, 0, L)
    hi = jnp.clip(t + half, 0, L)
    grp = jnp.arange(N_POOL_GROUPS)[None, :]
    win_sum = cs[:, hi, grp] - cs[:, lo, grp]
    count = (hi - lo).astype(jnp.float32)[None, :, :, None]
    d = (win_sum / count - ug).astype(u.dtype)
    y = jnp.einsum('blgc,gcd->blgd', d, w_pool).reshape(B, L, POOL_WIDTH)
    return y * pool_scale


def fourier_mixer(u, w_fno):
    B, L, _ = u.shape
    ug = u.astype(jnp.float32).reshape(B, L, N_FNO_GROUPS, FNO_GROUP_DIM)
    f = jnp.fft.fft2(ug, axes=(1, 3), norm='ortho').real.astype(u.dtype)
    return jnp.einsum('blgc,gcd->blgd', f, w_fno).reshape(B, L, FNO_WIDTH)


def mla_queries(u, g_q, w_uq):
    B, L, _ = u.shape
    cq = rmsnorm(u[..., COL_Q:COL_KV], g_q)
    return (cq @ w_uq).reshape(B, L, N_HEADS, QK_NOPE + QK_ROPE)


def mla_keys_values(u_kvr, g_kv, w_ukv, rope=None):
    B, L, _ = u_kvr.shape
    ckv = rmsnorm(u_kvr[..., :KV_LORA], g_kv)
    kv = (ckv @ w_ukv).reshape(B, L, N_HEADS, QK_NOPE + V_DIM)
    k_rope = u_kvr[..., KV_LORA:]
    if rope is not None:
        k_rope = rope2d(k_rope, rope[0], rope[1])
    k = jnp.concatenate([kv[..., :QK_NOPE],
                         jnp.broadcast_to(k_rope[:, :, None, :], (B, L, N_HEADS, QK_ROPE))], axis=-1)
    return k, kv[..., QK_NOPE:]


def attend(q, k, v):
    s = jnp.einsum('bqhd,bkhd->bhqk', q, k).astype(jnp.float32) * SOFTMAX_SCALE
    p = jax.nn.softmax(s, axis=-1).astype(v.dtype)
    return jnp.einsum('bhqk,bkhd->bqhd', p, v)


def latent_attention(q, k, v, k_ctx, v_ctx):
    B, L, H, Dqk = q.shape
    keys = jnp.concatenate([k_ctx, k], axis=1)
    vals = jnp.concatenate([v_ctx, v], axis=1)
    nb = L // Q_BLOCK
    qb = q.reshape(B, nb, Q_BLOCK, H, Dqk).transpose(1, 0, 2, 3, 4)
    o = lax.map(lambda qblk: attend(qblk, keys, vals), qb)
    return o.transpose(1, 0, 2, 3, 4).reshape(B, L, H * V_DIM)


def head_groups_output(u, attn_out, w_pool, pool_scale, w_fno, w_out):
    y = jnp.concatenate([pool_mixer(u[..., :COL_FNO], w_pool, pool_scale),
                         fourier_mixer(u[..., COL_FNO:COL_Q], w_fno),
                         attn_out], axis=-1)
    return y @ w_out


def route(h, w_router, router_bias):
    T = h.shape[0]
    s = jax.nn.sigmoid((h @ w_router).astype(jnp.float32))
    sel = s + router_bias.astype(jnp.float32)
    grp_score = lax.top_k(sel.reshape(T, N_EXPERT_GROUPS, EXPERTS_PER_GROUP), 2)[0].sum(-1)
    _, top_g = lax.top_k(grp_score, TOPK_GROUPS)
    gmask = jax.nn.one_hot(top_g, N_EXPERT_GROUPS, dtype=jnp.float32).sum(1) > 0
    emask = jnp.repeat(gmask, EXPERTS_PER_GROUP, axis=1)
    _, idx = lax.top_k(jnp.where(emask, sel, -jnp.inf), TOP_K)
    w = jnp.take_along_axis(s, idx, axis=1)
    w = w / jnp.sum(w, axis=-1, keepdims=True) * ROUTED_SCALE
    return idx, w


def moe_ffn(h, w_router, router_bias, w_gate, w_up, w_down, w_sh_gate, w_sh_up, w_sh_down):
    T = h.shape[0]
    idx, wts = route(h, w_router, router_bias)
    n_assign = T * TOP_K
    e_flat = idx.reshape(-1)
    tok_flat = jnp.arange(n_assign, dtype=jnp.int32) // TOP_K
    order = jnp.argsort(e_flat)
    e_sorted = e_flat[order]
    tok_sorted = tok_flat[order]
    w_sorted = wts.reshape(-1)[order]
    counts = jnp.zeros((N_EXPERTS,), jnp.int32).at[e_flat].add(1)
    padded = (counts + EXPERT_BLOCK - 1) // EXPERT_BLOCK * EXPERT_BLOCK
    pad_end = jnp.cumsum(padded)
    pad_start = pad_end - padded
    start = jnp.cumsum(counts) - counts
    dest = pad_start[e_sorted] + jnp.arange(n_assign, dtype=jnp.int32) - start[e_sorted]
    step_rows = EXPERT_BLOCK * BLOCKS_PER_STEP
    n_steps = -(-(n_assign + N_EXPERTS * (EXPERT_BLOCK - 1)) // step_rows)
    n_rows = n_steps * step_rows
    src = jnp.zeros((n_rows,), jnp.int32).at[dest].set(tok_sorted)
    row_w = jnp.zeros((n_rows,), h.dtype).at[dest].set(w_sorted.astype(h.dtype))
    block_start = jnp.arange(n_rows // EXPERT_BLOCK, dtype=jnp.int32) * EXPERT_BLOCK
    block_expert = jnp.minimum(jnp.searchsorted(pad_end, block_start, side='right'), N_EXPERTS - 1)

    def run_step(args):
        src_s, exp_s, w_s = args
        xb = h[src_s]
        a = jnp.einsum('nmd,ndf->nmf', xb, w_gate[exp_s])
        b = jnp.einsum('nmd,ndf->nmf', xb, w_up[exp_s])
        y = jnp.einsum('nmf,nfd->nmd', jax.nn.silu(a) * b, w_down[exp_s])
        return y * w_s[..., None]

    y = lax.map(run_step, (src.reshape(n_steps, BLOCKS_PER_STEP, EXPERT_BLOCK),
                           block_expert.reshape(n_steps, BLOCKS_PER_STEP),
                           row_w.reshape(n_steps, BLOCKS_PER_STEP, EXPERT_BLOCK)))
    routed = jax.ops.segment_sum(y.reshape(n_rows, -1), src, num_segments=T)
    shared = (jax.nn.silu(h @ w_sh_gate) * (h @ w_sh_up)) @ w_sh_down
    return routed + shared


def setup_inputs(seed: int = 0) -> dict:
    key = jax.random.key(seed)
    ks = jax.random.split(key, 26)

    def nrm(k, shape, scale):
        return scale * jax.random.normal(k, shape, jnp.float32)

    def gain(k, shape):
        return 1.0 + 0.1 * jax.random.normal(k, shape, jnp.float32)

    return {
        "x": nrm(ks[0], (BATCH, SEQ, D_MODEL), 1.0),
        "c": nrm(ks[1], (BATCH, D_MODEL), 1.0),
        "ctx": nrm(ks[2], (BATCH, CTX_LEN, D_MODEL), 1.0),
        "c_ctx": nrm(ks[3], (D_MODEL,), 1.0),
        "w_mod": nrm(ks[4], (DEPTH, D_MODEL, N_MOD * D_MODEL), 0.5 * D_MODEL ** -0.5),
        "b_mod": nrm(ks[5], (DEPTH, N_MOD * D_MODEL), 0.02),
        "g_mix": gain(ks[6], (DEPTH, D_MODEL)),
        "g_ffn": gain(ks[7], (DEPTH, D_MODEL)),
        "w_in": nrm(ks[8], (DEPTH, D_MODEL, IN_WIDTH), D_MODEL ** -0.5),
        "w_pool": nrm(ks[9], (DEPTH, N_POOL_GROUPS, POOL_GROUP_DIM, POOL_GROUP_DIM), POOL_GROUP_DIM ** -0.5),
        "pool_scale": gain(ks[10], (DEPTH, POOL_WIDTH)),
        "w_fno": nrm(ks[11], (DEPTH, N_FNO_GROUPS, FNO_GROUP_DIM, FNO_GROUP_DIM), FNO_GROUP_DIM ** -0.5),
        "g_q": gain(ks[12], (DEPTH, Q_LORA)),
        "w_uq": nrm(ks[13], (DEPTH, Q_LORA, N_HEADS * (QK_NOPE + QK_ROPE)), Q_LORA ** -0.5),
        "g_kv": gain(ks[14], (DEPTH, KV_LORA)),
        "w_ukv": nrm(ks[15], (DEPTH, KV_LORA, N_HEADS * (QK_NOPE + V_DIM)), KV_LORA ** -0.5),
        "w_out": nrm(ks[16], (DEPTH, MIX_WIDTH, D_MODEL), MIX_WIDTH ** -0.5),
        "w_router": nrm(ks[17], (DEPTH, D_MODEL, N_EXPERTS), D_MODEL ** -0.5),
        "router_bias": nrm(ks[18], (DEPTH, N_EXPERTS), 0.01),
        "w_gate": nrm(ks[19], (DEPTH, N_EXPERTS, D_MODEL, D_EXPERT), D_MODEL ** -0.5),
        "w_up": nrm(ks[20], (DEPTH, N_EXPERTS, D_MODEL, D_EXPERT), D_MODEL ** -0.5),
        "w_down": nrm(ks[21], (DEPTH, N_EXPERTS, D_EXPERT, D_MODEL), D_EXPERT ** -0.5),
        "w_sh_gate": nrm(ks[22], (DEPTH, D_MODEL, D_SHARED), D_MODEL ** -0.5),
        "w_sh_up": nrm(ks[23], (DEPTH, D_MODEL, D_SHARED), D_MODEL ** -0.5),
        "w_sh_down": nrm(ks[24], (DEPTH, D_SHARED, D_MODEL), D_SHARED ** -0.5),
        "g_final": gain(ks[25], (D_MODEL,)),
    }


def reference(x, c, ctx, c_ctx, w_mod, b_mod, g_mix, g_ffn, w_in, w_pool, pool_scale, w_fno,
              g_q, w_uq, g_kv, w_ukv, w_out, w_router, router_bias, w_gate, w_up, w_down,
              w_sh_gate, w_sh_up, w_sh_down, g_final):
    B, L, D = x.shape
    Lc = ctx.shape[1]
    cos, sin = axial_rope_tables(L)
    silu_c = jax.nn.silu(c)
    silu_cc = jax.nn.silu(c_ctx)
    xc = ctx
    for l in range(DEPTH):
        last = l == DEPTH - 1
        mod = silu_c @ w_mod[l] + b_mod[l]
        modc = silu_cc @ w_mod[l] + b_mod[l]
        sh1, sc1, gt1, sh2, sc2, gt2 = [m[:, None, :] for m in jnp.split(mod, N_MOD, axis=-1)]
        shc1, scc1, gtc1, shc2, scc2, gtc2 = jnp.split(modc, N_MOD, axis=-1)
        w_in_l = w_in[l]

        h = modulate(rmsnorm(x, g_mix[l]), sh1, sc1)
        hc = modulate(rmsnorm(xc, g_mix[l]), shc1, scc1)
        u = h @ w_in_l
        if last:
            uc_kvr = hc @ w_in_l[:, COL_KV:]
        else:
            uc = hc @ w_in_l
            uc_kvr = uc[..., COL_KV:]
        k_ctx, v_ctx = mla_keys_values(uc_kvr, g_kv[l], w_ukv[l])
        q = mla_queries(u, g_q[l], w_uq[l])
        q = jnp.concatenate([q[..., :QK_NOPE], rope2d(q[..., QK_NOPE:], cos[:, None], sin[:, None])], axis=-1)
        k, v = mla_keys_values(u[..., COL_KV:], g_kv[l], w_ukv[l], rope=(cos, sin))
        attn = latent_attention(q, k, v, k_ctx, v_ctx)
        y = head_groups_output(u, attn, w_pool[l], pool_scale[l], w_fno[l], w_out[l])
        x = x + gt1 * y
        if not last:
            qc = mla_queries(uc, g_q[l], w_uq[l])
            attn_c = attend(qc, k_ctx, v_ctx).reshape(B, Lc, ATTN_WIDTH)
            yc = head_groups_output(uc, attn_c, w_pool[l], pool_scale[l], w_fno[l], w_out[l])
            xc = xc + gtc1 * yc

        h2 = modulate(rmsnorm(x, g_ffn[l]), sh2, sc2)
        if last:
            out = moe_ffn(h2.reshape(B * L, D), w_router[l], router_bias[l], w_gate[l], w_up[l],
                          w_down[l], w_sh_gate[l], w_sh_up[l], w_sh_down[l])
            x = x + gt2 * out.reshape(B, L, D)
        else:
            hc2 = modulate(rmsnorm(xc, g_ffn[l]), shc2, scc2)
            tokens = jnp.concatenate([h2.reshape(B * L, D), hc2.reshape(B * Lc, D)], axis=0)
            out = moe_ffn(tokens, w_router[l], router_bias[l], w_gate[l], w_up[l],
                          w_down[l], w_sh_gate[l], w_sh_up[l], w_sh_down[l])
            x = x + gt2 * out[:B * L].reshape(B, L, D)
            xc = xc + gtc2 * out[B * L:].reshape(B, Lc, D)
    return rmsnorm(x, g_final)
```

```cpp
#include <hip/hip_runtime.h>
#include <cstdio>
#include <cstdint>
#include <cmath>

#ifndef MK_N_LAUNCHES
#define MK_N_LAUNCHES 1
#endif

#ifndef REP_NORM
#define REP_NORM 1
#endif
#ifndef REP_DENSE
#define REP_DENSE 1
#endif
#ifndef REP_ROWS
#define REP_ROWS 1
#endif
#ifndef REP_MOE
#define REP_MOE 1
#endif
#ifndef REP_FFT
#define REP_FFT 1
#endif
#ifndef REP_PRO
#define REP_PRO 1
#endif
#ifndef REP_COMB
#define REP_COMB 1
#endif
#ifndef REP_OUT
#define REP_OUT 1
#endif
#ifndef REP_BAR
#define REP_BAR 1
#endif
#ifndef REP_ATT
#define REP_ATT 1
#endif
#ifndef ATT_VAR
#define ATT_VAR 0
#endif
#ifndef REP_P7
#define REP_P7 1
#endif
#ifndef REP_DOWN
#define REP_DOWN 1
#endif
#ifndef REP_VT
#define REP_VT 1
#endif
#ifndef GRP_MIX
#define GRP_MIX 1
#endif
#ifndef GRP_MOE
#define GRP_MOE 1
#endif
#ifndef REP_ROUTE
#define REP_ROUTE 1
#endif
#define LAS __attribute__((address_space(3)))
#define GAS __attribute__((address_space(1)))
typedef unsigned short bf16_t;
typedef short bf16x8 __attribute__((ext_vector_type(8)));
typedef short s16x4 __attribute__((ext_vector_type(4)));
typedef float f32x4 __attribute__((ext_vector_type(4)));
typedef float f32x2 __attribute__((ext_vector_type(2)));
typedef float f32x16 __attribute__((ext_vector_type(16)));
typedef unsigned u32x4 __attribute__((ext_vector_type(4)));
typedef unsigned u32x2 __attribute__((ext_vector_type(2)));

constexpr int DM = 1024, NB = 2, SEQ = 16384, CTXL = 256, TL = NB * SEQ, TC = NB * CTXL, RT = TL + TC;
constexpr int NINP = 1280;
constexpr int NH = 8, DQK = 96, DV = 64, LK = SEQ + CTXL;
constexpr int NE = 64, DE = 256, NEX = NE + 1;
constexpr int COL_FNO = 256, COL_Q = 512, COL_KV = 896, COL_KR = 1152;
constexpr float EPS = 1e-6f;
constexpr int NSLOT_MAX = 282624 + RT;
constexpr int MAXU = 12;

constexpr size_t MiB = 1u << 20;
constexpr size_t WS_CTL = 0, CTL_ZERO_BYTES = 65536;
constexpr size_t WS_MODS = 65536;
constexpr size_t WS_DW = 1 * MiB, DW_LAYER = 7 * MiB;
constexpr size_t DW_WIN = 0, DW_WUQ = 2560 * 1024, DW_WUKV = 3200 * 1024, DW_WCOMB = 3712 * 1024, DW_WR = 6272 * 1024;
constexpr size_t WS_F1 = 15 * MiB, WS_F2 = WS_F1 + 65536, WS_FC = WS_F2 + 131072, WS_WCS = WS_FC + 262144;
constexpr size_t WS_XS = 17 * MiB;
constexpr size_t WS_X0 = 147 * MiB;
constexpr size_t WS_HQ = WS_X0;
constexpr size_t WS_U = WS_X0 + 65 * MiB;
constexpr size_t WS_KB = WS_U + 83200 * 1024;
constexpr size_t WS_VB = WS_KB + 49920 * 1024;
constexpr size_t WS_YA = WS_VB + 33280 * 1024;
constexpr size_t WS_YP = WS_YA + 83200 * 1024;
constexpr size_t WS_VT8 = WS_YP + 32 * MiB;
constexpr size_t WS_MIX_END = WS_VT8 + (size_t)16 * 260 * 4096;
constexpr size_t WS_EW = WS_X0;
constexpr size_t EW_GU_BYTES = (size_t)NEX * 512 * 1024 * 2, EW_D_BYTES = (size_t)NEX * 1024 * 256 * 2;
constexpr size_t WS_ACT = WS_EW + EW_GU_BYTES + EW_D_BYTES;
constexpr size_t WS_TOKL = WS_ACT + (size_t)NSLOT_MAX * 512;
constexpr size_t WS_TPOS = WS_TOKL + (size_t)NE * RT * 4;
constexpr size_t WS_TW = WS_TPOS + (size_t)RT * 32;
constexpr size_t WS_LOG = WS_TW + (size_t)RT * 32;
constexpr size_t WS_YB = WS_LOG + (size_t)RT * 256;
constexpr size_t WS_END = WS_YB + (size_t)NSLOT_MAX * 512;
static_assert(WS_MIX_END <= 590 * MiB && WS_END <= 590 * MiB, "workspace map must fit the guaranteed 590 MiB");
static_assert(WS_WCS + 262144 <= WS_XS && WS_DW + 2 * DW_LAYER <= WS_F1 && DW_WR + 512 * 1024 <= DW_LAYER, "dense weight map");
static_assert((size_t)RT * 2048 <= (size_t)NSLOT_MAX * 512, "H2 fits in the head of YB");
constexpr int CW_TMO = 0, CW_BAR = 1024, CW_CNT = 8192;

constexpr int LDS_WORK = 131072, IDX_OFF = LDS_WORK, ULIST_OFF = IDX_OFF + MAXU * 1024, TAB_OFF = ULIST_OFF + 512, MISC_OFF = TAB_OFF + 1024, VOC_OFF = MISC_OFF + 512, LDS_BYTES = VOC_OFF + 16384;
static_assert(LDS_BYTES <= 163840, "LDS");

__device__ __forceinline__ unsigned cvt_pk_bf16(float lo, float hi) { unsigned r; asm volatile("v_cvt_pk_bf16_f32 %0, %1, %2" : "=v"(r) : "v"(lo), "v"(hi)); return r; }
__device__ __forceinline__ float bf_lo(unsigned w) { return __uint_as_float(w << 16); }
__device__ __forceinline__ float bf_hi(unsigned w) { return __uint_as_float(w & 0xffff0000u); }
__device__ __forceinline__ float shx(float v, int o, int lane) { return __int_as_float(__builtin_amdgcn_ds_bpermute((lane ^ o) << 2, __float_as_int(v))); }
__device__ __forceinline__ int shxi(int v, int o, int lane) { return __builtin_amdgcn_ds_bpermute((lane ^ o) << 2, v); }
__device__ __forceinline__ float wave_sum(float v, int lane) {
#pragma unroll
    for (int o = 1; o < 32; o <<= 1) v += shx(v, o, lane);
    { auto rr = __builtin_amdgcn_permlane32_swap(__float_as_uint(v), __float_as_uint(v), false, false); v = __uint_as_float(rr[0]) + __uint_as_float(rr[1]); }
    return v;
}
__device__ __forceinline__ float silu_f(float v) { return v * __builtin_amdgcn_rcpf(1.0f + __builtin_amdgcn_exp2f(v * -1.4426950408889634f)); }
typedef int i32x8 __attribute__((ext_vector_type(8)));
__device__ __forceinline__ unsigned pk4_fp8(float a, float b, float c, float d) { unsigned w = __float_as_uint(a); w = __builtin_amdgcn_cvt_pk_fp8_f32(a, b, w, false); w = __builtin_amdgcn_cvt_pk_fp8_f32(c, d, w, true); return w; }
#define LDS_WAIT() asm volatile("s_waitcnt lgkmcnt(0)" ::: "memory")
#define VM_WAIT() asm volatile("s_waitcnt vmcnt(0)" ::: "memory")

#define XB_TMO      128
#define XB_XCNT(j)  (256  + 64 * (j))
#define XB_XSUB(j)  (1280 + 64 * (j))
#define XB_XGEN(j)  (2304 + 64 * (j))
#define XB_TOP      3328
#define XB_TOPGEN   3392
#define XCD_BAR_WORDS 3456
#define XB_SPIN_CAP (1u << 22)
__device__ __forceinline__ unsigned xb_ld(unsigned* p)              { return __hip_atomic_load(p, __ATOMIC_RELAXED, __HIP_MEMORY_SCOPE_AGENT); }
__device__ __forceinline__ unsigned xb_add(unsigned* p, unsigned v) { return __hip_atomic_fetch_add(p, v, __ATOMIC_RELAXED, __HIP_MEMORY_SCOPE_AGENT); }
__device__ __forceinline__ unsigned xb_xcc_id() { return (unsigned)__builtin_amdgcn_s_getreg((3 << 11) | 20) & 0xFu; }
#define XB_SPIN(cond, bar) do { unsigned _sp = 0; while (cond) { __builtin_amdgcn_s_sleep(1); \
    if ((++_sp & 255u) == 0u) { if (xb_ld(&(bar)[XB_TMO])) break; if (_sp > XB_SPIN_CAP) { atomicAdd(&(bar)[XB_TMO], 1u); break; } } } } while (0)
struct XcdBarrier { unsigned* bar; unsigned x; volatile LAS unsigned* st; };
__device__ __forceinline__ XcdBarrier xcd_barrier_post(unsigned* bar, volatile LAS unsigned* st) {
    XcdBarrier b; b.bar = bar; b.x = xb_xcc_id(); b.st = st;
    if (threadIdx.x == 0) (void)xb_add(&bar[XB_XCNT(b.x)], 1u);
    return b;
}
__device__ __forceinline__ void xcd_barrier_complete(unsigned* bar, unsigned x, unsigned& nloc, unsigned& nx) {
    const unsigned G = gridDim.x * gridDim.y * gridDim.z;
    unsigned sum, cnt, mine, sp = 0u;
    for (;;) {
        sum = 0u; cnt = 0u; mine = 0u;
#pragma unroll
        for (unsigned j = 0; j < 16; ++j) { const unsigned c = xb_ld(&bar[XB_XCNT(j)]); sum += c; cnt += (c > 0u) ? 1u : 0u; mine = (j == x) ? c : mine; }
        if (sum == G) break;
        __builtin_amdgcn_s_sleep(1);
        if ((++sp & 255u) == 0u) { if (xb_ld(&bar[XB_TMO])) break; if (sp > XB_SPIN_CAP) { atomicAdd(&bar[XB_TMO], 1u); break; } }
    }
    nloc = mine > 0u ? mine : 1u; nx = cnt > 0u ? cnt : 1u;
}
__device__ __forceinline__ void xcd_barrier(const XcdBarrier& b, const int tid0) {
    asm volatile("s_waitcnt vmcnt(0)" ::: "memory");
    __syncthreads();
    if (tid0 == 0) {
        unsigned* bar = b.bar;
        __builtin_amdgcn_s_waitcnt(0);
        unsigned nloc = b.st[0], nx = b.st[1];
        if (nloc == 0u) { xcd_barrier_complete(bar, b.x, nloc, nx); b.st[0] = nloc; b.st[1] = nx; }
        const unsigned old = xb_add(&bar[XB_XSUB(b.x)], 1u);
        const unsigned gen = old / nloc;
        if (old + 1u == (gen + 1u) * nloc) {
            __builtin_amdgcn_fence(__ATOMIC_RELEASE, "agent");
            asm volatile("s_waitcnt vmcnt(0)" ::: "memory");
            const unsigned og = xb_add(&bar[XB_TOP], 1u);
            const unsigned tg = og / nx;
            if (og + 1u == (tg + 1u) * nx) xb_add(&bar[XB_TOPGEN], 1u);
            else XB_SPIN(xb_ld(&bar[XB_TOPGEN]) == tg, bar);
            __builtin_amdgcn_fence(__ATOMIC_ACQUIRE, "agent");
            xb_add(&bar[XB_XGEN(b.x)], 1u);
            asm volatile("s_waitcnt vmcnt(0)" ::: "memory");
        } else {
            XB_SPIN(xb_ld(&bar[XB_XGEN(b.x)]) == gen, bar);
            __builtin_amdgcn_fence(__ATOMIC_ACQUIRE, "agent");
            asm volatile("s_waitcnt vmcnt(0)" ::: "memory");
        }
    }
    __syncthreads();
}

namespace pg8 {
constexpr int BM = 256, BK = 64, HALF = 128, HTB = HALF * BK * 2, STAGE_BYTES = 8 * HTB, NXCD = 8, WGM = 8;
__device__ __forceinline__ int lds_byte(int r, int c) { const int st = (r >> 4) * 2 + (c >> 5), rr = r & 15, cc = c & 31, ob = rr * 64 + cc * 2; return st * 1024 + (ob ^ (((ob >> 9) & 1) << 5)); }
__device__ __forceinline__ void stage_rc(int b, int& R, int& C) { const int st = b / 1024, sb = b % 1024, swz = sb ^ (((sb >> 9) & 1) << 5); R = (st >> 1) * 16 + swz / 64; C = (st & 1) * 32 + (swz % 64) / 2; }
__device__ __forceinline__ int perm32(int rho) { const int n = rho >> 4, i = rho & 15; return 8 * (i >> 2) + 4 * n + (i & 3); }
struct Unit { int pm, pn, e, aux; };

template <class Epi, class Sched, bool F8 = false>
__device__ __forceinline__ void gemm_phase(LAS unsigned char* lds, const int K, const Sched& S, const Epi& E, const int tid) {
    const int wid = __builtin_amdgcn_readfirstlane(tid >> 6), lane = tid & 63, wr = wid >> 2, wc = wid & 3, fr = lane & 15, fq = lane >> 4;
    const int nt = F8 ? K / 128 : K / BK;
    int Rr[2], Cc[2]; unsigned voffB[2];
#pragma unroll
    for (int i = 0; i < 2; ++i) { int R, C; stage_rc(tid * 16 + i * 8192, R, C); const int Rb = Epi::PERM ? ((R & ~31) + perm32(R & 31)) : R; Rr[i] = R; Cc[i] = C; voffB[i] = F8 ? (unsigned)(Rb * K + 2 * C) : (unsigned)(Rb * K + C) * 2u; }
    const size_t kstep = (size_t)(BK * 2);
    const size_t hstep = F8 ? (size_t)HALF * K : (size_t)HALF * K * 2;
    const unsigned ldsw = (unsigned)wid * 1024u;
    const int aoff = lds_byte(wr * 64 + fr, fq * 8), boff = lds_byte(wc * 32 + fr, fq * 8);
    const int f8in = (fq >> 1) * 1024 + ((fr * 64 + 32 * (fq & 1)) ^ ((fr >> 3) << 5)); const int aoff8 = 8 * wr * 1024 + f8in, boff8 = 4 * wc * 1024 + f8in;
#define PG8_SA(b, h) (((b) * 2 + (h)) * HTB)
#define PG8_SB(b, h) ((4 + (b) * 2 + (h)) * HTB)
#define PG8_STAGE(bufoff, gbase, voff) do { _Pragma("unroll") for (int _i = 0; _i < 2; ++_i) { unsigned vo_ = (voff)[_i]; asm volatile("" : "+v"(vo_));     \
        __builtin_amdgcn_global_load_lds((const unsigned*)((const char*)(gbase) + vo_), (LAS unsigned*)(lds + (bufoff) + ldsw + _i * 8192), 16, 0, 0); } } while (0)
#define PG8_STAGEA(bufoff, o0, o1) do { \
        __builtin_amdgcn_global_load_lds((const unsigned*)(aB + (size_t)(o0)), (LAS unsigned*)(lds + (bufoff) + ldsw), 16, 0, 0); \
        __builtin_amdgcn_global_load_lds((const unsigned*)(aB + (size_t)(o1)), (LAS unsigned*)(lds + (bufoff) + ldsw + 8192), 16, 0, 0); } while (0)
#define PG8_LDA(dst, b, h) do { if constexpr (F8) { _Pragma("unroll") for (int m = 0; m < 4; ++m) { typedef int i32x4_ __attribute__((ext_vector_type(4))); const i32x4_ x_ = *(const LAS i32x4_*)(lds + PG8_SA(b, h) + aoff8 + m * 2048), y_ = *(const LAS i32x4_*)(lds + PG8_SA(b, h) + aoff8 + m * 2048 + 16); \
            dst##8[m] = __builtin_shufflevector(x_, y_, 0, 1, 2, 3, 4, 5, 6, 7); } } \
        else { _Pragma("unroll") for (int m = 0; m < 4; ++m) _Pragma("unroll") for (int k = 0; k < 2; ++k) dst[m][k] = *(const LAS bf16x8*)(lds + PG8_SA(b, h) + aoff + m * 2048 + k * 1024); } } while (0)
#define PG8_LDB(dst, b, h) do { if constexpr (F8) { _Pragma("unroll") for (int n = 0; n < 2; ++n) { typedef int i32x4_ __attribute__((ext_vector_type(4))); const i32x4_ x_ = *(const LAS i32x4_*)(lds + PG8_SB(b, h) + boff8 + n * 2048), y_ = *(const LAS i32x4_*)(lds + PG8_SB(b, h) + boff8 + n * 2048 + 16); \
            dst##8[n] = __builtin_shufflevector(x_, y_, 0, 1, 2, 3, 4, 5, 6, 7); } } \
        else { _Pragma("unroll") for (int n = 0; n < 2; ++n) _Pragma("unroll") for (int k = 0; k < 2; ++k) dst[n][k] = *(const LAS bf16x8*)(lds + PG8_SB(b, h) + boff + n * 2048 + k * 1024); } } while (0)
#define PG8_MMA(ai, bj, At, Bt) do { __builtin_amdgcn_s_setprio(1); if constexpr (F8) { _Pragma("unroll") for (int m = 0; m < 4; ++m) _Pragma("unroll") for (int n = 0; n < 2; ++n) \
            acc[ai][bj][m][n] = __builtin_amdgcn_mfma_scale_f32_16x16x128_f8f6f4(Bt##8[n], At##8[m], acc[ai][bj][m][n], 0, 0, 0, 0, 0, 0); } \
        else { _Pragma("unroll") for (int m = 0; m < 4; ++m) _Pragma("unroll") for (int n = 0; n < 2; ++n) _Pragma("unroll") for (int k = 0; k < 2; ++k) \
            acc[ai][bj][m][n] = __builtin_amdgcn_mfma_f32_16x16x32_bf16(Bt[n][k], At[m][k], acc[ai][bj][m][n], 0, 0, 0); } __builtin_amdgcn_s_setprio(0); } while (0)
#define PG8_MMA0(ai, bj, At, Bt) do { __builtin_amdgcn_s_setprio(1); _Pragma("unroll") for (int m = 0; m < 4; ++m) _Pragma("unroll") for (int n = 0; n < 2; ++n) \
            acc[ai][bj][m][n] = __builtin_amdgcn_mfma_scale_f32_16x16x128_f8f6f4(Bt##8[n], At##8[m], ((f32x4){0.f, 0.f, 0.f, 0.f}), 0, 0, 0, 0, 0, 0); __builtin_amdgcn_s_setprio(0); } while (0)
#define PG8_WAIT_V(n) asm volatile("s_waitcnt vmcnt(" #n ")" ::: "memory")
#define PG8_WAIT_L(n) asm volatile("s_waitcnt lgkmcnt(" #n ")" ::: "memory")
#define PG8_BAR __builtin_amdgcn_s_barrier()
#define PG8_SCHED __builtin_amdgcn_sched_barrier(0)
    Unit cur, nxt; int ui = 0;
    if (!S.next(0, cur)) return;
    f32x4 acc[2][2][4][2];
#pragma unroll
    for (int a = 0; a < 2; ++a)
#pragma unroll
        for (int b = 0; b < 2; ++b)
#pragma unroll
            for (int m = 0; m < 4; ++m)
#pragma unroll
                for (int n = 0; n < 2; ++n) acc[a][b][m][n] = (f32x4){0.f, 0.f, 0.f, 0.f};
    bf16x8 At[4][2], B0[2][2], B1[2][2]; i32x8 At8[4], B08[2], B18[2];
    unsigned voc[2][2];
    S.a_off(cur, Rr, Cc, voc);
    const int vso = VOC_OFF + wid * 2048 - 8 * wr * 1024; int csel = 0;
    if constexpr (F8) *(LAS u32x4*)(lds + vso + aoff8) = (u32x4){voc[0][0], voc[0][1], voc[1][0], voc[1][1]};
#define PG8_RDV(sel, h) (*(const LAS u32x2*)(lds + vso + aoff8 + (sel) + (h) * 8))
    const char* const aB = S.a_base();
    const char* cB = S.b_base(cur);
    PG8_STAGE(PG8_SB(0, 0), cB, voffB); PG8_STAGE(PG8_SB(0, 1), cB + hstep, voffB); PG8_STAGEA(PG8_SA(0, 0), voc[0][0], voc[0][1]); PG8_STAGEA(PG8_SA(0, 1), voc[1][0], voc[1][1]);
    if (wr == 1) PG8_BAR;
    PG8_WAIT_V(2); PG8_BAR;
    PG8_STAGE(PG8_SB(1, 0), cB + kstep, voffB); PG8_STAGEA(PG8_SA(1, 0), voc[0][0] + 128u, voc[0][1] + 128u); PG8_STAGE(PG8_SB(1, 1), cB + hstep + kstep, voffB);
    PG8_WAIT_V(6); PG8_BAR;
    for (;;) {
        const bool has_next = S.next(ui + 1, nxt);
        const char* nB = has_next ? S.b_base(nxt) : cB;
#pragma unroll 1
        for (int t = 0; t < nt; t += 2) {
            const bool last = (t == nt - 2);
            const unsigned k1b = (unsigned)(t + 1) * 128u, k2b = last ? 0u : (unsigned)(t + 2) * 128u;
            const char* b2 = last ? nB : cB + (size_t)(t + 2) * kstep; const char* b3 = b2 + kstep;
            if constexpr (F8) {
                const bool sw = last && has_next; const int nsel = sw ? (csel ^ 16) : csel;
                if (sw) {
                    unsigned vn[2][2]; int tl_; asm volatile("v_mbcnt_lo_u32_b32 %0, -1, 0\n\tv_mbcnt_hi_u32_b32 %0, -1, %0" : "=v"(tl_)); tl_ += wid * 64; int R2[2], C2[2];
#pragma unroll
                    for (int i = 0; i < 2; ++i) stage_rc(tl_ * 16 + i * 8192, R2[i], C2[i]);
                    S.a_off(nxt, R2, C2, vn); *(LAS u32x4*)(lds + vso + aoff8 + nsel) = (u32x4){vn[0][0], vn[0][1], vn[1][0], vn[1][1]};
                }
                { const u32x2 o_ = PG8_RDV(csel, 1);
                  PG8_LDB(B0, 0, 0); PG8_LDB(B1, 0, 1); PG8_SCHED; PG8_LDA(At, 0, 0); PG8_STAGEA(PG8_SA(1, 1), o_.x + k1b, o_.y + k1b); }
                PG8_WAIT_V(8); PG8_WAIT_L(0); PG8_BAR; if (t == 0) { PG8_MMA0(0, 0, At, B0); PG8_MMA0(0, 1, At, B1); } else { PG8_MMA(0, 0, At, B0); PG8_MMA(0, 1, At, B1); } PG8_BAR; PG8_SCHED;
                { const u32x2 o_ = PG8_RDV(nsel, 0);
                  PG8_LDA(At, 0, 1); PG8_STAGE(PG8_SB(0, 0), b2, voffB); PG8_STAGE(PG8_SB(0, 1), b2 + hstep, voffB); PG8_STAGEA(PG8_SA(0, 0), o_.x + k2b, o_.y + k2b); }
                PG8_WAIT_V(8); PG8_WAIT_L(0); PG8_BAR; if (t == 0) { PG8_MMA0(1, 0, At, B0); PG8_MMA0(1, 1, At, B1); } else { PG8_MMA(1, 0, At, B0); PG8_MMA(1, 1, At, B1); } PG8_BAR; PG8_SCHED;
                { const u32x2 o_ = PG8_RDV(nsel, 1);
                  PG8_LDB(B0, 1, 0); PG8_LDB(B1, 1, 1); PG8_SCHED; PG8_LDA(At, 1, 0); PG8_STAGEA(PG8_SA(0, 1), o_.x + k2b, o_.y + k2b); }
                PG8_WAIT_V(8); PG8_WAIT_L(0); PG8_BAR; PG8_MMA(0, 0, At, B0); PG8_MMA(0, 1, At, B1); PG8_BAR; PG8_SCHED;
                { const u32x2 o_ = PG8_RDV(nsel, 0);
                  PG8_LDA(At, 1, 1); PG8_STAGE(PG8_SB(1, 0), b3, voffB); PG8_STAGE(PG8_SB(1, 1), b3 + hstep, voffB); PG8_STAGEA(PG8_SA(1, 0), o_.x + (k2b + 128u), o_.y + (k2b + 128u)); }
                PG8_WAIT_V(8); PG8_WAIT_L(0); PG8_BAR; PG8_MMA(1, 0, At, B0); PG8_MMA(1, 1, At, B1); PG8_BAR; PG8_SCHED;
            } else {
            unsigned s00 = voc[0][0] + k2b, s01 = voc[0][1] + k2b, s10 = voc[1][0] + k2b, s11 = voc[1][1] + k2b;
            if (last && has_next) {
                unsigned vn[2][2]; int tl_; asm volatile("v_mbcnt_lo_u32_b32 %0, -1, 0\n\tv_mbcnt_hi_u32_b32 %0, -1, %0" : "=v"(tl_)); tl_ += wid * 64; int R2[2], C2[2];
#pragma unroll
                for (int i = 0; i < 2; ++i) stage_rc(tl_ * 16 + i * 8192, R2[i], C2[i]);
                S.a_off(nxt, R2, C2, vn); s00 = vn[0][0]; s01 = vn[0][1]; s10 = vn[1][0]; s11 = vn[1][1];
            }
            PG8_LDB(B0, 0, 0); PG8_LDB(B1, 0, 1); PG8_SCHED; PG8_LDA(At, 0, 0); PG8_STAGEA(PG8_SA(1, 1), voc[1][0] + k1b, voc[1][1] + k1b);
            PG8_WAIT_V(8); PG8_WAIT_L(0); PG8_BAR; PG8_MMA(0, 0, At, B0); PG8_MMA(0, 1, At, B1); PG8_BAR; PG8_SCHED;
            PG8_LDA(At, 0, 1); PG8_STAGE(PG8_SB(0, 0), b2, voffB); PG8_STAGE(PG8_SB(0, 1), b2 + hstep, voffB); PG8_STAGEA(PG8_SA(0, 0), s00, s01);
            PG8_WAIT_V(8); PG8_WAIT_L(0); PG8_BAR; PG8_MMA(1, 0, At, B0); PG8_MMA(1, 1, At, B1); PG8_BAR; PG8_SCHED;
            PG8_LDB(B0, 1, 0); PG8_LDB(B1, 1, 1); PG8_SCHED; PG8_LDA(At, 1, 0); PG8_STAGEA(PG8_SA(0, 1), s10, s11);
            PG8_WAIT_V(8); PG8_WAIT_L(0); PG8_BAR; PG8_MMA(0, 0, At, B0); PG8_MMA(0, 1, At, B1); PG8_BAR; PG8_SCHED;
            PG8_LDA(At, 1, 1); PG8_STAGE(PG8_SB(1, 0), b3, voffB); PG8_STAGE(PG8_SB(1, 1), b3 + hstep, voffB); PG8_STAGEA(PG8_SA(1, 0), s00 + 128u, s01 + 128u);
            PG8_WAIT_V(8); PG8_WAIT_L(0); PG8_BAR; PG8_MMA(1, 0, At, B0); PG8_MMA(1, 1, At, B1); PG8_BAR; PG8_SCHED;
            }
        }
        if (wr == 0) PG8_BAR;
        E(acc, cur, wr, wc, fr, fq);
        if (!has_next) break;
        if constexpr (!F8) {
#pragma unroll
        for (int a = 0; a < 2; ++a)
#pragma unroll
            for (int b = 0; b < 2; ++b)
#pragma unroll
                for (int m = 0; m < 4; ++m)
#pragma unroll
                    for (int n = 0; n < 2; ++n) acc[a][b][m][n] = (f32x4){0.f, 0.f, 0.f, 0.f}; }
        cur = nxt; cB = nB; ++ui;
        if constexpr (F8) csel ^= 16;
        else { int tl_; asm volatile("v_mbcnt_lo_u32_b32 %0, -1, 0\n\tv_mbcnt_hi_u32_b32 %0, -1, %0" : "=v"(tl_)); tl_ += wid * 64; int R2[2], C2[2];
#pragma unroll
          for (int i = 0; i < 2; ++i) stage_rc(tl_ * 16 + i * 8192, R2[i], C2[i]);
          S.a_off(cur, R2, C2, voc); }
        if (wr == 1) PG8_BAR;
    }
    PG8_WAIT_V(0);
    PG8_BAR;
#undef PG8_SA
#undef PG8_SB
#undef PG8_STAGE
#undef PG8_STAGEA
#undef PG8_RDV
#undef PG8_LDA
#undef PG8_LDB
#undef PG8_MMA
#undef PG8_MMA0
#undef PG8_WAIT_V
#undef PG8_WAIT_L
#undef PG8_BAR
#undef PG8_SCHED
}

struct DenseSched {
    int nM, nN, nwg, G, c; const char* A; unsigned lda_b; const char* Bt; int K;
    __device__ __forceinline__ void init(int M, int N, int G_, int c_, const void* A_, int lda_elems, const void* Bt_, int K_) { nM = M / BM; nN = N / BM; nwg = nM * nN; G = G_; c = c_; A = (const char*)A_; lda_b = (unsigned)lda_elems * 2u; Bt = (const char*)Bt_; K = K_; }
    __device__ __forceinline__ bool next(int i, Unit& u) const {
        const long L = (long)i * G + c; if (L >= nwg) return false;
        int wgid = (int)L; { const int q = nwg / NXCD, r = nwg % NXCD, xcd = wgid % NXCD, off = wgid / NXCD; wgid = (xcd < r ? xcd * (q + 1) : r * (q + 1) + (xcd - r) * q) + off; }
        const int nig = WGM * nN, gid = wgid / nig, fm = gid * WGM, gsz = (nM - fm) < WGM ? (nM - fm) : WGM;
        u.pm = fm + ((wgid % nig) % gsz); u.pn = (wgid % nig) / gsz; u.e = 0; u.aux = 0; return true;
    }
    __device__ __forceinline__ void a_off(const Unit& u, const int (&R)[2], const int (&C)[2], unsigned (&vo)[2][2]) const {
#pragma unroll
        for (int h = 0; h < 2; ++h)
#pragma unroll
            for (int i = 0; i < 2; ++i) vo[h][i] = (unsigned)(u.pm * BM + h * HALF + R[i]) * lda_b + (unsigned)C[i] * 2u;
    }
    __device__ __forceinline__ const char* a_base() const { return A; }
    __device__ __forceinline__ const char* b_base(const Unit& u) const { return Bt + (size_t)u.pn * BM * K * 2; }
};
struct MoeSched {
    const LAS int* ulist; const LAS int* uidx; int nu; const char* A; const char* Bt; int mode  ; int quarter;
    __device__ __forceinline__ bool next(int i, Unit& u) const {
        if (i >= nu) return false;
        u.e = __builtin_amdgcn_readfirstlane(ulist[i * 4 + 0]); u.pm = __builtin_amdgcn_readfirstlane(ulist[i * 4 + 1]); u.pn = __builtin_amdgcn_readfirstlane(ulist[i * 4 + 2]); u.aux = i; return true;
    }
    __device__ __forceinline__ void a_off(const Unit& u, const int (&R)[2], const int (&C)[2], unsigned (&vo)[2][2]) const {
        if (mode == 0) {
#pragma unroll
            for (int i = 0; i < 2; ++i) { const LAS int* p = uidx + u.aux * 256 + R[i]; vo[0][i] = (unsigned)p[0] * 1024u + (unsigned)C[i] * 2u; vo[1][i] = (unsigned)p[HALF] * 1024u + (unsigned)C[i] * 2u; }
        } else {
#pragma unroll
            for (int h = 0; h < 2; ++h)
#pragma unroll
                for (int i = 0; i < 2; ++i) vo[h][i] = (unsigned)(u.pm * BM + h * HALF + R[i]) * 256u + (unsigned)C[i] * 2u;
        }
    }
    __device__ __forceinline__ const char* a_base() const { return A; }
    __device__ __forceinline__ const char* b_base(const Unit& u) const {
        return mode == 0 ? Bt + ((size_t)u.e * 512 + (size_t)u.pn * 256) * 1024 : Bt + ((size_t)u.e * 1024 + (size_t)quarter * 512 + (size_t)u.pn * 256) * 256;
    }
};

struct EpiBf16 {
    static constexpr bool PERM = true;
    bf16_t* O; int ldc; int col_tile0;
    __device__ __forceinline__ void operator()(const f32x4 (&acc)[2][2][4][2], const Unit& u, int wr, int wc, int fr, int fq) const {
        const int row0 = u.pm * BM + wr * 64 + fr; const int col0 = (col_tile0 ? 0 : u.pn * BM) + wc * 32 + 8 * fq;
#pragma unroll
        for (int ai = 0; ai < 2; ++ai)
#pragma unroll
            for (int m = 0; m < 4; ++m) { bf16_t* rowp = O + (size_t)(row0 + ai * HALF + m * 16) * ldc + col0;
#pragma unroll
                for (int bj = 0; bj < 2; ++bj) { const f32x4 v0 = acc[ai][bj][m][0], v1 = acc[ai][bj][m][1];
                    u32x4 w; w.x = cvt_pk_bf16(v0[0], v0[1]); w.y = cvt_pk_bf16(v0[2], v0[3]); w.z = cvt_pk_bf16(v1[0], v1[1]); w.w = cvt_pk_bf16(v1[2], v1[3]);
                    *(u32x4*)(rowp + bj * HALF) = w; } }
    }
};
struct EpiFp8 {
    static constexpr bool PERM = true;
    unsigned char* O; int ldc; float oscale;
    __device__ __forceinline__ void operator()(const f32x4 (&acc)[2][2][4][2], const Unit& u, int wr, int wc, int fr, int fq) const {
        const int row0 = u.pm * BM + wr * 64 + fr; const int col0 = u.pn * BM + wc * 32 + 8 * fq;
#pragma unroll
        for (int ai = 0; ai < 2; ++ai)
#pragma unroll
            for (int m = 0; m < 4; ++m) { unsigned char* rowp = O + (size_t)(row0 + ai * HALF + m * 16) * ldc + col0;
#pragma unroll
                for (int bj = 0; bj < 2; ++bj) { const f32x4 v0 = acc[ai][bj][m][0] * oscale, v1 = acc[ai][bj][m][1] * oscale;
                    u32x2 w; w.x = pk4_fp8(v0[0], v0[1], v0[2], v0[3]); w.y = pk4_fp8(v1[0], v1[1], v1[2], v1[3]);
                    *(u32x2*)(rowp + bj * HALF) = w; } }
    }
};
struct EpiKV {
    static constexpr bool PERM = true;
    unsigned char* K8; bf16_t* Vb;
    __device__ __forceinline__ void operator()(const f32x4 (&acc)[2][2][4][2], const Unit& u, int wr, int wc, int fr, int fq) const {
        const int row0 = u.pm * BM + wr * 64 + fr;
#pragma unroll
        for (int ai = 0; ai < 2; ++ai)
#pragma unroll
            for (int m = 0; m < 4; ++m) { const int row = row0 + ai * HALF + m * 16; int b, key;
                if (row < TL) { b = row >> 14; key = CTXL + (row & (SEQ - 1)); } else { const int rr = row - TL; b = rr >> 8; key = rr & (CTXL - 1); }
#pragma unroll
                for (int bj = 0; bj < 2; ++bj) { const int col0 = u.pn * BM + bj * HALF + wc * 32 + 8 * fq, h = col0 >> 7, j = col0 & 127;
                    const f32x4 v0 = acc[ai][bj][m][0], v1 = acc[ai][bj][m][1];
                    if (j < 64) { u32x2 w; w.x = pk4_fp8(v0[0], v0[1], v0[2], v0[3]); w.y = pk4_fp8(v1[0], v1[1], v1[2], v1[3]);
                        *(u32x2*)(K8 + ((size_t)(b * NH + h) * LK + key) * 128 + j) = w; }
                    else { u32x4 w; w.x = cvt_pk_bf16(v0[0], v0[1]); w.y = cvt_pk_bf16(v0[2], v0[3]); w.z = cvt_pk_bf16(v1[0], v1[1]); w.w = cvt_pk_bf16(v1[2], v1[3]);
                        *(u32x4*)(Vb + ((size_t)(b * NH + h) * LK + key) * DV + (j - 64)) = w; } } }
    }
};
struct EpiResid {
    static constexpr bool PERM = false;
    const float* xlat; const float* xctx; const bf16_t* xsin; bf16_t* XS; const float* mods; float gscale;
    __device__ __forceinline__ void operator()(const f32x4 (&acc)[2][2][4][2], const Unit& u, int wr, int wc, int fr, int fq) const {
        const int rowt = u.pm * BM; const int vec = rowt < SEQ ? 0 : (rowt < TL ? 1 : 2);
        const float* gate = mods + vec * 6144 + 2 * DM;
        const float* xin = rowt < TL ? xlat + (size_t)rowt * DM : xctx + (size_t)(rowt - TL) * DM;
        const bf16_t* xib = xsin + (size_t)rowt * DM;
        bf16_t* xo = XS + (size_t)rowt * DM;
        const int r0 = wr * 64 + fr, col0 = u.pn * BM + wc * 32 + 4 * fq;
        f32x4 gv[2][2];
#pragma unroll
        for (int bj = 0; bj < 2; ++bj)
#pragma unroll
            for (int n = 0; n < 2; ++n) { gv[bj][n] = *(const f32x4*)(gate + col0 + bj * HALF + n * 16); if (REP_OUT > 1) gv[bj][n] = gv[bj][n] * gscale; }
#pragma unroll
        for (int ai = 0; ai < 2; ++ai)
#pragma unroll
            for (int m = 0; m < 4; ++m) { const unsigned off = (unsigned)((r0 + ai * HALF + m * 16) * DM + col0);
#pragma unroll
                for (int bj = 0; bj < 2; ++bj)
#pragma unroll
                    for (int n = 0; n < 2; ++n) { f32x4 xv;
                        if (xsin) { const u32x2 w = *(const u32x2*)(xib + off + bj * HALF + n * 16); xv = (f32x4){bf_lo(w.x), bf_hi(w.x), bf_lo(w.y), bf_hi(w.y)}; }
                        else xv = __builtin_nontemporal_load((const f32x4*)(xin + off + bj * HALF + n * 16));
                        const f32x4 y = xv + gv[bj][n] * acc[ai][bj][m][n]; u32x2 o; o.x = cvt_pk_bf16(y.x, y.y); o.y = cvt_pk_bf16(y.z, y.w);
                        *(u32x2*)(xo + off + bj * HALF + n * 16) = o; }
                asm volatile("" ::: "memory"); }
    }
};
struct EpiLogits {
    static constexpr bool PERM = false;
    float* Lg;
    __device__ __forceinline__ void operator()(const f32x4 (&acc)[2][2][4][2], const Unit& u, int wr, int wc, int fr, int fq) const {
        if (wc >= 2) return;
        const int row0 = u.pm * BM + wr * 64 + fr, col0 = wc * 32 + 4 * fq;
#pragma unroll
        for (int ai = 0; ai < 2; ++ai)
#pragma unroll
            for (int m = 0; m < 4; ++m)
#pragma unroll
                for (int n = 0; n < 2; ++n) *(f32x4*)(Lg + (size_t)(row0 + ai * HALF + m * 16) * NE + col0 + n * 16) = acc[ai][0][m][n];
    }
};
struct EpiSwiGLU {
    static constexpr bool PERM = true;
    bf16_t* ACT; float wscale;
    __device__ __forceinline__ void operator()(const f32x4 (&acc)[2][2][4][2], const Unit& u, int wr, int wc, int fr, int fq) const {
        const unsigned off0 = (unsigned)(u.pm * BM + wr * 64 + fr) * DE + (unsigned)(u.pn * 128 + wc * 16 + 4 * fq);
#pragma unroll
        for (int ai = 0; ai < 2; ++ai)
#pragma unroll
            for (int m = 0; m < 4; ++m) {
#pragma unroll
                for (int bj = 0; bj < 2; ++bj) { const f32x4 g = acc[ai][bj][m][0] * wscale, v = acc[ai][bj][m][1] * wscale;
                    const unsigned w = pk4_fp8(silu_f(g[0]) * v[0], silu_f(g[1]) * v[1], silu_f(g[2]) * v[2], silu_f(g[3]) * v[3]);
                    *(unsigned*)((char*)ACT + (off0 + (unsigned)((ai * HALF + m * 16) * DE + bj * 64))) = w; } }
    }
};
}

namespace att {
constexpr int NW = 8, QBLK = 32, KVBLK = 64, KROW = 208;
constexpr int SHM_V = KVBLK * DV * 2, SHM_K = KVBLK * KROW, OFF_K = 2 * SHM_V, OFF_WS = OFF_K + 2 * SHM_K, OFF_OST = OFF_WS + NW * 64 * 4, LDS_ATT = OFF_OST + NW * 4096;
static_assert(LDS_ATT <= LDS_WORK, "attention LDS");
constexpr float SCALE = 0.10206207261596575f;
constexpr float THR = 8.f;
#define SBAR() __builtin_amdgcn_sched_barrier(0)
__device__ __forceinline__ int crow(int r, int hi) { return (r & 3) + 8 * (r >> 2) + 4 * hi; }
__device__ __forceinline__ void partialSM(f32x16& p0, f32x16& p1, float& m_reg, float& mn, float& alpha) {
    constexpr float C = SCALE * 1.4426950408889634f;
    float pmax = p0[0];
#pragma unroll
    for (int r = 1; r < 16; ++r) pmax = fmaxf(pmax, p0[r]);
#pragma unroll
    for (int r = 0; r < 16; ++r) pmax = fmaxf(pmax, p1[r]);
    { auto rr = __builtin_amdgcn_permlane32_swap(__float_as_uint(pmax), __float_as_uint(pmax), false, false);
      pmax = fmaxf(__uint_as_float(rr[0]), __uint_as_float(rr[1])); }
    if (__builtin_expect(__all(pmax - m_reg <= THR / SCALE), 1)) { mn = m_reg; alpha = 1.f; }
    else { mn = fmaxf(m_reg, pmax); alpha = __builtin_amdgcn_exp2f((m_reg - mn) * C); m_reg = mn; }
    const float mnC = -mn * C;
#pragma unroll
    for (int r = 0; r < 16; ++r) p0[r] = fmaf(p0[r], C, mnC);
#pragma unroll
    for (int r = 0; r < 16; ++r) p1[r] = fmaf(p1[r], C, mnC);
#pragma unroll
    for (int r = 0; r < 16; ++r) p0[r] = __builtin_amdgcn_exp2f(p0[r]);
}
__device__ __forceinline__ void finishSM(f32x16& p0, f32x16& p1, float alpha, float& l_reg, bf16x8& pa0, bf16x8& pa1, bf16x8& pa2, bf16x8& pa3) {
#pragma unroll
    for (int r = 0; r < 16; ++r) p1[r] = __builtin_amdgcn_exp2f(p1[r]);
    float ps = 0;
#pragma unroll
    for (int r = 0; r < 16; ++r) ps += p0[r];
#pragma unroll
    for (int r = 0; r < 16; ++r) ps += p1[r];
    { auto rr = __builtin_amdgcn_permlane32_swap(__float_as_uint(ps), __float_as_uint(ps), false, false);
      ps = __uint_as_float(rr[0]) + __uint_as_float(rr[1]); }
    l_reg = l_reg * alpha + ps;
#define PK4(P, BASE, OUT) do { unsigned a0 = cvt_pk_bf16(P[BASE + 0], P[BASE + 1]), a1 = cvt_pk_bf16(P[BASE + 2], P[BASE + 3]);   \
    unsigned b0 = cvt_pk_bf16(P[BASE + 4], P[BASE + 5]), b1 = cvt_pk_bf16(P[BASE + 6], P[BASE + 7]);                              \
    auto r0 = __builtin_amdgcn_permlane32_swap(a0, b0, false, false); auto r1 = __builtin_amdgcn_permlane32_swap(a1, b1, false, false); \
    u32x4 w = {r0[0], r1[0], r0[1], r1[1]}; OUT = *reinterpret_cast<bf16x8*>(&w); } while (0)
    PK4(p0, 0, pa0); PK4(p0, 8, pa1); PK4(p1, 0, pa2); PK4(p1, 8, pa3);
#undef PK4
}
__device__ __forceinline__ void qkt(f32x16& p0, f32x16& p1, const LAS char* Ks, const bf16x8* qr, int r32, int hi) {
    p0 = f32x16{}; p1 = f32x16{};
#pragma unroll
    for (int d0 = 0; d0 < 6; ++d0) { const int cb = (d0 * 16 + hi * 8) * 2;
        const bf16x8 b0 = *reinterpret_cast<const LAS bf16x8*>(Ks + r32 * KROW + cb);
        const bf16x8 b1 = *reinterpret_cast<const LAS bf16x8*>(Ks + (32 + r32) * KROW + cb);
        p0 = __builtin_amdgcn_mfma_f32_32x32x16_bf16(b0, qr[d0], p0, 0, 0, 0);
        p1 = __builtin_amdgcn_mfma_f32_32x32x16_bf16(b1, qr[d0], p1, 0, 0, 0); }
}
__device__ __forceinline__ int v_st(int k, int c) { const int kk = (k & ~0xC) | ((k & 4) << 1) | ((k & 8) >> 1); return ((kk >> 3) * 2 + (c >> 5)) * 512 + ((kk & 7) * 32 + (c & 31)) * 2; }
__device__ __forceinline__ int v_rd_base(int lane) { return ((lane & 3) << 3) | (((lane >> 2) & 3) << 6) | (((lane >> 4) & 1) << 5) | (((lane >> 5) & 1) << 8); }
template <int OFF> __device__ __forceinline__ s16x4 tr_read(int vb) {
    s16x4 r; asm volatile("ds_read_b64_tr_b16 %0, %1 offset:%2" : "=&v"(r) : "v"(vb), "i"(OFF) : "memory"); return r;
}
template <int D0> __device__ __forceinline__ void pv_one(f32x16& od, int vb, bf16x8 pa0, bf16x8 pa1, bf16x8 pa2, bf16x8 pa3) {
    const s16x4 l0 = tr_read<D0 * 512 + 0 * 2048>(vb), h0 = tr_read<D0 * 512 + 0 * 2048 + 1024>(vb), l1 = tr_read<D0 * 512 + 1 * 2048>(vb), h1 = tr_read<D0 * 512 + 1 * 2048 + 1024>(vb);
    const s16x4 l2 = tr_read<D0 * 512 + 2 * 2048>(vb), h2 = tr_read<D0 * 512 + 2 * 2048 + 1024>(vb), l3 = tr_read<D0 * 512 + 3 * 2048>(vb), h3 = tr_read<D0 * 512 + 3 * 2048 + 1024>(vb);
    asm volatile("s_waitcnt lgkmcnt(0)" ::: "memory"); SBAR();
#define PK(L, H) (bf16x8){L[0], L[1], L[2], L[3], H[0], H[1], H[2], H[3]}
    od = __builtin_amdgcn_mfma_f32_32x32x16_bf16(pa0, PK(l0, h0), od, 0, 0, 0);
    od = __builtin_amdgcn_mfma_f32_32x32x16_bf16(pa1, PK(l1, h1), od, 0, 0, 0);
    od = __builtin_amdgcn_mfma_f32_32x32x16_bf16(pa2, PK(l2, h2), od, 0, 0, 0);
    od = __builtin_amdgcn_mfma_f32_32x32x16_bf16(pa3, PK(l3, h3), od, 0, 0, 0);
#undef PK
}
__device__ __forceinline__ void pv_d0(f32x16* o, int vb, bf16x8 pa0, bf16x8 pa1, bf16x8 pa2, bf16x8 pa3) {
    pv_one<0>(o[0], vb, pa0, pa1, pa2, pa3); pv_one<1>(o[1], vb, pa0, pa1, pa2, pa3);
}
__device__ __forceinline__ void attn_unit(const bf16_t* __restrict__ Qb, const bf16_t* __restrict__ Kh, const bf16_t* __restrict__ Vh, bf16_t* __restrict__ Ob, int ldo, int seq, bool rope, int pos0, LAS char* lds, const int tid) {
    const int wid = __builtin_amdgcn_readfirstlane(tid >> 6), lane = tid & 63, r32 = lane & 31, hi = lane >> 5;
    LAS char* V_lds = lds; LAS char* K_lds = lds + OFF_K;
    LAS float* ws = (LAS float*)(lds + OFF_WS) + wid * 64; LAS float* li_l = ws; LAS float* al_l = ws + 32;
    float m_reg = -1e30f, l_reg = 0; f32x16 o[2] = {}; bf16x8 qr[6];
    const bf16_t* Qw = Qb + (size_t)(wid * QBLK + r32) * 768 + hi * 8;
#pragma unroll
    for (int d0 = 0; d0 < 6; ++d0) qr[d0] = *reinterpret_cast<const bf16x8*>(Qw + d0 * 16);
    if (rope) {
        const int t = pos0 + wid * QBLK + r32;
#pragma unroll
        for (int ax = 0; ax < 2; ++ax) {
            const float pos = (float)(ax == 0 ? (t >> 6) : (t & 63));
            u32x4 mine = *reinterpret_cast<u32x4*>(&qr[4 + ax]); u32x4 oth;
#pragma unroll
            for (int j = 0; j < 4; ++j) { auto rr = __builtin_amdgcn_permlane32_swap(mine[j], mine[j], false, false); oth[j] = hi ? rr[1] : rr[0]; }
            u32x4 res;
#pragma unroll
            for (int j = 0; j < 4; ++j) {
                float cs[2], sn[2];
#pragma unroll
                for (int q = 0; q < 2; ++q) { const float ang = pos * __powf(10000.0f, -(float)(2 * j + q) * 0.125f); sn[q] = __sinf(ang); cs[q] = __cosf(ang); }
                const float m0 = bf_lo(mine[j]), m1 = bf_hi(mine[j]), o0 = bf_lo(oth[j]), o1 = bf_hi(oth[j]);
                const float r0 = hi == 0 ? m0 * cs[0] - o0 * sn[0] : m0 * cs[0] + o0 * sn[0];
                const float r1 = hi == 0 ? m1 * cs[1] - o1 * sn[1] : m1 * cs[1] + o1 * sn[1];
                res[j] = cvt_pk_bf16(r0, r1);
            }
            qr[4 + ax] = *reinterpret_cast<bf16x8*>(&res);
        }
    }
    const int vk = tid >> 3, vc = (tid & 7) * 8, vst = v_st(vk, vc);
    const int kc0 = tid, kc1 = 512 + (tid & 255); const int kst0 = (kc0 / 12) * KROW + (kc0 % 12) * 16, kst1 = (kc1 / 12) * KROW + (kc1 % 12) * 16;
    const bool k2 = wid < 4;
    const int vb0 = (int)(uintptr_t)V_lds + v_rd_base(lane);
    struct { bf16x8 vs0, ks0, ks1; } sr_[2];
#define SLOAD(i, k0) do { sr_[i].vs0 = *reinterpret_cast<const bf16x8*>(Vh + (size_t)(k0) * DV + tid * 8); sr_[i].ks0 = *reinterpret_cast<const bf16x8*>(Kh + (size_t)(k0) * DQK + kc0 * 8); \
    if (k2) sr_[i].ks1 = *reinterpret_cast<const bf16x8*>(Kh + (size_t)(k0) * DQK + kc1 * 8); } while (0)
#define SWRITE(b, i) do { *(LAS bf16x8*)(V_lds + (b) * SHM_V + vst) = sr_[i].vs0; *(LAS bf16x8*)(K_lds + (b) * SHM_K + kst0) = sr_[i].ks0; \
    if (k2) *(LAS bf16x8*)(K_lds + (b) * SHM_K + kst1) = sr_[i].ks1; } while (0)
#define RESC(a) do { if (__any((a) < 1.f)) { if (hi == 0) al_l[r32] = (a); asm volatile("s_waitcnt lgkmcnt(0)" ::: "memory"); \
    _Pragma("unroll") for (int d = 0; d < 2; ++d) _Pragma("unroll") for (int r = 0; r < 16; ++r) o[d][r] *= al_l[crow(r, hi)]; } } while (0)
    f32x16 pA0, pA1, pB0, pB1; float mnA, mnB, alA, alB; bf16x8 pa0, pa1, pa2, pa3; const int NT = seq / KVBLK;
    constexpr int SE = 0, SO = 1;
    SLOAD(SE, 0); asm volatile("s_waitcnt vmcnt(0)" ::: "memory"); SWRITE(0, SE); __syncthreads();
    qkt(pA0, pA1, K_lds, qr, r32, hi); partialSM(pA0, pA1, m_reg, mnA, alA);
    SLOAD(SO, KVBLK); if (2 < NT) SLOAD(SE, 2 * KVBLK);
    SWRITE(1, SO); __syncthreads();
    for (int j = 1; j + 1 < NT; j += 2) {
        SBAR(); qkt(pB0, pB1, K_lds + SHM_K, qr, r32, hi);
        finishSM(pA0, pA1, alA, l_reg, pa0, pa1, pa2, pa3); SBAR();
        SLOAD(SO, (j + 2) * KVBLK); SBAR();
        pv_d0(o, vb0, pa0, pa1, pa2, pa3); partialSM(pB0, pB1, m_reg, mnB, alB);
        __syncthreads(); SWRITE(0, SE);
        RESC(alB); __syncthreads();
        SBAR(); qkt(pA0, pA1, K_lds, qr, r32, hi);
        finishSM(pB0, pB1, alB, l_reg, pa0, pa1, pa2, pa3); SBAR();
        if (j + 3 < NT) SLOAD(SE, (j + 3) * KVBLK); SBAR();
        pv_d0(o, vb0 + SHM_V, pa0, pa1, pa2, pa3); partialSM(pA0, pA1, m_reg, mnA, alA);
        __syncthreads(); SWRITE(1, SO);
        RESC(alA); __syncthreads();
    }
    SBAR(); qkt(pB0, pB1, K_lds + SHM_K, qr, r32, hi);
    finishSM(pA0, pA1, alA, l_reg, pa0, pa1, pa2, pa3); SBAR();
    pv_d0(o, vb0, pa0, pa1, pa2, pa3); partialSM(pB0, pB1, m_reg, mnB, alB);
    __syncthreads(); RESC(alB);
    finishSM(pB0, pB1, alB, l_reg, pa0, pa1, pa2, pa3); SBAR();
    pv_d0(o, vb0 + SHM_V, pa0, pa1, pa2, pa3);
    if (hi == 0) li_l[r32] = l_reg; asm volatile("s_waitcnt lgkmcnt(0)" ::: "memory");
    float rli[16];
#pragma unroll
    for (int r = 0; r < 16; ++r) rli[r] = __builtin_amdgcn_rcpf(li_l[crow(r, hi)]);
    { LAS bf16_t* stg = (LAS bf16_t*)(lds + OFF_OST) + wid * 2048;
#pragma unroll
      for (int r = 0; r < 16; ++r) { const int orow = crow(r, hi);
#pragma unroll
          for (int d0 = 0; d0 < 2; ++d0) stg[orow * 64 + d0 * 32 + r32] = (bf16_t)(cvt_pk_bf16(o[d0][r] * rli[r], 0.f) & 0xffffu); }
      asm volatile("s_waitcnt lgkmcnt(0)" ::: "memory");
      bf16_t* Ow = Ob + (size_t)(wid * QBLK) * ldo;
#pragma unroll
      for (int i = 0; i < 4; ++i) { const int row = i * 8 + (lane >> 3), ch = lane & 7; const u32x4 v = *(const LAS u32x4*)(stg + row * 64 + ch * 8); *(u32x4*)(Ow + (size_t)row * ldo + ch * 8) = v; } }
    asm volatile("s_waitcnt lgkmcnt(0)" ::: "memory"); __syncthreads();
#undef SLOAD
#undef SWRITE
#undef RESC
}
}


namespace att8 {
constexpr int KROW = 144, VROW = 80, SLOT_K = 64 * KROW, SLOT_V = 64 * VROW, NSLOT = 3;
constexpr int OFF_V = NSLOT * SLOT_K, OFF_WS = OFF_V + NSLOT * SLOT_V, OFF_OST = OFF_WS + 8 * 512, LDS_ATT = OFF_OST + 8 * 8192;
static_assert(LDS_ATT <= LDS_WORK, "attention LDS");
constexpr float C2 = 0.10206207261596575f * 1.4426950408889634f;
constexpr float THR = 6.f, PSH = 2.f;
__device__ __forceinline__ int crow(int r, int hi) { return (r & 3) + 8 * (r >> 2) + 4 * hi; }
#define MFMA8(a, b, c) __builtin_amdgcn_mfma_scale_f32_32x32x64_f8f6f4(a, b, c, 0, 0, 0, 0, 0, 0)
__device__ __forceinline__ float max3f(float a, float b, float c) { float r; asm("v_max3_f32 %0, %1, %2, %3" : "=v"(r) : "v"(a), "v"(b), "v"(c)); return r; }
__device__ __forceinline__ i32x8 ld32(const LAS char* p) { const u32x4 a = *(const LAS u32x4*)p, b = *(const LAS u32x4*)(p + 16); return (i32x8){(int)a.x, (int)a.y, (int)a.z, (int)a.w, (int)b.x, (int)b.y, (int)b.z, (int)b.w}; }
__device__ __forceinline__ i32x8 softmax_blk(f32x16& p0, f32x16& p1, float& m_reg, float& l_reg, f32x16 (&o)[2], LAS float* al_l, int r32, int hi) {
    float a = fmaxf(fmaxf(p0[0], p0[1]), p1[0]), b = fmaxf(fmaxf(p0[2], p0[3]), p1[1]); a = fmaxf(fmaxf(a, p1[2]), p1[3]);
#pragma unroll
    for (int r = 4; r < 16; r += 4) { a = fmaxf(fmaxf(a, p0[r]), p0[r + 1]); b = fmaxf(fmaxf(b, p0[r + 2]), p0[r + 3]); a = fmaxf(fmaxf(a, p1[r]), p1[r + 1]); b = fmaxf(fmaxf(b, p1[r + 2]), p1[r + 3]); }
    float pmax = fmaxf(a, b);
    { auto rr = __builtin_amdgcn_permlane32_swap(__float_as_uint(pmax), __float_as_uint(pmax), false, false); pmax = fmaxf(__uint_as_float(rr[0]), __uint_as_float(rr[1])); }
    if (__builtin_expect(!__all(pmax - m_reg <= THR), 0)) {
        const float mn = fmaxf(m_reg, pmax), alpha = __builtin_amdgcn_exp2f(m_reg - mn); m_reg = mn; l_reg *= alpha;
        if (hi == 0) al_l[r32] = alpha; asm volatile("s_waitcnt lgkmcnt(0)" ::: "memory");
        int hi_ = hi; asm volatile("" : "+v"(hi_));
#pragma unroll
        for (int d = 0; d < 2; ++d)
#pragma unroll
            for (int r = 0; r < 16; ++r) o[d][r] *= al_l[crow(r, hi_)];
    }
    const float ms = m_reg - PSH;
#pragma unroll
    for (int r = 0; r < 16; ++r) { p0[r] = __builtin_amdgcn_exp2f(p0[r] - ms); p1[r] = __builtin_amdgcn_exp2f(p1[r] - ms); }
    float ps = 0.f;
#pragma unroll
    for (int r = 0; r < 16; ++r) ps += p0[r];
#pragma unroll
    for (int r = 0; r < 16; ++r) ps += p1[r];
    { auto rr = __builtin_amdgcn_permlane32_swap(__float_as_uint(ps), __float_as_uint(ps), false, false); ps = __uint_as_float(rr[0]) + __uint_as_float(rr[1]); }
    l_reg += ps;
    i32x8 pa;
#pragma unroll
    for (int w = 0; w < 4; ++w) { pa[w] = (int)pk4_fp8(p0[4 * w], p0[4 * w + 1], p0[4 * w + 2], p0[4 * w + 3]); pa[4 + w] = (int)pk4_fp8(p1[4 * w], p1[4 * w + 1], p1[4 * w + 2], p1[4 * w + 3]); }
    return pa;
}
__device__ __forceinline__ void load_q(i32x8 (&q)[2], const char* __restrict__ qbase, unsigned qoff, int hi, bool rope, int t) {
    { const u32x4* p = (const u32x4*)(qbase + (qoff + (unsigned)hi * 64u)); float f[32];
#pragma unroll
      for (int c = 0; c < 4; ++c) { const u32x4 v = p[c];
#pragma unroll
          for (int j = 0; j < 4; ++j) { f[8 * c + 2 * j] = bf_lo(v[j]) * C2; f[8 * c + 2 * j + 1] = bf_hi(v[j]) * C2; } }
#pragma unroll
      for (int w = 0; w < 8; ++w) q[0][w] = (int)pk4_fp8(f[4 * w], f[4 * w + 1], f[4 * w + 2], f[4 * w + 3]); }
    { const u32x4* p = (const u32x4*)(qbase + (qoff + 128u)); float f[32];
#pragma unroll
      for (int c = 0; c < 4; ++c) { const u32x4 v = p[c];
#pragma unroll
          for (int j = 0; j < 4; ++j) { f[8 * c + 2 * j] = bf_lo(v[j]) * C2; f[8 * c + 2 * j + 1] = bf_hi(v[j]) * C2; } }
      if (rope) {
#pragma unroll
          for (int ax = 0; ax < 2; ++ax) { const float pos = (float)(ax == 0 ? (t >> 6) : (t & 63));
#pragma unroll
              for (int j = 0; j < 8; ++j) { const float ang = pos * __powf(10000.0f, -(float)j * 0.125f); const float sn = __sinf(ang), cs = __cosf(ang);
                  const float x1 = f[16 * ax + j], x2 = f[16 * ax + 8 + j]; f[16 * ax + j] = x1 * cs - x2 * sn; f[16 * ax + 8 + j] = x2 * cs + x1 * sn; } } }
#pragma unroll
      for (int w = 0; w < 8; ++w) q[1][w] = hi ? 0 : (int)pk4_fp8(f[4 * w], f[4 * w + 1], f[4 * w + 2], f[4 * w + 3]); }
}
__device__ __forceinline__ void attn_unit(const bf16_t* __restrict__ Qb, const unsigned char* __restrict__ K8t, const unsigned char* __restrict__ VTt, bf16_t* __restrict__ Ob, int ldo, int ntile, bool rope, int pos0, int nvalid, LAS char* lds, const int tid) {
    const int wid = __builtin_amdgcn_readfirstlane(tid >> 6), lane = tid & 63, r32 = lane & 31, hi = lane >> 5;
    LAS float* wsf = (LAS float*)(lds + OFF_WS) + wid * 128;
    i32x8 qX[2], qY[2];
    { const int rx = wid * 64 + r32, ry = rx + 32; const int cx = rx < nvalid ? rx : rx % nvalid, cy = ry < nvalid ? ry : ry % nvalid;
      load_q(qX, (const char*)Qb, (unsigned)cx * 1536u, hi, rope, pos0 + rx); load_q(qY, (const char*)Qb, (unsigned)cy * 1536u, hi, rope, pos0 + ry); }
    float mX = -1e30f, mY = -1e30f, lX = 0.f, lY = 0.f; f32x16 oX[2] = {}, oY[2] = {};
    const int kst = (tid >> 3) * KROW + (tid & 7) * 16, vst = OFF_V + (tid >> 2) * VROW + (tid & 3) * 16; const bool vth = wid < 4;
    const int kfo = r32 * KROW + hi * 32, vfo = OFF_V + r32 * VROW + hi * 32;
    unsigned zz_ = 0u; asm volatile("" : "+v"(zz_));
    u32x4 sk, sv = {zz_, zz_, zz_, zz_};
    const unsigned toff = (unsigned)tid * 16u;
#define SLOAD8(t) do { sk = *(const u32x4*)(K8t + (size_t)(t) * 8192 + toff); if (vth) sv = *(const u32x4*)(VTt + (size_t)(t) * 4096 + toff); } while (0)
#define SWRITE8(s) do { *(LAS u32x4*)(lds + (s) * SLOT_K + kst) = sk; if (vth) *(LAS u32x4*)(lds + (s) * SLOT_V + vst) = sv; } while (0)
    SLOAD8(0); SWRITE8(0); if (1 < ntile) SLOAD8(1);
    int sc = 0, sn = 1;
    for (int t = 0; t < ntile; ++t) {
        __syncthreads();
        if (t + 1 < ntile) SWRITE8(sn);
        if (t + 2 < ntile) SLOAD8(t + 2);
        const LAS char* kb = lds + sc * SLOT_K + kfo; const LAS char* vb = lds + sc * SLOT_V + vfo;
        f32x16 pX0, pX1, pY0, pY1;
        { const i32x8 k0 = ld32(kb), k1 = ld32(kb + 32 * KROW); const f32x16 z = {};
          pX0 = MFMA8(k0, qX[0], z); pX1 = MFMA8(k1, qX[0], z); pY0 = MFMA8(k0, qY[0], z); pY1 = MFMA8(k1, qY[0], z); }
        { const i32x8 k0 = ld32(kb + 64), k1 = ld32(kb + 32 * KROW + 64);
          pX0 = MFMA8(k0, qX[1], pX0); pX1 = MFMA8(k1, qX[1], pX1); pY0 = MFMA8(k0, qY[1], pY0); pY1 = MFMA8(k1, qY[1], pY1); }
        const i32x8 paX = softmax_blk(pX0, pX1, mX, lX, oX, wsf, r32, hi);
        { const i32x8 v0 = ld32(vb), v1 = ld32(vb + 32 * VROW);
          oX[0] = MFMA8(paX, v0, oX[0]); oX[1] = MFMA8(paX, v1, oX[1]); }
        const i32x8 paY = softmax_blk(pY0, pY1, mY, lY, oY, wsf + 32, r32, hi);
        { const i32x8 v0 = ld32(vb), v1 = ld32(vb + 32 * VROW);
          oY[0] = MFMA8(paY, v0, oY[0]); oY[1] = MFMA8(paY, v1, oY[1]); }
        sc = sn; sn = (sn == NSLOT - 1) ? 0 : sn + 1;
    }
#undef SLOAD8
#undef SWRITE8
    if (hi == 0) { wsf[64 + r32] = lX; wsf[96 + r32] = lY; } asm volatile("s_waitcnt lgkmcnt(0)" ::: "memory");
    LAS bf16_t* stg = (LAS bf16_t*)(lds + OFF_OST) + wid * 4096;
#pragma unroll
    for (int r = 0; r < 16; ++r) { const int orow = crow(r, hi); const float rx = __builtin_amdgcn_rcpf(wsf[64 + orow]), ry = __builtin_amdgcn_rcpf(wsf[96 + orow]);
#pragma unroll
        for (int d0 = 0; d0 < 2; ++d0) { stg[orow * 64 + d0 * 32 + r32] = (bf16_t)(cvt_pk_bf16(oX[d0][r] * rx, 0.f) & 0xffffu); stg[(32 + orow) * 64 + d0 * 32 + r32] = (bf16_t)(cvt_pk_bf16(oY[d0][r] * ry, 0.f) & 0xffffu); } }
    asm volatile("s_waitcnt lgkmcnt(0)" ::: "memory");
#pragma unroll
    for (int i = 0; i < 8; ++i) { const int row = i * 8 + (lane >> 3), ch = lane & 7; const u32x4 v = *(const LAS u32x4*)(stg + row * 64 + ch * 8);
        if (wid * 64 + row < nvalid) *(u32x4*)(Ob + (size_t)(wid * 64 + row) * ldo + ch * 8) = v; }
    asm volatile("s_waitcnt lgkmcnt(0)" ::: "memory"); __syncthreads();
}
#undef MFMA8

__device__ __forceinline__ void sm_max(f32x16& p0, f32x16& p1, float& m_reg, float& l_reg, f32x16 (&o)[2], i32x8& qpad, LAS float* al_l, int r32, int hi, bool first) {
    float a = fmaxf(fmaxf(p0[0], p0[1]), p1[0]), b = fmaxf(fmaxf(p0[2], p0[3]), p1[1]); a = fmaxf(fmaxf(a, p1[2]), p1[3]);
#pragma unroll
    for (int r = 4; r < 16; r += 4) { a = fmaxf(fmaxf(a, p0[r]), p0[r + 1]); b = fmaxf(fmaxf(b, p0[r + 2]), p0[r + 3]); a = fmaxf(fmaxf(a, p1[r]), p1[r + 1]); b = fmaxf(fmaxf(b, p1[r + 2]), p1[r + 3]); }
    float pmax = fmaxf(a, b);
    { auto rr = __builtin_amdgcn_permlane32_swap(__float_as_uint(pmax), __float_as_uint(pmax), false, false); pmax = fmaxf(__uint_as_float(rr[0]), __uint_as_float(rr[1])); }
    if (__builtin_expect(first || !__all(pmax <= THR + PSH), 0)) {
        const float tm = ceilf(pmax + (m_reg - PSH)); float x = (first ? tm : fmaxf(m_reg, tm)) - PSH;
        const unsigned qb_ = __builtin_amdgcn_cvt_pk_fp8_f32(-x, 0.f, 0u, false) & 0xffu; x = -__builtin_amdgcn_cvt_f32_fp8((int)qb_, 0);
        const float mn = x + PSH, d = mn - m_reg, alpha = __builtin_amdgcn_exp2f(-d); m_reg = mn; l_reg *= alpha;
        if (hi == 0) al_l[r32] = alpha; asm volatile("s_waitcnt lgkmcnt(0)" ::: "memory");
        int hi_ = hi; asm volatile("" : "+v"(hi_));
#pragma unroll
        for (int dd = 0; dd < 2; ++dd)
#pragma unroll
            for (int r = 0; r < 16; ++r) o[dd][r] *= al_l[crow(r, hi_)];
#pragma unroll
        for (int r = 0; r < 16; ++r) { p0[r] -= d; p1[r] -= d; }
        if (hi_) qpad[0] = (int)qb_;
    }
}
__device__ __forceinline__ i32x8 sm_exp(f32x16& p0, f32x16& p1, const float m_reg, float& l_reg) {
    const float ms = m_reg - PSH;
#pragma unroll
    for (int r = 0; r < 16; ++r) { p0[r] = __builtin_amdgcn_exp2f(p0[r] - ms); p1[r] = __builtin_amdgcn_exp2f(p1[r] - ms); }
    float ps = 0.f;
#pragma unroll
    for (int r = 0; r < 16; ++r) ps += p0[r];
#pragma unroll
    for (int r = 0; r < 16; ++r) ps += p1[r];
    { auto rr = __builtin_amdgcn_permlane32_swap(__float_as_uint(ps), __float_as_uint(ps), false, false); ps = __uint_as_float(rr[0]) + __uint_as_float(rr[1]); }
    l_reg += ps;
    i32x8 pa;
#pragma unroll
    for (int w = 0; w < 4; ++w) { pa[w] = (int)pk4_fp8(p0[4 * w], p0[4 * w + 1], p0[4 * w + 2], p0[4 * w + 3]); pa[4 + w] = (int)pk4_fp8(p1[4 * w], p1[4 * w + 1], p1[4 * w + 2], p1[4 * w + 3]); }
    return pa;
}
#define MFMA8(a, b, c) __builtin_amdgcn_mfma_scale_f32_32x32x64_f8f6f4(a, b, c, 0, 0, 0, 0, 0, 0)
#ifndef ATT_FENCE
#define ATT_FENCE 1
#endif
#if ATT_FENCE
#define SB0() __builtin_amdgcn_sched_barrier(0)
#else
#define SB0() do {} while (0)
#endif
#define ATT_EXP(x) (VAR == 1 ? (x) * 1.0009765625f : __builtin_amdgcn_exp2f(x))
#define SM_CHUNK(P0, P1, PA, PS, c) do { if constexpr (VAR == 3) { PA[c] = __float_as_int(P0[4 * (c)]); PA[4 + (c)] = __float_as_int(P1[4 * (c)]); } else { \
    _Pragma("unroll") for (int r_ = 4 * (c); r_ < 4 * (c) + 4; ++r_) { P0[r_] = ATT_EXP(P0[r_]); P1[r_] = ATT_EXP(P1[r_]); } \
    _Pragma("unroll") for (int r_ = 4 * (c); r_ < 4 * (c) + 4; ++r_) { PS += P0[r_]; PS += P1[r_]; } \
    PA[c] = (int)pk4_fp8(P0[4 * (c)], P0[4 * (c) + 1], P0[4 * (c) + 2], P0[4 * (c) + 3]); PA[4 + (c)] = (int)pk4_fp8(P1[4 * (c)], P1[4 * (c) + 1], P1[4 * (c) + 2], P1[4 * (c) + 3]); } } while (0)
__device__ __forceinline__ void sm_rescale(f32x16& p0, f32x16& p1, i32x8& pa, float& s_row, float& m_reg, float& l_reg, f32x16 (&o)[2], i32x8& qpad, LAS float* al_l, int r32, int hi, bool first) {
    float d = ceilf(__log2f(fmaxf(s_row, 1e-30f))) - 4.f; d = fminf(fmaxf(d, first ? -100.f : 0.f), 100.f);
    const float xo = m_reg - PSH; const float xn = xo + d;
    unsigned qb_ = __builtin_amdgcn_cvt_pk_fp8_f32(-xn, 0.f, 0u, false) & 0xffu; float xq = -__builtin_amdgcn_cvt_f32_fp8((int)qb_, 0);
    if (xq < xn) { const float st = __builtin_amdgcn_exp2f(floorf(__log2f(fabsf(xq) + 1e-9f)) - 3.f); qb_ = __builtin_amdgcn_cvt_pk_fp8_f32(-(xq + st), 0.f, 0u, false) & 0xffu; xq = -__builtin_amdgcn_cvt_f32_fp8((int)qb_, 0); }
    const float dd = xq - xo, f = __builtin_amdgcn_exp2f(-dd);
    m_reg = xq + PSH; l_reg *= f; s_row *= f;
    if (hi == 0) al_l[r32] = f; asm volatile("s_waitcnt lgkmcnt(0)" ::: "memory");
    int hi_ = hi; asm volatile("" : "+v"(hi_));
#pragma unroll
    for (int dq = 0; dq < 2; ++dq)
#pragma unroll
        for (int r = 0; r < 16; ++r) o[dq][r] *= al_l[crow(r, hi_)];
#pragma unroll
    for (int r = 0; r < 16; ++r) { p0[r] *= f; p1[r] *= f; }
#pragma unroll
    for (int w = 0; w < 4; ++w) { pa[w] = (int)pk4_fp8(p0[4 * w], p0[4 * w + 1], p0[4 * w + 2], p0[4 * w + 3]); pa[4 + w] = (int)pk4_fp8(p1[4 * w], p1[4 * w + 1], p1[4 * w + 2], p1[4 * w + 3]); }
    if (hi_) qpad[0] = (int)qb_;
}
#define SM_FIN(PS, L, P0, P1, PA, M, O, QP, AL, FIRST) do { float s_ = PS; { auto rr_ = __builtin_amdgcn_permlane32_swap(__float_as_uint(s_), __float_as_uint(s_), false, false); s_ = __uint_as_float(rr_[0]) + __uint_as_float(rr_[1]); } \
    if (__builtin_expect((FIRST) || !__all(s_ <= 256.f), 0)) sm_rescale(P0, P1, PA, s_, M, L, O, QP, AL, r32, hi, FIRST); \
    L += s_; } while (0)
template <int VAR> __device__ __forceinline__ f32x16 mfv(const i32x8& a, const i32x8& b, f32x16 c) {
    if constexpr (VAR == 2) { asm volatile("" : "+v"(c)); return c; } else return __builtin_amdgcn_mfma_scale_f32_32x32x64_f8f6f4(a, b, c, 0, 0, 0, 0, 0, 0);
}
template <int VAR = 0>
__device__ __forceinline__ void attn_unit_p(const bf16_t* __restrict__ Qb, const unsigned char* __restrict__ K8t, const unsigned char* __restrict__ VTt, bf16_t* __restrict__ Ob, int ldo, int ntile, bool rope, int pos0, int nvalid, LAS char* lds, const int tid) {
#define MF(a, b, c) mfv<VAR>(a, b, c)
#define MFZ(a, b, cold) (VAR == 2 ? mfv<VAR>(a, b, cold) : mfv<VAR>(a, b, z))

    const int wid = __builtin_amdgcn_readfirstlane(tid >> 6), lane = tid & 63, r32 = lane & 31, hi = lane >> 5;
    LAS float* wsf = (LAS float*)(lds + OFF_WS) + wid * 128;
    i32x8 qX[2], qY[2];
    { const int rx = wid * 64 + r32, ry = rx + 32; const int cx = rx < nvalid ? rx : rx % nvalid, cy = ry < nvalid ? ry : ry % nvalid;
      load_q(qX, (const char*)Qb, (unsigned)cx * 1536u, hi, rope, pos0 + rx); load_q(qY, (const char*)Qb, (unsigned)cy * 1536u, hi, rope, pos0 + ry); }
    if (wid >= 4) __builtin_amdgcn_s_setprio(1);
    float mX = 0.f, mY = 0.f, lX = 0.f, lY = 0.f; f32x16 oX[2] = {}, oY[2] = {};
    { const unsigned qb_ = __builtin_amdgcn_cvt_pk_fp8_f32(PSH, 0.f, 0u, false) & 0xffu; if (hi) { qX[1][0] = (int)qb_; qY[1][0] = (int)qb_; } }
    const int kst = (tid >> 3) * KROW + (tid & 7) * 16, vst = OFF_V + (tid >> 2) * VROW + (tid & 3) * 16; const bool vth = wid < 4;
    const int kfo = r32 * KROW + hi * 32, vfo = OFF_V + r32 * VROW + hi * 32;
    const unsigned toff = (unsigned)tid * 16u;
    unsigned zz_ = 0u; asm volatile("" : "+v"(zz_));
    u32x4 sk, sv = {zz_, zz_, zz_, zz_};
#define LDK(t) (sk = *(const u32x4*)(K8t + (size_t)(t) * 8192 + toff))
#define LDV(t) do { if (vth) sv = *(const u32x4*)(VTt + (size_t)(t) * 4096 + toff); } while (0)
#define WRK(s) (*(LAS u32x4*)(lds + (s) * SLOT_K + kst) = sk)
#define WRV(s) do { if (vth) *(LAS u32x4*)(lds + (s) * SLOT_V + vst) = sv; } while (0)
    LDK(0); LDV(0); WRK(0); WRV(0); if (1 < ntile) { LDK(1); WRK(1); } if (2 < ntile) LDK(2); if (1 < ntile) LDV(1);
    if (tid < 320) *(LAS u32x4*)(lds + OFF_V + 2 * SLOT_V + tid * 16) = (u32x4){zz_, zz_, zz_, zz_};
    __syncthreads();
    f32x16 pX0, pX1, pY0, pY1; i32x8 paX, paY = {};
    i32x8 kc0, kc1;
    { const LAS char* kb = lds + kfo; const f32x16 z = {};
      kc0 = ld32(kb); kc1 = ld32(kb + 32 * KROW); pX0 = MFZ(kc0, qX[0], pX0); pX1 = MFZ(kc1, qX[0], pX1);
      { const i32x8 k0 = ld32(kb + 64), k1 = ld32(kb + 32 * KROW + 64); pX0 = MF(k0, qX[1], pX0); pX1 = MF(k1, qX[1], pX1); } }
    int s0 = 0, s1 = 1, s2 = 2;
    for (int t = 0; t < ntile; ++t) {
        if constexpr (VAR != 4) __syncthreads();
        i32x8 w0, w1;
        {   const LAS char* vb = lds + s2 * SLOT_V + vfo; const LAS char* kb = lds + s0 * SLOT_K + kfo; const LAS char* vb2 = lds + s0 * SLOT_V + vfo; const f32x16 z = {};
            float ps = 0.f; SB0();
            pY0 = MFZ(kc0, qY[0], pY0); const i32x8 k2 = ld32(kb + 64);
            if (t + 2 < ntile) WRK(s2); if (t + 1 < ntile) WRV(s1);
            if (t + 3 < ntile) LDK(t + 3); if (t + 2 < ntile) LDV(t + 2);
            SM_CHUNK(pX0, pX1, paX, ps, 0); SB0();
            pY1 = MFZ(kc1, qY[0], pY1); const i32x8 k3 = ld32(kb + 32 * KROW + 64);
            SM_CHUNK(pX0, pX1, paX, ps, 1); SB0();
            pY0 = MF(k2, qY[1], pY0); const i32x8 v0 = ld32(vb);
            SM_CHUNK(pX0, pX1, paX, ps, 2); SB0();
            pY1 = MF(k3, qY[1], pY1); const i32x8 v1 = ld32(vb + 32 * VROW);
            SM_CHUNK(pX0, pX1, paX, ps, 3); SB0();
            oY[0] = MF(paY, v0, oY[0]); w0 = ld32(vb2); oY[1] = MF(paY, v1, oY[1]); w1 = ld32(vb2 + 32 * VROW);
            SM_FIN(ps, lX, pX0, pX1, paX, mX, oX, qX[1], wsf, t == 0); SB0();
        }
        {   const LAS char* kb = lds + s1 * SLOT_K + kfo; const f32x16 z = {};
            float ps = 0.f; SB0();
            oX[0] = MF(paX, w0, oX[0]); kc0 = ld32(kb);
            SM_CHUNK(pY0, pY1, paY, ps, 0); SB0();
            oX[1] = MF(paX, w1, oX[1]); kc1 = ld32(kb + 32 * KROW);
            SM_CHUNK(pY0, pY1, paY, ps, 1); SB0();
            pX0 = MFZ(kc0, qX[0], pX0); const i32x8 k2 = ld32(kb + 64);
            SM_CHUNK(pY0, pY1, paY, ps, 2); SB0();
            pX1 = MFZ(kc1, qX[0], pX1); const i32x8 k3 = ld32(kb + 32 * KROW + 64);
            SM_CHUNK(pY0, pY1, paY, ps, 3); SB0();
            pX0 = MF(k2, qX[1], pX0); pX1 = MF(k3, qX[1], pX1);
            SM_FIN(ps, lY, pY0, pY1, paY, mY, oY, qY[1], wsf + 32, t == 0); SB0();
        }
        { const int ts = s0; s0 = s1; s1 = s2; s2 = ts; }
    }
    { const LAS char* vb = lds + s2 * SLOT_V + vfo; const i32x8 v0 = ld32(vb), v1 = ld32(vb + 32 * VROW); oY[0] = MF(paY, v0, oY[0]); oY[1] = MF(paY, v1, oY[1]); }
#undef LDK
#undef LDV
#undef WRK
#undef WRV
    if (hi == 0) { wsf[64 + r32] = lX; wsf[96 + r32] = lY; } asm volatile("s_waitcnt lgkmcnt(0)" ::: "memory");
    LAS bf16_t* stg = (LAS bf16_t*)(lds + OFF_OST) + wid * 4096;
#pragma unroll
    for (int r = 0; r < 16; ++r) { const int orow = crow(r, hi); const float rx = __builtin_amdgcn_rcpf(wsf[64 + orow]), ry = __builtin_amdgcn_rcpf(wsf[96 + orow]);
#pragma unroll
        for (int d0 = 0; d0 < 2; ++d0) { stg[orow * 64 + d0 * 32 + r32] = (bf16_t)(cvt_pk_bf16(oX[d0][r] * rx, 0.f) & 0xffffu); stg[(32 + orow) * 64 + d0 * 32 + r32] = (bf16_t)(cvt_pk_bf16(oY[d0][r] * ry, 0.f) & 0xffffu); } }
    asm volatile("s_waitcnt lgkmcnt(0)" ::: "memory");
#pragma unroll
    for (int i = 0; i < 8; ++i) { const int row = i * 8 + (lane >> 3), ch = lane & 7; const u32x4 v = *(const LAS u32x4*)(stg + row * 64 + ch * 8);
        if (wid * 64 + row < nvalid) *(u32x4*)((char*)Ob + (unsigned)(((wid * 64 + row) * ldo + ch * 8) * 2)) = v; }
    asm volatile("s_waitcnt lgkmcnt(0)" ::: "memory"); __builtin_amdgcn_s_setprio(0); __syncthreads();
}
#undef SB0
#undef MF
#undef MFZ
#undef ATT_EXP
#undef SM_CHUNK
#undef SM_FIN
#undef MFMA8
}

namespace dft {
__device__ __forceinline__ int v_st8(int k, int c) { const int kk = (k & ~0xC) | ((k & 4) << 1) | ((k & 8) >> 1); return ((kk >> 3) * 8 + (c >> 5)) * 512 + ((kk & 7) * 32 + (c & 31)) * 2; }
template <int MODE, int K>
__device__ __forceinline__ void unit(LAS char* lds, const bf16_t* __restrict__ F, const char* __restrict__ in, size_t in_stride, char* __restrict__ dst, int p0, int p1, const int tid) {
    const int wid = __builtin_amdgcn_readfirstlane(tid >> 6), lane = tid & 63, r32 = lane & 31, hi = lane >> 5;
    { constexpr int NJ = K / 16; bf16x8 v[NJ];
#pragma unroll
      for (int j = 0; j < NJ; ++j) v[j] = *reinterpret_cast<const bf16x8*>(in + (size_t)((tid >> 5) + 16 * j) * in_stride + (tid & 31) * 16);
#pragma unroll
      for (int j = 0; j < NJ; ++j) *(LAS bf16x8*)(lds + v_st8((tid >> 5) + 16 * j, (tid & 31) * 8)) = v[j];
    }
    __syncthreads();
    f32x16 acc[8];
#pragma unroll
    for (int d = 0; d < 8; ++d) acc[d] = f32x16{};
    const int vb0 = (int)(uintptr_t)lds + att::v_rd_base(lane);
    const bf16_t* Fw = F + (size_t)(wid * 32 + r32) * K + hi * 8;
#pragma unroll 1
    for (int ks = 0; ks < K / 16; ++ks) {
        const bf16x8 a = *reinterpret_cast<const bf16x8*>(Fw + ks * 16);
        const int vb = vb0 + ks * 8192;
        {   s16x4 lo[4], hh[4];
            lo[0] = att::tr_read<0 * 512>(vb); hh[0] = att::tr_read<0 * 512 + 4096>(vb); lo[1] = att::tr_read<1 * 512>(vb); hh[1] = att::tr_read<1 * 512 + 4096>(vb);
            lo[2] = att::tr_read<2 * 512>(vb); hh[2] = att::tr_read<2 * 512 + 4096>(vb); lo[3] = att::tr_read<3 * 512>(vb); hh[3] = att::tr_read<3 * 512 + 4096>(vb);
            asm volatile("s_waitcnt lgkmcnt(0)" ::: "memory"); __builtin_amdgcn_sched_barrier(0);
#pragma unroll
            for (int d = 0; d < 4; ++d) { const bf16x8 b = (bf16x8){lo[d][0], lo[d][1], lo[d][2], lo[d][3], hh[d][0], hh[d][1], hh[d][2], hh[d][3]};
                acc[d] = __builtin_amdgcn_mfma_f32_32x32x16_bf16(a, b, acc[d], 0, 0, 0); } }
        {   s16x4 lo[4], hh[4];
            lo[0] = att::tr_read<4 * 512>(vb); hh[0] = att::tr_read<4 * 512 + 4096>(vb); lo[1] = att::tr_read<5 * 512>(vb); hh[1] = att::tr_read<5 * 512 + 4096>(vb);
            lo[2] = att::tr_read<6 * 512>(vb); hh[2] = att::tr_read<6 * 512 + 4096>(vb); lo[3] = att::tr_read<7 * 512>(vb); hh[3] = att::tr_read<7 * 512 + 4096>(vb);
            asm volatile("s_waitcnt lgkmcnt(0)" ::: "memory"); __builtin_amdgcn_sched_barrier(0);
#pragma unroll
            for (int d = 0; d < 4; ++d) { const bf16x8 b = (bf16x8){lo[d][0], lo[d][1], lo[d][2], lo[d][3], hh[d][0], hh[d][1], hh[d][2], hh[d][3]};
                acc[4 + d] = __builtin_amdgcn_mfma_f32_32x32x16_bf16(a, b, acc[4 + d], 0, 0, 0); } }
    }
    if (MODE == 0) {
#pragma unroll
        for (int g = 0; g < 2; ++g)
#pragma unroll
            for (int i = 0; i < 4; ++i) { const int k1 = 16 * wid + 8 * g + 4 * hi + i; float sn, cs; sincospif((float)(k1 * p1) * (1.0f / 8192.0f), &sn, &cs);
#pragma unroll
                for (int d = 0; d < 8; ++d) { const float yr = acc[d][8 * g + i], yi = acc[d][8 * g + 4 + i]; acc[d][8 * g + i] = yr * cs + yi * sn; acc[d][8 * g + 4 + i] = yi * cs - yr * sn; } }
    }
    __syncthreads();
    LAS bf16_t* stg = (LAS bf16_t*)lds + wid * 8192;
#pragma unroll
    for (int r = 0; r < 16; ++r) { const int orow = att::crow(r, hi);
#pragma unroll
        for (int d = 0; d < 8; ++d) stg[orow * 256 + d * 32 + r32] = (bf16_t)(cvt_pk_bf16(acc[d][r], 0.f) & 0xffffu); }
    asm volatile("s_waitcnt lgkmcnt(0)" ::: "memory");
#pragma unroll
    for (int it = 0; it < 16; ++it) { const int id = it * 64 + lane, rho = id >> 5, ch = id & 31; const u32x4 v = *(const LAS u32x4*)(stg + rho * 256 + ch * 8);
        size_t off;
        if (MODE == 0) { const int part = (rho >> 3) & 1, k1 = 16 * wid + (((rho >> 4) << 3) | (rho & 7)); off = ((((size_t)p0 * 128 + k1) * 128 + p1) * 2 + part) * 512; }
        else if (MODE == 1) { const int m = wid * 32 + rho, zp = m >> 7, k2 = m & 127; off = ((size_t)(p0 * SEQ + p1 + 128 * k2) * NINP + 256 + zp * 256) * 2; }
        else { const int m = wid * 32 + rho; off = ((size_t)(TL + p0 * CTXL + m) * NINP + 256 + p1 * 256) * 2; }
        *(u32x4*)(dst + off + ch * 16) = v; }
    asm volatile("s_waitcnt lgkmcnt(0)" ::: "memory"); __syncthreads();
}
}


#ifndef SELFCHECK
#define SELFCHECK 0
#endif
#ifndef SELFCHECK_REPORT
#define SELFCHECK_REPORT 1
#endif
#if SELFCHECK
constexpr int CW_CHK = 64;
__device__ __forceinline__ float fp8q(float x) { const unsigned w = __builtin_amdgcn_cvt_pk_fp8_f32(x, 0.f, 0u, false); return __builtin_amdgcn_cvt_f32_fp8((int)w, 0); }
__device__ __forceinline__ float bf2f(bf16_t v) { return __uint_as_float(((unsigned)v) << 16); }
__device__ __forceinline__ float chk_invfreq(int j) { return j == 0 ? 1.0f : j == 1 ? 0.316227766f : j == 2 ? 0.1f : j == 3 ? 0.0316227766f : j == 4 ? 0.01f : j == 5 ? 0.00316227766f : j == 6 ? 0.001f : 0.000316227766f; }
__device__ __forceinline__ void chk_sincos(float a, float& s, float& c) { const float k = rintf(a * 0.15915494309189535f); float r = fmaf(-k, 6.28125f, a); r = fmaf(-k, 1.9353071795864769e-3f, r); s = __sinf(r); c = __cosf(r); }
__device__ __forceinline__ void selfcheck_attn(int l, const bf16_t* Q, const unsigned char* K8, const bf16_t* Vb, const unsigned char* VT8, const bf16_t* YA, const bf16_t* Ub, const bf16_t* WuqT, const bf16_t* WukvT, unsigned* flag, LAS float* sm, int wave_g, int lane) {
    if (wave_g < 32) {
        const int i = wave_g, b = i & 1, h = (i >> 1) & 7, t = (i * 521 + 37 + 4099 * (i >> 4)) & (SEQ - 1); const int row = b * SEQ + t;
        LAS float* q = sm;
        for (int d = lane; d < 96; d += 64) q[d] = bf2f(Q[(size_t)row * 768 + h * 96 + d]);
        __builtin_amdgcn_s_waitcnt(0);
        float nv[2] = {0.f, 0.f};
        if (lane < 16) { const int ax = lane >> 3, j = lane & 7; const float pos = (float)(ax == 0 ? (t >> 6) : (t & 63)); const float ang = pos * chk_invfreq(j);
            float cs, sn; chk_sincos(ang, sn, cs); const float x1 = q[64 + 16 * ax + j], x2 = q[64 + 16 * ax + 8 + j]; nv[0] = x1 * cs - x2 * sn; nv[1] = x2 * cs + x1 * sn; }
        __builtin_amdgcn_s_waitcnt(0);
        if (lane < 16) { const int ax = lane >> 3, j = lane & 7; q[64 + 16 * ax + j] = nv[0]; q[64 + 16 * ax + 8 + j] = nv[1]; }
        __builtin_amdgcn_s_waitcnt(0);
        for (int d = lane; d < 96; d += 64) q[d] = fp8q(q[d] * (0.10206207261596575f * 1.4426950408889634f));
        __builtin_amdgcn_s_waitcnt(0);
        const unsigned char* Kh = K8 + (size_t)(b * NH + h) * LK * 128; const bf16_t* Vh = Vb + (size_t)(b * NH + h) * LK * DV;
        float mx = -1e30f, m0 = -1e30f;
        for (int k0 = 0; k0 < LK; k0 += 64) { const unsigned char* kr = Kh + (size_t)(k0 + lane) * 128; float s = 0.f;
            for (int d = 0; d < 96; d += 4) { const unsigned w = *(const unsigned*)(kr + d);
                s += q[d] * __builtin_amdgcn_cvt_f32_fp8((int)w, 0) + q[d + 1] * __builtin_amdgcn_cvt_f32_fp8((int)w, 1) + q[d + 2] * __builtin_amdgcn_cvt_f32_fp8((int)w, 2) + q[d + 3] * __builtin_amdgcn_cvt_f32_fp8((int)w, 3); }
            mx = fmaxf(mx, s); if (k0 == 0) m0 = s; }
        for (int o = 1; o < 64; o <<= 1) { mx = fmaxf(mx, shx(mx, o, lane)); m0 = fmaxf(m0, shx(m0, o, lane)); }
        const float mref = ceilf(m0); const bool skip = (mx - mref) > 5.9f;
        float acc[64]; float lsum = 0.f;
#pragma unroll
        for (int d = 0; d < 64; ++d) acc[d] = 0.f;
        for (int k0 = 0; k0 < LK; k0 += 64) { const unsigned char* kr = Kh + (size_t)(k0 + lane) * 128; float s = 0.f;
            for (int d = 0; d < 96; d += 4) { const unsigned w = *(const unsigned*)(kr + d);
                s += q[d] * __builtin_amdgcn_cvt_f32_fp8((int)w, 0) + q[d + 1] * __builtin_amdgcn_cvt_f32_fp8((int)w, 1) + q[d + 2] * __builtin_amdgcn_cvt_f32_fp8((int)w, 2) + q[d + 3] * __builtin_amdgcn_cvt_f32_fp8((int)w, 3); }
            const float p = __builtin_amdgcn_exp2f(s - (mref - 2.0f)); lsum += p; const float pq = fp8q(p); const bf16_t* vr = Vh + (size_t)(k0 + lane) * DV;
#pragma unroll
            for (int d = 0; d < 64; ++d) acc[d] += pq * fp8q(bf2f(vr[d])); }
        lsum = wave_sum(lsum, lane);
        float worst = 0.f;
#pragma unroll
        for (int d = 0; d < 64; ++d) { const float o = wave_sum(acc[d], lane) / lsum; const float got = bf2f(YA[(size_t)row * NINP + 768 + h * 64 + d]); worst = fmaxf(worst, fabsf(got - o) - 0.0042f * fabsf(o)); }
        if (skip) worst = 0.f;
        if (lane == 0) atomicMax(flag + 1 + l, (unsigned)(worst * 1.0e6f));
        if (lane == 0 && !(worst < 3e-3f)) atomicOr(flag, 1u << l);
    }
    else if (wave_g < 64) {
        const int i = wave_g - 32, b = i & 1, t = (i * 977 + 13) & (SEQ - 1); const int row = b * SEQ + t, key = CTXL + t;
        unsigned bad = 0;
        if (lane < 32) { const int d = lane, ax = d >> 4, j = d & 7, second = (d >> 3) & 1; const float pos = (float)(ax == 0 ? (t >> 6) : (t & 63)); const float ang = pos * chk_invfreq(j);
            float cs, sn; chk_sincos(ang, sn, cs); const float x1 = bf2f(Ub[(size_t)row * NINP + COL_KR + 16 * ax + j]), x2 = bf2f(Ub[(size_t)row * NINP + COL_KR + 16 * ax + 8 + j]);
            const float ref = second ? x2 * cs + x1 * sn : x1 * cs - x2 * sn; const float rq = fp8q(ref);
            for (int h = 0; h < NH; ++h) { const unsigned char* kr = K8 + ((size_t)(b * NH + h) * LK + key) * 128; const float got = __builtin_amdgcn_cvt_f32_fp8((int)kr[64 + d], 0);
                if (fabsf(got - rq) > 0.13f * fabsf(rq) + 1e-3f) bad |= 1u; if (kr[96 + d] != (d == 0 ? 0x38 : 0)) bad |= 2u; } }
        { const int h = lane & 7, jj = lane >> 3; float ak = 0.f, av = 0.f, aq = 0.f; const int jk = jj & 3; const int qd = (jj < 4) ? jj : 88 + jj;
          for (int k = 0; k < 256; ++k) { const float u = bf2f(Ub[(size_t)row * NINP + COL_KV + k]); ak += u * bf2f(WukvT[(size_t)(h * 128 + 17 * jk) * 256 + k]); av += u * bf2f(WukvT[(size_t)(h * 128 + 64 + 15 * jk) * 256 + k]); }
          for (int k = 0; k < 384; ++k) aq += bf2f(Ub[(size_t)row * NINP + COL_Q + k]) * bf2f(WuqT[(size_t)(h * 96 + qd) * 384 + k]);
          const float gk = __builtin_amdgcn_cvt_f32_fp8((int)K8[((size_t)(b * NH + h) * LK + key) * 128 + 17 * jk], 0), gv = bf2f(Vb[((size_t)(b * NH + h) * LK + key) * DV + 15 * jk]), gq = bf2f(Q[(size_t)row * 768 + h * 96 + qd]);
          if (fabsf(gk - ak) > 0.08f * fabsf(ak) + 0.02f) bad |= 4u; if (fabsf(gv - av) > 0.02f * fabsf(av) + 0.01f) bad |= 8u; if (fabsf(gq - aq) > 0.02f * fabsf(aq) + 0.01f) bad |= 16u;
          const int tl = key >> 6, kin = key & 63, kk = kin & 31, khi = (kk >> 2) & 1, kr_ = (kk & 3) + 4 * (kk >> 3), kpos = khi * 32 + (kin >> 5) * 16 + kr_;
          const float gt = __builtin_amdgcn_cvt_f32_fp8((int)VT8[((size_t)(b * NH + h) * 260 + tl) * 4096 + (15 * jk) * 64 + kpos], 0);
          if (gt != fp8q(gv)) bad |= 32u; }
        if (bad) atomicOr(flag, bad << (8 + 8 * l));
    }
}
#endif
__device__ __forceinline__ void tr_item(const float* __restrict__ W, int ldS, const float* __restrict__ rs, bf16_t* __restrict__ WT, int ldD, int col0D, int nblk, int rowmode, LAS float* scr, int item, int lane, float f8scale = 0.f) {
    const int kb = item / nblk, nb = item % nblk, k0 = 64 * kb, n0 = 32 * nb;
#pragma unroll
    for (int i = 0; i < 32; ++i) { const int kk = 2 * i + (lane >> 5); float v = W[(size_t)(k0 + kk) * ldS + n0 + (lane & 31)]; if (rs) v *= rs[k0 + kk]; scr[kk * 33 + (lane & 31)] = v; }
    LDS_WAIT(); asm volatile("" ::: "memory");
    const int c = lane & 7;
#pragma unroll
    for (int j = 0; j < 4; ++j) { const int n = (lane >> 3) + 8 * j; const LAS float* s = scr + (8 * c) * 33 + n;
        u32x4 o; o.x = cvt_pk_bf16(s[0 * 33], s[1 * 33]); o.y = cvt_pk_bf16(s[2 * 33], s[3 * 33]); o.z = cvt_pk_bf16(s[4 * 33], s[5 * 33]); o.w = cvt_pk_bf16(s[6 * 33], s[7 * 33]);
        const int ns = n0 + n; const int nd = rowmode == 0 ? ns : (8 * (ns >> 2) + (ns & 3) + (rowmode == 2 ? 4 : 0));
        if (f8scale != 0.f) { u32x2 o8; o8.x = pk4_fp8(s[0 * 33] * f8scale, s[1 * 33] * f8scale, s[2 * 33] * f8scale, s[3 * 33] * f8scale); o8.y = pk4_fp8(s[4 * 33] * f8scale, s[5 * 33] * f8scale, s[6 * 33] * f8scale, s[7 * 33] * f8scale);
            *(u32x2*)((unsigned char*)WT + (size_t)nd * ldD + col0D + k0 + 8 * c) = o8; }
        else *(u32x4*)(WT + (size_t)nd * ldD + col0D + k0 + 8 * c) = o; }
    LDS_WAIT(); asm volatile("" ::: "memory");
}

struct TrDesc { const float* W; unsigned char* WT; int ldS, ldD, rowmode, k0, n0; float sc; };
__device__ __forceinline__ void tr8_load(const TrDesc& d, float (&v)[32], int lane) {
    unsigned off = (unsigned)((d.k0 + (lane >> 5)) * d.ldS + d.n0 + (lane & 31)) * 4u; const unsigned step = (unsigned)d.ldS * 8u;
#pragma unroll
    for (int i = 0; i < 32; ++i) { v[i] = __builtin_nontemporal_load((const float*)((const char*)d.W + off)); off += step; }
}
__device__ __forceinline__ void tr8_store(const TrDesc& d, const float (&v)[32], LAS float* scr, int lane) {
#pragma unroll
    for (int i = 0; i < 32; ++i) scr[(2 * i + (lane >> 5)) * 33 + (lane & 31)] = v[i];
    LDS_WAIT(); asm volatile("" ::: "memory");
    const int c = lane & 7;
#pragma unroll
    for (int j = 0; j < 4; ++j) { const int n = (lane >> 3) + 8 * j; const LAS float* s = scr + (8 * c) * 33 + n;
        const int ns = d.n0 + n; const int nd = d.rowmode == 0 ? ns : (8 * (ns >> 2) + (ns & 3) + (d.rowmode == 2 ? 4 : 0));
        u32x2 o8; o8.x = pk4_fp8(s[0 * 33] * d.sc, s[1 * 33] * d.sc, s[2 * 33] * d.sc, s[3 * 33] * d.sc); o8.y = pk4_fp8(s[4 * 33] * d.sc, s[5 * 33] * d.sc, s[6 * 33] * d.sc, s[7 * 33] * d.sc);
        *(u32x2*)(d.WT + (unsigned)(nd * d.ldD + d.k0 + 8 * c)) = o8; }
    LDS_WAIT(); asm volatile("" ::: "memory");
}

struct Params { const float* in[26]; float* out; unsigned char* ws; int ph_lo, ph_hi, use_bar, pad; };
constexpr int NPH_L = 15, NPHASE = 2 + 2 * NPH_L;

template <bool XB16 = false>
__device__ __forceinline__ void norm_rows(const void* __restrict__ xin_, bf16_t* __restrict__ hout, const float* __restrict__ g, const float* __restrict__ sh, const float* __restrict__ sc, int nrows, int lane, unsigned char* __restrict__ h8 = nullptr) {
    f32x4 gm[4], sv[4];
#pragma unroll
    for (int j = 0; j < 4; ++j) { const f32x4 gv = *(const f32x4*)(g + 4 * lane + 256 * j), s1 = *(const f32x4*)(sc + 4 * lane + 256 * j); gm[j] = gv * (s1 + 1.0f); sv[j] = *(const f32x4*)(sh + 4 * lane + 256 * j); }
    for (int r = 0; r < nrows; r += 2) {
        f32x4 v0[4], v1[4]; float s0 = 0.f, s1 = 0.f;
        if constexpr (XB16) { const u32x2* xr0 = (const u32x2*)((const bf16_t*)xin_ + (size_t)r * DM) + lane; const u32x2* xr1 = xr0 + DM / 4;
#pragma unroll
            for (int j = 0; j < 4; ++j) { const u32x2 a = xr0[64 * j], b = xr1[64 * j]; v0[j] = (f32x4){bf_lo(a.x), bf_hi(a.x), bf_lo(a.y), bf_hi(a.y)}; v1[j] = (f32x4){bf_lo(b.x), bf_hi(b.x), bf_lo(b.y), bf_hi(b.y)}; } }
        else { const f32x4* xr0 = (const f32x4*)((const float*)xin_ + (size_t)r * DM) + lane; const f32x4* xr1 = xr0 + DM / 4;
#pragma unroll
            for (int j = 0; j < 4; ++j) { v0[j] = xr0[64 * j]; v1[j] = xr1[64 * j]; } }
#pragma unroll
        for (int j = 0; j < 4; ++j) { s0 += (v0[j].x * v0[j].x + v0[j].y * v0[j].y) + (v0[j].z * v0[j].z + v0[j].w * v0[j].w); s1 += (v1[j].x * v1[j].x + v1[j].y * v1[j].y) + (v1[j].z * v1[j].z + v1[j].w * v1[j].w); }
        const float rstd0 = rsqrtf(wave_sum(s0, lane) * (1.0f / DM) + EPS), rstd1 = rsqrtf(wave_sum(s1, lane) * (1.0f / DM) + EPS);
        u32x2* o0 = (u32x2*)(hout + (size_t)r * DM) + lane; u32x2* o1 = o0 + DM / 4;
#pragma unroll
        for (int j = 0; j < 4; ++j) { const f32x4 y0 = v0[j] * rstd0 * gm[j] + sv[j], y1 = v1[j] * rstd1 * gm[j] + sv[j]; u32x2 w0, w1; w0.x = cvt_pk_bf16(y0.x, y0.y); w0.y = cvt_pk_bf16(y0.z, y0.w); w1.x = cvt_pk_bf16(y1.x, y1.y); w1.y = cvt_pk_bf16(y1.z, y1.w); o0[64 * j] = w0; o1[64 * j] = w1;
            if (h8) { ((unsigned*)(h8 + (size_t)r * DM))[lane + 64 * j] = pk4_fp8(y0.x, y0.y, y0.z, y0.w); ((unsigned*)(h8 + (size_t)(r + 1) * DM))[lane + 64 * j] = pk4_fp8(y1.x, y1.y, y1.z, y1.w); } }
    }
}

#define PHASE_BEGIN unsigned zo_ = 0; int z_ = 0; int tid; asm volatile("v_mbcnt_lo_u32_b32 %0, -1, 0\n\tv_mbcnt_hi_u32_b32 %0, -1, %0" : "=v"(tid)); tid += wave0_ * 64; int bx = blockIdx.x; int G = gridDim.x; LAS unsigned char* ldsp = lds; asm volatile("" : "+s"(zo_), "+s"(z_), "+v"(tid), "+s"(bx), "+s"(G), "+s"(ldsp)); \
    zo_ = (unsigned)__builtin_amdgcn_readfirstlane((int)zo_); z_ = __builtin_amdgcn_readfirstlane(z_); bx = __builtin_amdgcn_readfirstlane(bx); G = __builtin_amdgcn_readfirstlane(G); ldsp = (LAS unsigned char*)(unsigned)__builtin_amdgcn_readfirstlane((int)(unsigned)(uintptr_t)ldsp);     \
    (void)ldsp; unsigned char* wsp = P.ws + zo_; \
    const int lane = tid & 63, wave = __builtin_amdgcn_readfirstlane(tid >> 6); const int vcu = (G % 8 == 0) ? (bx % 8) * (G / 8) + bx / 8 : bx; const int gw = vcu * 8 + wave, NGW = G * 8; (void)lane; (void)wave; (void)vcu; (void)gw; (void)NGW
#define INP(k) (P.in[(k) + z_])
#define CV_NIT (NEX * 384)
#define CV_ON (G == 256)
#define CV_Q6 8
#define CV_Q8 7
#define CV_A (CV_ON ? 248 * 8 * CV_Q6 : 0)
#define CV_B (CV_ON ? CV_NIT - 126 * 8 * CV_Q8 : CV_NIT)
#define TR_DESC(D, it_) do { const int e_ = (it_) / 384, r_ = (it_) % 384, q_ = r_ & 127; \
                if (r_ < 128) { D.W = e_ < NE ? INP(19) + ((size_t)l * NE + e_) * DM * DE : INP(22) + (size_t)l * DM * DE; D.WT = P_EWGU8 + (size_t)e_ * 512 * 1024; D.ldS = DE; D.ldD = DM; D.rowmode = 1; D.k0 = 64 * (q_ >> 3); D.n0 = 32 * (q_ & 7); D.sc = 32.0f; } \
                else if (r_ < 256) { D.W = e_ < NE ? INP(20) + ((size_t)l * NE + e_) * DM * DE : INP(23) + (size_t)l * DM * DE; D.WT = P_EWGU8 + (size_t)e_ * 512 * 1024; D.ldS = DE; D.ldD = DM; D.rowmode = 2; D.k0 = 64 * (q_ >> 3); D.n0 = 32 * (q_ & 7); D.sc = 32.0f; } \
                else { D.W = e_ < NE ? INP(21) + ((size_t)l * NE + e_) * DE * DM : INP(24) + (size_t)l * DE * DM; D.WT = (unsigned char*)P_EWD + (size_t)e_ * 1024 * 256; D.ldS = DM; D.ldD = DE; D.rowmode = 0; D.k0 = 64 * (q_ >> 5); D.n0 = 32 * (q_ & 31); D.sc = 16.0f; } } while (0)
#define CONVERT_ITEMS(first_, step_, end_) do { int it = (first_); const int st_ = (step_), en_ = (end_);     \
                if (it < en_) { TrDesc d0, d1; float va[32], vb[32]; TR_DESC(d0, it); d1 = d0; \
                    { const float zf_ = (float)z_;                  \
                      _Pragma("unroll") for (int i = 0; i < 32; ++i) vb[i] = zf_; } \
                    tr8_load(d0, va, lane); \
                    for (;;) { \
                        const int it1 = it + st_; const bool h1 = it1 < en_; if (h1) { TR_DESC(d1, it1); tr8_load(d1, vb, lane); } \
                        tr8_store(d0, va, scr, lane); if (!h1) break; \
                        const int it2 = it1 + st_; const bool h2 = it2 < en_; if (h2) { TR_DESC(d0, it2); tr8_load(d0, va, lane); } \
                        tr8_store(d1, vb, scr, lane); if (!h2) break; \
                        it = it2; } } } while (0)
#define P_MODS ((float*)(wsp + WS_MODS))
#define P_XS ((bf16_t*)(wsp + WS_XS))
#define P_HQ ((bf16_t*)(wsp + WS_HQ))
#define P_U ((bf16_t*)(wsp + WS_U))
#define P_KB ((bf16_t*)(wsp + WS_KB))
#define P_VB ((bf16_t*)(wsp + WS_VB))
#define P_YA ((bf16_t*)(wsp + WS_YA))
#define P_YP ((bf16_t*)(wsp + WS_YP))
#define P_K8 ((unsigned char*)(wsp + WS_KB))
#define P_VT8 ((unsigned char*)(wsp + WS_VT8))
#define P_EWGU ((bf16_t*)(wsp + WS_EW))
#define P_EWD ((bf16_t*)(wsp + WS_EW + EW_GU_BYTES))
#define P_EWGU8 ((unsigned char*)(wsp + WS_EW))
#define P_H2F8 ((unsigned char*)(wsp + WS_EW + EW_GU_BYTES / 2))
#define P_ACT ((bf16_t*)(wsp + WS_ACT))
#define P_TOKL ((int*)(wsp + WS_TOKL))
#define P_TPOS ((int*)(wsp + WS_TPOS))
#define P_TW ((float*)(wsp + WS_TW))
#define P_LOG ((float*)(wsp + WS_LOG))
#define P_YB ((bf16_t*)(wsp + WS_YB))
#define P_F1 ((bf16_t*)(wsp + WS_F1))
#define P_F2 ((bf16_t*)(wsp + WS_F2))
#define P_FC ((bf16_t*)(wsp + WS_FC))
#define P_WCS ((float*)(wsp + WS_WCS))
#define P_DW(l) (wsp + WS_DW + (size_t)(l) * DW_LAYER)
#define P_GCNT(l) ((unsigned*)(wsp + WS_CTL) + CW_CNT + (l) * 64)

__global__ void __launch_bounds__(512, 2) mk_fwd(Params P) {
    extern __shared__ __attribute__((aligned(16))) unsigned char lds_raw[];
    LAS unsigned char* lds = (LAS unsigned char*)lds_raw;
    const int wave0_ = __builtin_amdgcn_readfirstlane((int)threadIdx.x >> 6);
    volatile LAS unsigned* MISC = (volatile LAS unsigned*)(lds + MISC_OFF);
    for (int u = threadIdx.x; u < 128; u += 512) MISC[u] = 0u;
    __syncthreads();
    XcdBarrier bar; bar.bar = (unsigned*)(P.ws + WS_CTL) + CW_BAR; bar.x = 0; bar.st = nullptr;
    if (P.use_bar) bar = xcd_barrier_post((unsigned*)(P.ws + WS_CTL) + CW_BAR, MISC + 8);
    const int lo = P.ph_lo, hi = P.ph_hi;
#define IN(k) ({ int lo_ = lo; asm volatile("" : "+s"(lo_)); lo_ = __builtin_amdgcn_readfirstlane(lo_); (lo_ <= (k) && (k) < hi); })
#define SEAM(k) do { if (IN(k) && IN((k) + 1)) { XcdBarrier bb_ = bar; unsigned zb_ = 0; int t0_; asm volatile("v_mbcnt_lo_u32_b32 %0, -1, 0\n\tv_mbcnt_hi_u32_b32 %0, -1, %0" : "=v"(t0_)); t0_ += wave0_ * 64; asm volatile("" : "+s"(zb_), "+s"(bb_.x)); zb_ = (unsigned)__builtin_amdgcn_readfirstlane((int)zb_); bb_.x = (unsigned)__builtin_amdgcn_readfirstlane((int)bb_.x); bb_.bar = (unsigned*)(P.ws + WS_CTL + zb_) + CW_BAR; for (int rb_ = 0; rb_ < REP_BAR; ++rb_) xcd_barrier(bb_, t0_); } } while (0)

    if (IN(0)) for (int rep_ = 0; rep_ < REP_PRO; ++rep_) {
        PHASE_BEGIN;
        {
            LAS float* sl = (LAS float*)lds;
            const float* c_in = INP(1); const float* cctx_in = INP(3);
            for (int i = tid; i < 3 * DM; i += 512) { const int v = i >> 10, d = i & 1023; const float cv = v < 2 ? c_in[v * DM + d] : cctx_in[d]; sl[i] = silu_f(cv); }
            __syncthreads();
            LAS float* red = sl + 3 * DM;
            for (int it = vcu; it < 192; it += G) {
                const int l = it / 96, n = (it % 96) * 64 + lane; const float* w = INP(4) + (size_t)l * DM * 6144 + n;
                float a0 = 0.f, a1 = 0.f, a2 = 0.f;
#pragma unroll 8
                for (int d = wave * 128; d < wave * 128 + 128; ++d) { const float wv = __builtin_nontemporal_load(w + (size_t)d * 6144); a0 += sl[d] * wv; a1 += sl[DM + d] * wv; a2 += sl[2 * DM + d] * wv; }
                red[(wave * 3 + 0) * 64 + lane] = a0; red[(wave * 3 + 1) * 64 + lane] = a1; red[(wave * 3 + 2) * 64 + lane] = a2;
                __syncthreads();
                if (wave < 3) { float s = 0.f;
#pragma unroll
                    for (int w8 = 0; w8 < 8; ++w8) s += red[(w8 * 3 + wave) * 64 + lane];
                    P_MODS[(l * 3 + wave) * 6144 + n] = s + INP(5)[l * 6144 + n]; }
                __syncthreads();
            }
            __syncthreads();
        }
        {
            LAS float* scr = (LAS float*)(lds + wave * 16384);
            constexpr int I_IN = 16 * 37, I_UQ = 6 * 24, I_UKV = 4 * 32, I_OUT = 8 * 32, I_R = 16 * 2, I_L = I_IN + I_UQ + I_UKV + I_OUT + I_R;
            for (int it = gw; it < 2 * I_L; it += NGW) {
                const int l = it / I_L; int r = it % I_L; unsigned char* dw = P_DW(l);
                if (r < I_IN) { tr_item(INP(8) + (size_t)l * DM * 1184, 1184, nullptr, (bf16_t*)(dw + DW_WIN), DM, 0, 37, 0, scr, r, lane); continue; } r -= I_IN;
                if (r < I_UQ) { tr_item(INP(13) + (size_t)l * 384 * 768, 768, INP(12) + l * 384, (bf16_t*)(dw + DW_WUQ), 384, 0, 24, 0, scr, r, lane); continue; } r -= I_UQ;
                if (r < I_UKV) { tr_item(INP(15) + (size_t)l * 256 * 1024, 1024, INP(14) + l * 256, (bf16_t*)(dw + DW_WUKV), 256, 0, 32, 0, scr, r, lane); continue; } r -= I_UKV;
                if (r < I_OUT) { tr_item(INP(16) + (size_t)l * DM * DM + (size_t)512 * DM, DM, nullptr, (bf16_t*)(dw + DW_WCOMB), NINP, 768, 32, 0, scr, r, lane); continue; } r -= I_OUT;
                tr_item(INP(17) + (size_t)l * DM * NE, NE, nullptr, (bf16_t*)(dw + DW_WR), DM, 0, 2, 0, scr, r, lane);
            }
            for (int l = 0; l < 2; ++l) {
                u32x4* z1 = (u32x4*)(P_DW(l) + DW_WIN + (size_t)1184 * DM * 2); const int n1 = 96 * DM * 2 / 16;
                for (int i = bx * 512 + tid; i < n1; i += G * 512) z1[i] = (u32x4){(unsigned)z_, (unsigned)z_, (unsigned)z_, (unsigned)z_};
                u32x4* z2 = (u32x4*)(P_DW(l) + DW_WR + (size_t)64 * DM * 2); const int n2 = 192 * DM * 2 / 16;
                for (int i = bx * 512 + tid; i < n2; i += G * 512) z2[i] = (u32x4){(unsigned)z_, (unsigned)z_, (unsigned)z_, (unsigned)z_};
            }
        }
        { bf16_t* F1 = P_F1; bf16_t* F2 = P_F2; bf16_t* FC = P_FC;
        for (int i = bx * 512 + tid; i < 256 * 128; i += G * 512) { const int m = i >> 7, l1 = i & 127, w = m >> 5, rho = m & 31, part = (rho >> 3) & 1, k1 = 16 * w + (((rho >> 4) << 3) | (rho & 7));
            float sn, cs; sincospif((float)((k1 * l1) & 127) * (1.0f / 64.0f), &sn, &cs); const float v = (part ? -sn : cs) * (1.0f / 128.0f); F1[i] = (bf16_t)(cvt_pk_bf16(v, 0.f) & 0xffffu); }
        for (int i = bx * 512 + tid; i < 256 * 256; i += G * 512) { const int m = i >> 8, j = i & 255, zp = m >> 7, k2 = m & 127, l2 = j >> 1, part = j & 1;
            float sn, cs; sincospif((float)((k2 * l2) & 127) * (1.0f / 64.0f), &sn, &cs); const float v = zp == 0 ? (part ? sn : cs) : (part ? cs : -sn); F2[i] = (bf16_t)(cvt_pk_bf16(v, 0.f) & 0xffffu); }
        for (int i = bx * 512 + tid; i < 512 * 256; i += G * 512) { const int m = i >> 8, l = i & 255, zp = m >> 8, k = m & 255;
            float sn, cs; sincospif((float)((k * l) & 255) * (1.0f / 128.0f), &sn, &cs); const float v = (zp ? -sn : cs) * (1.0f / 16.0f); FC[i] = (bf16_t)(cvt_pk_bf16(v, 0.f) & 0xffffu); } }
        for (int i = bx * 512 + tid; i < 2 * 2 * 4 * 64 * 64; i += G * 512) { const int d = i & 63, c = (i >> 6) & 63, g = (i >> 12) & 3, cs_ = (i >> 14) & 1, l = i >> 15;
            const float* wf = INP(11) + (size_t)(l * 4 + g) * 4096 + d; float a = 0.f;
            for (int m = 0; m < 64; ++m) { float sn, cs; sincospif((float)((m * c) & 63) * (1.0f / 32.0f), &sn, &cs); a += (cs_ ? sn : cs) * wf[m * 64]; }
            P_WCS[i] = a * 0.125f; }
    }
    SEAM(0);

#pragma unroll 1
    for (int l = 0; l < 2; ++l) {
        const int pb = 1 + l * NPH_L;
        const int RL = l == 0 ? RT : TL;

        for (int grp_ = 0; grp_ < GRP_MIX; ++grp_) {
        if (IN(pb + 0)) for (int rep_ = 0; rep_ < REP_NORM; ++rep_) {
            PHASE_BEGIN;
            const float* mods = P_MODS + (size_t)l * 3 * 6144;
            const float* xlat = INP(0); const float* xctx = INP(2);
            if (l == 0)
            for (int ch = gw; ch < RT / 16; ch += NGW) { const int r0 = ch * 16; const int vec = r0 < SEQ ? 0 : (r0 < TL ? 1 : 2);
                const float* xi = r0 < TL ? xlat + (size_t)r0 * DM : xctx + (size_t)(r0 - TL) * DM;
                norm_rows(xi, P_HQ + (size_t)r0 * DM, INP(6) + l * DM, mods + vec * 6144 + 0, mods + vec * 6144 + DM, 16, lane); }
            if (l == 0) {
                for (int it = gw; it < 2 * 96 * 16; it += NGW) {
                    const int itu = __builtin_amdgcn_readfirstlane(it); const int nch = itu & 15, kb = (itu >> 4) % 96, ll = itu / (96 * 16), k0 = kb * 8, n = nch * 64 + lane;
                    const bool pool = k0 < 256; const int kk = pool ? k0 : k0 - 256, cs_ = pool ? 0 : (kk >> 8), g = (kk >> 6) & 3, c0 = kk & 63;
                    const float* wo = INP(16) + (size_t)ll * DM * DM + (size_t)((pool ? 0 : 256) + g * 64) * DM + n;
                    const float* arow = pool ? INP(9) + (size_t)(ll * 4 + g) * 4096 + c0 * 64 : P_WCS + ((size_t)((ll * 2 + cs_) * 4 + g) * 64 + c0) * 64;
                    const float* ps = INP(10) + ll * 256 + g * 64;
                    float acc[8];
#pragma unroll
                    for (int j = 0; j < 8; ++j) acc[j] = 0.f;
#pragma unroll 4
                    for (int d = 0; d < 64; ++d) { const float wv = wo[(size_t)d * DM]; const float sc_ = pool ? ps[d] : 1.0f;
#pragma unroll
                        for (int j = 0; j < 8; ++j) acc[j] += arow[j * 64 + d] * sc_ * wv; }
                    u32x4 w; w.x = cvt_pk_bf16(acc[0], acc[1]); w.y = cvt_pk_bf16(acc[2], acc[3]); w.z = cvt_pk_bf16(acc[4], acc[5]); w.w = cvt_pk_bf16(acc[6], acc[7]);
                    *(u32x4*)((bf16_t*)(P_DW(ll) + DW_WCOMB) + (size_t)n * NINP + k0) = w;
                }
            }
        }
        if (l == 0 || GRP_MOE > 1 || REP_COMB > 1 || GRP_MIX > 1) SEAM(pb + 0);

        if (IN(pb + 1)) for (int rep_ = 0; rep_ < REP_DENSE; ++rep_) {
            PHASE_BEGIN;
            pg8::DenseSched S; S.init(RT, NINP, G, bx, P_HQ, DM, P_DW(l) + DW_WIN, DM);
            pg8::EpiBf16 E{P_U, NINP, 0};
            pg8::gemm_phase<pg8::EpiBf16, pg8::DenseSched>(lds, DM, S, E, tid);
        }
        SEAM(pb + 1);

        if (IN(pb + 2)) for (int rep_ = 0; rep_ < REP_ROWS; ++rep_) {
            PHASE_BEGIN;
            bf16_t* Ub = P_U; bf16_t* YA = P_YA;
            for (int ch = gw; ch < RT / 16; ch += NGW) {
                const int r0 = ch * 16; const bool isc = r0 >= TL; const int b = isc ? (r0 - TL) >> 8 : r0 >> 14; const int t0 = isc ? (r0 - TL) & (CTXL - 1) : r0 & (SEQ - 1); const int Ls = isc ? CTXL : SEQ;
                const bf16_t* useq = Ub + (size_t)(r0 - t0) * NINP;
                if (l == 0 || !isc) {
                    u32x2 x[32];
#pragma unroll
                    for (int j = 0; j < 32; ++j) { const int tt = t0 - 8 + j; const int tc = tt < 0 ? 0 : (tt >= Ls ? Ls - 1 : tt); x[j] = *(const u32x2*)(useq + (size_t)tc * NINP + lane * 4); if (tt < 0 || tt >= Ls) x[j] = (u32x2){(unsigned)z_, (unsigned)z_}; }
                    const int g = lane >> 4, hw = 1 << g;
                    float res[16][4];
#pragma unroll
                    for (int half = 0; half < 2; ++half) {
                        float p0[33], p1[33]; p0[0] = 0.f; p1[0] = 0.f;
#pragma unroll
                        for (int j = 0; j < 32; ++j) { const unsigned w = half ? x[j].y : x[j].x; p0[j + 1] = p0[j] + bf_lo(w); p1[j + 1] = p1[j] + bf_hi(w); }
#pragma unroll
                        for (int i = 0; i < 16; ++i) { const int c = i + 8;
                            const float a1 = p0[c + 1] - p0[c - 1], a2 = p0[c + 2] - p0[c - 2], a4 = p0[c + 4] - p0[c - 4], a8 = p0[c + 8] - p0[c - 8];
                            const float b1 = p1[c + 1] - p1[c - 1], b2 = p1[c + 2] - p1[c - 2], b4 = p1[c + 4] - p1[c - 4], b8 = p1[c + 8] - p1[c - 8];
                            res[i][2 * half] = g == 0 ? a1 : (g == 1 ? a2 : (g == 2 ? a4 : a8)); res[i][2 * half + 1] = g == 0 ? b1 : (g == 1 ? b2 : (g == 2 ? b4 : b8)); }
                    }
#pragma unroll
                    for (int i = 0; i < 16; ++i) { const int t = t0 + i; const int lo_ = (t - hw) < 0 ? 0 : t - hw, hi_ = (t + hw) > Ls ? Ls : t + hw; const float ic = 1.0f / (float)(hi_ - lo_);
                        const u32x2 me = x[i + 8];
                        u32x2 w; w.x = cvt_pk_bf16(res[i][0] * ic - bf_lo(me.x), res[i][1] * ic - bf_hi(me.x)); w.y = cvt_pk_bf16(res[i][2] * ic - bf_lo(me.y), res[i][3] * ic - bf_hi(me.y));
                        *(u32x2*)(YA + (size_t)(r0 + i) * NINP + lane * 4) = w; }
                }
#pragma unroll 1
                for (int rb = 0; rb < 16; rb += 8) {
                    u32x4 qv[8], kv[8], kr[8]; const int cpc = lane & 3;
#pragma unroll
                    for (int k = 0; k < 8; ++k) { bf16_t* ur = Ub + (size_t)(r0 + rb + k) * NINP;
                        qv[k] = (u32x4){(unsigned)z_, (unsigned)z_, (unsigned)z_, (unsigned)z_}; kv[k] = qv[k];
                        if (lane < 48) qv[k] = *(const u32x4*)(ur + COL_Q + lane * 8);
                        if (lane < 32) kv[k] = *(const u32x4*)(ur + COL_KV + lane * 8);
                        kr[k] = *(const u32x4*)(ur + COL_KR + cpc * 8); }
#pragma unroll
                    for (int k = 0; k < 8; ++k) { const int row = r0 + rb + k, t = t0 + rb + k; bf16_t* ur = Ub + (size_t)row * NINP;
                        float sq = 0.f, sk = 0.f;
#pragma unroll
                        for (int j = 0; j < 4; ++j) { const float a = bf_lo(qv[k][j]), c2 = bf_hi(qv[k][j]); sq += a * a + c2 * c2; const float a2 = bf_lo(kv[k][j]), c3 = bf_hi(kv[k][j]); sk += a2 * a2 + c3 * c3; }
                        const float rq = rsqrtf(wave_sum(sq, lane) * (1.0f / 384.0f) + EPS), rk = rsqrtf(wave_sum(sk, lane) * (1.0f / 256.0f) + EPS);
                        if (lane < 48) { u32x4 w;
#pragma unroll
                            for (int j = 0; j < 4; ++j) w[j] = cvt_pk_bf16(bf_lo(qv[k][j]) * rq, bf_hi(qv[k][j]) * rq);
                            *(u32x4*)(ur + COL_Q + lane * 8) = w; }
                        if (lane < 32) { u32x4 w;
#pragma unroll
                            for (int j = 0; j < 4; ++j) w[j] = cvt_pk_bf16(bf_lo(kv[k][j]) * rk, bf_hi(kv[k][j]) * rk);
                            *(u32x4*)(ur + COL_KV + lane * 8) = w; }
                        const u32x4 mine = kr[k]; u32x4 oth;
#pragma unroll
                        for (int j = 0; j < 4; ++j) oth[j] = (unsigned)shxi((int)mine[j], 1, lane);
                        float f[8];
#pragma unroll
                        for (int j = 0; j < 4; ++j) { f[2 * j] = bf_lo(mine[j]); f[2 * j + 1] = bf_hi(mine[j]); }
                        if (!isc) { const float pos = (float)((cpc >> 1) == 0 ? (t >> 6) : (t & 63)); const bool second = cpc & 1;
#pragma unroll
                            for (int j = 0; j < 4; ++j) {
#pragma unroll
                                for (int q = 0; q < 2; ++q) { const float ang = pos * __powf(10000.0f, -(float)(2 * j + q) * 0.125f); const float sn = __sinf(ang), cs = __cosf(ang);
                                    const float m0 = q ? bf_hi(mine[j]) : bf_lo(mine[j]), o0 = q ? bf_hi(oth[j]) : bf_lo(oth[j]);
                                    f[2 * j + q] = second ? m0 * cs + o0 * sn : m0 * cs - o0 * sn; } } }
                        const int h = (lane >> 2) & 7; const int key = isc ? t : CTXL + t;
                        unsigned char* kd = P_K8 + ((size_t)(b * NH + h) * LK + key) * 128;
                        u32x2 w; w.x = pk4_fp8(f[0], f[1], f[2], f[3]); w.y = pk4_fp8(f[4], f[5], f[6], f[7]);
                        if (lane < 32) *(u32x2*)(kd + 64 + cpc * 8) = w; else *(u32x2*)(kd + 96 + cpc * 8) = (u32x2){(unsigned)z_ + (cpc == 0 ? 0x38u : 0u), (unsigned)z_}; }
                }
            }
        }
        SEAM(pb + 2);

        if (IN(pb + 3)) {
            for (int rep_ = 0; rep_ < REP_DENSE; ++rep_) { PHASE_BEGIN; pg8::DenseSched S; S.init(RL, 768, G, bx, P_U + COL_Q, NINP, P_DW(l) + DW_WUQ, 384);
              pg8::EpiBf16 E{P_HQ, 768, 0};
              pg8::gemm_phase<pg8::EpiBf16, pg8::DenseSched>(lds, 384, S, E, tid); }
            for (int rep_ = 0; rep_ < REP_DENSE; ++rep_) { PHASE_BEGIN; pg8::DenseSched S; S.init(RT, 1024, G, (G == 256) ? ((bx + 120) & 255) : bx, P_U + COL_KV, NINP, P_DW(l) + DW_WUKV, 256);
              pg8::EpiKV E{P_K8, P_VB};
              pg8::gemm_phase<pg8::EpiKV, pg8::DenseSched>(lds, 256, S, E, tid); }
            for (int rep_ = 0; rep_ < REP_FFT; ++rep_) { PHASE_BEGIN;
              for (int u = vcu; u < 256; u += G) { const int b = u >> 7, l2 = u & 127;
                dft::unit<0, 128>((LAS char*)lds, P_F1, (const char*)(P_U + (size_t)(b * SEQ + l2) * NINP + COL_FNO), (size_t)128 * NINP * 2, (char*)P_YP, b, l2, tid); } }
            if (l == 0) { PHASE_BEGIN;
              for (int u = vcu; u < 4; u += G) { const int b = u >> 1, zp = u & 1;
                dft::unit<2, 256>((LAS char*)lds, P_FC + (size_t)zp * 256 * 256, (const char*)(P_U + (size_t)(TL + b * CTXL) * NINP + COL_FNO), (size_t)NINP * 2, (char*)P_YA, b, zp, tid); } }
        }
        SEAM(pb + 3);

        if (IN(pb + 4)) for (int rep_ = 0; rep_ < REP_VT; ++rep_) {
            PHASE_BEGIN;
            LAS unsigned char* scr = (LAS unsigned char*)(ldsp + wave * 5120);
            const int k = lane, kk = k & 31, khi = (kk >> 2) & 1, kr = (kk & 3) + 4 * (kk >> 3), kpos = khi * 32 + (k >> 5) * 16 + kr;
            for (int u = gw; u < 16 * 260; u += NGW) { const int bh = u / 260, tl = u % 260;
                const u32x4* srcp = (const u32x4*)(P_VB + ((size_t)bh * LK + tl * 64 + k) * DV);
                u32x4 v[8];
#pragma unroll
                for (int c = 0; c < 8; ++c) v[c] = srcp[c];
#pragma unroll
                for (int c = 0; c < 8; ++c)
#pragma unroll
                    for (int j = 0; j < 4; ++j) { const unsigned w = __builtin_amdgcn_cvt_pk_fp8_f32(bf_lo(v[c][j]), bf_hi(v[c][j]), 0u, false); const int d = 8 * c + 2 * j;
                        scr[d * 80 + kpos] = (unsigned char)(w & 0xffu); scr[(d + 1) * 80 + kpos] = (unsigned char)((w >> 8) & 0xffu); }
                LDS_WAIT(); asm volatile("" ::: "memory");
                u32x4* dstp = (u32x4*)(P_VT8 + ((size_t)bh * 260 + tl) * 4096 + lane * 64);
#pragma unroll
                for (int c = 0; c < 4; ++c) dstp[c] = *(const LAS u32x4*)(scr + lane * 80 + c * 16);
                LDS_WAIT(); asm volatile("" ::: "memory");
            }
        }
        SEAM(pb + 4);

        if (IN(pb + 5)) {
            for (int rep_ = 0; rep_ < REP_FFT; ++rep_) { PHASE_BEGIN;
              for (int u = vcu; u < 256; u += G) { const int b = u >> 7, k1 = u & 127;
                dft::unit<1, 256>((LAS char*)lds, P_F2, (const char*)(P_YP + (size_t)(b * 128 + k1) * 256 * 256), (size_t)512, (char*)P_YA, b, k1, tid); } }
            if (l == 0) { PHASE_BEGIN;
              for (int u = vcu; u < 16; u += G) { const int b = u >> 3, h = u & 7;
                att8::attn_unit(P_HQ + (size_t)(TL + b * CTXL) * 768 + h * DQK, P_K8 + (size_t)(b * NH + h) * LK * 128, P_VT8 + (size_t)(b * NH + h) * 260 * 4096,
                                P_YA + (size_t)(TL + b * CTXL) * NINP + 768 + h * DV, NINP, CTXL / 64, false, 0, CTXL, (LAS char*)lds, tid); } }
            for (int rep_ = 0; rep_ < REP_ATT; ++rep_) { PHASE_BEGIN;
              for (int u = vcu; u < 512; u += G) { const int bh = u >> 5, qb = u & 31, b = bh >> 3, h = bh & 7; int tidu = tid; asm volatile("" : "+v"(tidu));
#if ATT_VAR
                if (rep_ + 1 < REP_ATT) att8::attn_unit_p<ATT_VAR>(P_HQ + (size_t)(b * SEQ + qb * 512) * 768 + h * DQK, P_K8 + (size_t)bh * LK * 128, P_VT8 + (size_t)bh * 260 * 4096,
                                P_YA + (size_t)(b * SEQ + qb * 512) * NINP + 768 + h * DV, NINP, LK / 64, true, qb * 512, 512, (LAS char*)lds, tidu); else
#endif
                att8::attn_unit_p<0>(P_HQ + (size_t)(b * SEQ + qb * 512) * 768 + h * DQK, P_K8 + (size_t)bh * LK * 128, P_VT8 + (size_t)bh * 260 * 4096,
                                P_YA + (size_t)(b * SEQ + qb * 512) * NINP + 768 + h * DV, NINP, LK / 64, true, qb * 512, 512, (LAS char*)lds, tidu); } }
        }
        SEAM(pb + 5);
        }

        if (IN(pb + 6)) for (int rep_ = 0; rep_ < REP_OUT; ++rep_) {
            PHASE_BEGIN;
#if SELFCHECK
            if (gw < 64) selfcheck_attn(l, P_HQ, P_K8, P_VB, P_VT8, P_YA, P_U, (const bf16_t*)(P_DW(l) + DW_WUQ), (const bf16_t*)(P_DW(l) + DW_WUKV), (unsigned*)(wsp + WS_CTL) + CW_CHK, (LAS float*)(ldsp + wave * 1024), gw, lane);
            __syncthreads();
#endif
            const float* xlat = INP(0); const float* xctx = INP(2); const bf16_t* xsin = (l == 0 && rep_ == 0) ? nullptr : P_XS;
            pg8::DenseSched S; S.init(RL, DM, G, bx, P_YA, NINP, P_DW(l) + DW_WCOMB, NINP);
            pg8::EpiResid E{xlat, xctx, xsin, P_XS, P_MODS + (size_t)l * 3 * 6144, (REP_OUT > 1 && rep_ > 0) ? 0.f : 1.f};
            pg8::gemm_phase<pg8::EpiResid, pg8::DenseSched>(lds, NINP, S, E, tid);
            if (CV_ON && bx >= 8 && rep_ == 0) { LAS float* scr = (LAS float*)(lds + wave * 16384);
                CONVERT_ITEMS((bx - 8) * 8 + wave, 248 * 8, CV_A); }
        }
        SEAM(pb + 6);

        for (int grp2_ = 0; grp2_ < GRP_MOE; ++grp2_) {
        if (IN(pb + 7)) for (int rep_ = 0; rep_ < REP_NORM * REP_P7; ++rep_) {
            PHASE_BEGIN;
            const float* mods = P_MODS + (size_t)l * 3 * 6144;
            for (int ch = gw; ch < RL / 16; ch += NGW) { const int r0 = ch * 16; const int vec = r0 < SEQ ? 0 : (r0 < TL ? 1 : 2);
                norm_rows<true>(P_XS + (size_t)r0 * DM, P_YB + (size_t)r0 * DM, INP(7) + l * DM, mods + vec * 6144 + 3 * DM, mods + vec * 6144 + 4 * DM, 16, lane, P_H2F8 + (size_t)r0 * DM); }
            LAS float* scr = (LAS float*)(lds + wave * 16384);
            CONVERT_ITEMS(CV_A + gw, NGW, CV_B);
        }
        SEAM(pb + 7);

        if (IN(pb + 8)) for (int rep_ = 0; rep_ < REP_DENSE; ++rep_) {
            PHASE_BEGIN;
            pg8::DenseSched S; S.init(RL, 256, G, bx, P_YB, DM, P_DW(l) + DW_WR, DM);
            pg8::EpiLogits E{P_LOG};
            pg8::gemm_phase<pg8::EpiLogits, pg8::DenseSched>(lds, DM, S, E, tid);
            if (CV_ON && bx >= 130 && rep_ == 0) { LAS float* scr = (LAS float*)(lds + wave * 16384);
                CONVERT_ITEMS(CV_B + (bx - 130) * 8 + wave, 126 * 8, CV_NIT); }
        }
        SEAM(pb + 8);

        if (IN(pb + 9)) for (int rep_ = 0; rep_ < REP_ROUTE; ++rep_) {
            PHASE_BEGIN;
            LAS int* lcnt = (LAS int*)lds; LAS int* lbase = lcnt + 64; LAS int* rec = lbase + 64;
            if (tid < 64) lcnt[tid] = 0;
            __syncthreads();
            const int per = (RL + G - 1) / G; const int t0 = vcu * per; const int t1 = (t0 + per) < RL ? (t0 + per) : RL;
            const float bias = INP(18)[l * NE + lane]; const float* LOGITS = P_LOG;
            for (int t = t0 + wave; t < t1; t += 8) {
                const float lg = LOGITS[(size_t)t * NE + lane]; const float s = 1.0f / (1.0f + __expf(-lg)); const float sel = s + bias;
                float v1 = sel; int i1 = lane;
#pragma unroll
                for (int off = 1; off < 8; off <<= 1) { const float ov = shx(v1, off, lane); const int oi = shxi(i1, off, lane); if (ov > v1 || (ov == v1 && oi < i1)) { v1 = ov; i1 = oi; } }
                float v2 = (lane == i1) ? -INFINITY : sel;
#pragma unroll
                for (int off = 1; off < 8; off <<= 1) v2 = fmaxf(v2, shx(v2, off, lane));
                const float gs = v1 + v2; const int g = lane >> 3; int grank = 0;
#pragma unroll
                for (int gg = 0; gg < 8; ++gg) { const float og = __uint_as_float(__builtin_amdgcn_readlane(__float_as_uint(gs), gg * 8)); grank += (og > gs || (og == gs && gg < g)) ? 1 : 0; }
                const bool gsel = grank < 4; const float msel = gsel ? sel : -INFINITY; int rank = 0;
                unsigned long long gm = __ballot(gsel && (lane & 7) == 0);
#pragma unroll 1
                for (int gi = 0; gi < 4; ++gi) { const int gb = __builtin_amdgcn_readfirstlane((int)__builtin_ctzll(gm | (1ull << 63))); gm &= gm - 1ull;
#pragma unroll
                    for (int j = 0; j < 8; ++j) { const int e2 = gb + j; const float ov = __uint_as_float(__builtin_amdgcn_readlane(__float_as_uint(msel), e2)); rank += (ov > msel || (ov == msel && e2 < lane)) ? 1 : 0; } }
                const bool chosen = gsel && rank < 8;
                const float ssum = wave_sum(chosen ? s : 0.f, lane);
                if (chosen) { const int lp = __hip_atomic_fetch_add(lcnt + lane, 1, __ATOMIC_RELAXED, __HIP_MEMORY_SCOPE_WORKGROUP); LAS int* rr = rec + ((t - t0) * 8 + rank) * 3; rr[0] = lane; rr[1] = lp; rr[2] = (int)__float_as_uint(s / ssum * 2.5f); }
            }
            __syncthreads();
            if (tid < 64) lbase[tid] = (int)__hip_atomic_fetch_add(P_GCNT(l) + 256 * rep_ + 512 * grp2_ + tid, (unsigned)lcnt[tid], __ATOMIC_RELAXED, __HIP_MEMORY_SCOPE_AGENT);
            __syncthreads();
            int* TOKL = P_TOKL; int* TPOS = P_TPOS; float* TW = P_TW;
            if (REP_ROUTE > 1 && rep_ > 0) { TOKL = (int*)(wsp + WS_YB + 70 * MiB); TPOS = (int*)(wsp + WS_YB + 80 * MiB); TW = (float*)(wsp + WS_YB + 82 * MiB); }
            for (int i = tid; i < (t1 - t0) * 8; i += 512) { const LAS int* rr = rec + i * 3; const int e = rr[0], pos = lbase[e] + rr[1], t = t0 + (i >> 3);
                TOKL[(size_t)e * RT + pos] = t; TPOS[(size_t)t * 8 + (i & 7)] = (e << 20) | pos; TW[(size_t)t * 8 + (i & 7)] = __uint_as_float((unsigned)rr[2]); }
            __syncthreads();
        }
        SEAM(pb + 9);

#define tstart ((LAS int*)(ldsp + TAB_OFF))
#define ecnt ((LAS int*)(ldsp + TAB_OFF + 288))
#define ulist ((LAS int*)(ldsp + ULIST_OFF))
#define uidx ((LAS int*)(ldsp + IDX_OFF))
        const bool need_tab = (hi > pb + 10) && (lo <= pb + 14);
        if (need_tab) {
            PHASE_BEGIN;
            if (tid < 64) {
                const int c = (int)__hip_atomic_load(P_GCNT(l) + 512 * grp2_ + tid, __ATOMIC_RELAXED, __HIP_MEMORY_SCOPE_AGENT); const int nt_ = (c + 255) >> 8; int inc = nt_;
#pragma unroll
                for (int o = 1; o < 64; o <<= 1) { const int v = __builtin_amdgcn_ds_bpermute(((lane - o) & 63) << 2, inc); if (lane >= o) inc += v; }
                ecnt[tid] = c; tstart[tid] = inc - nt_;
                if (tid == 63) { ecnt[NE] = RL; tstart[NE] = inc; tstart[NEX] = inc + RL / 256; } }
            __syncthreads();
        }
        int ntile = 0; if (need_tab) { PHASE_BEGIN; ntile = tstart[NEX]; }

        if (IN(pb + 10)) for (int rep_ = 0; rep_ < REP_MOE; ++rep_) {
            PHASE_BEGIN;
            const int nunits = ntile * 2; int nu = 0;
            for (int i = 0; ; ++i) { const int u = i * G + vcu; if (u >= nunits || i >= MAXU) break; nu = i + 1; }
            if (tid < nu) { const int u = tid * G + vcu, tile = u >> 1; int e = 0;
_Pragma("unroll 1")
                for (int q = 0; q < NEX; ++q) if (tstart[q] <= tile) e = q;
                ulist[tid * 4 + 0] = e; ulist[tid * 4 + 1] = tile; ulist[tid * 4 + 2] = u & 1; ulist[tid * 4 + 3] = tile - tstart[e]; }
            __syncthreads();
            const int* TOKL = P_TOKL;
            for (int i = 0; i < nu; ++i) { const int e = ulist[i * 4 + 0], rt = ulist[i * 4 + 3], cnt = ecnt[e];
                if (tid < 256) { const int pos = rt * 256 + tid; const int pc = pos < cnt ? pos : cnt - 1; uidx[i * 256 + tid] = e < NE ? TOKL[(size_t)e * RT + pc] : pc; } }
            __syncthreads();
            pg8::MoeSched S{ulist, uidx, nu, (const char*)P_H2F8, (const char*)P_EWGU8, 0, 0};
            pg8::EpiSwiGLU E{P_ACT, 1.0f / 32.0f};
            pg8::gemm_phase<pg8::EpiSwiGLU, pg8::MoeSched, true>(lds, DM, S, E, tid);
        }
        SEAM(pb + 10);

#pragma unroll 1
        for (int qd = 0; qd < 2; ++qd) {
            if (IN(pb + 11 + 2 * qd)) for (int rep_ = 0; rep_ < REP_MOE * REP_DOWN; ++rep_) {
                PHASE_BEGIN;
                const int nunits = ntile * 2; int nu = 0;
                for (int i = 0; ; ++i) { const int u = i * G + vcu; if (u >= nunits || i >= MAXU) break; nu = i + 1; }
                __syncthreads();
                if (tid < nu) { const int u = tid * G + vcu, tile = u >> 1; int e = 0;
_Pragma("unroll 1")
                    for (int q = 0; q < NEX; ++q) if (tstart[q] <= tile) e = q;
                    ulist[tid * 4 + 0] = e; ulist[tid * 4 + 1] = tile; ulist[tid * 4 + 2] = u & 1; ulist[tid * 4 + 3] = tile - tstart[e]; }
                __syncthreads();
                pg8::MoeSched S{ulist, uidx, nu, (const char*)P_ACT, (const char*)P_EWD, 1, qd};
                pg8::EpiFp8 E{(unsigned char*)P_YB, 512, 1.0f / 16.0f};
                pg8::gemm_phase<pg8::EpiFp8, pg8::MoeSched, true>(lds, DE, S, E, tid);
            }
            SEAM(pb + 11 + 2 * qd);
            if (IN(pb + 12 + 2 * qd)) for (int rep_ = 0; rep_ < REP_COMB; ++rep_) {
                PHASE_BEGIN;
                const float* mods = P_MODS + (size_t)l * 3 * 6144; const int* TPOS = P_TPOS; const float* TW = P_TW; const unsigned char* YB8 = (const unsigned char*)P_YB; bf16_t* XS = P_XS;
                const bool fuse = (qd == 1) && (GRP_MOE == 1 || grp2_ + 1 == GRP_MOE) && (REP_COMB == 1);
                for (int ch = gw; ch < RL / 8; ch += NGW) {
                    const int tb = ch * 8; const int vec = tb < SEQ ? 0 : (tb < TL ? 1 : 2);
                    const float* gp = mods + vec * 6144 + 5 * DM + qd * 512 + lane * 8; f32x4 g0 = *(const f32x4*)gp, g1 = *(const f32x4*)(gp + 4);
                    if ((REP_COMB > 1 && rep_ > 0) || (GRP_MOE > 1 && grp2_ + 1 < GRP_MOE)) { g0 = g0 * 0.f; g1 = g1 * 0.f; }
                    f32x4 nm[4], ns[4];
                    { const float zf_ = (float)z_;
#pragma unroll
                      for (int q = 0; q < 4; ++q) { nm[q] = (f32x4){zf_, zf_, zf_, zf_}; ns[q] = nm[q]; } }
                    if (fuse) {
                        if (l == 0) { const float* m1 = P_MODS + (size_t)3 * 6144 + vec * 6144; const float* gmx = INP(6) + DM;
#pragma unroll
                            for (int q = 0; q < 4; ++q) { const int col = (q >> 1) * 512 + lane * 8 + (q & 1) * 4; const f32x4 gv = *(const f32x4*)(gmx + col), s1 = *(const f32x4*)(m1 + DM + col); nm[q] = gv * (s1 + 1.0f); ns[q] = *(const f32x4*)(m1 + col); } }
                        else { const float* gf = INP(25);
#pragma unroll
                            for (int q = 0; q < 4; ++q) { const int col = (q >> 1) * 512 + lane * 8 + (q & 1) * 4; nm[q] = *(const f32x4*)(gf + col); ns[q] = nm[q] * 0.f; } }
                    }
#pragma unroll 2
                    for (int t = tb; t < tb + 8; ++t) {
                        int tp = 0; float tw = 0.f; if (lane < 8) { tp = TPOS[(size_t)t * 8 + lane]; tw = TW[(size_t)t * 8 + lane]; }
                        u32x2 v[9];
#pragma unroll
                        for (int k = 0; k < 8; ++k) { const int tpk = __builtin_amdgcn_readlane(tp, k); const int slot = tstart[tpk >> 20] * 256 + (tpk & 0xfffff); v[k] = __builtin_nontemporal_load((const u32x2*)(YB8 + (size_t)slot * 512 + lane * 8)); }
                        v[8] = __builtin_nontemporal_load((const u32x2*)(YB8 + (size_t)(tstart[NE] * 256 + t) * 512 + lane * 8));
                        u32x4* xp = (u32x4*)(XS + (size_t)t * DM + qd * 512 + lane * 8); const u32x4 xw = *xp;
                        f32x4 x0 = {bf_lo(xw.x), bf_hi(xw.x), bf_lo(xw.y), bf_hi(xw.y)}, x1 = {bf_lo(xw.z), bf_hi(xw.z), bf_lo(xw.w), bf_hi(xw.w)};
                        f32x4 y0 = x0, y1 = x1; if (fuse) { const u32x4 yw = *(const u32x4*)(XS + (size_t)t * DM + lane * 8); y0 = (f32x4){bf_lo(yw.x), bf_hi(yw.x), bf_lo(yw.y), bf_hi(yw.y)}; y1 = (f32x4){bf_lo(yw.z), bf_hi(yw.z), bf_lo(yw.w), bf_hi(yw.w)}; }
                        float a[8];
#pragma unroll
                        for (int j = 0; j < 8; ++j) a[j] = 0.f;
#pragma unroll
                        for (int k = 0; k < 9; ++k) { const float w = k < 8 ? __uint_as_float(__builtin_amdgcn_readlane(__float_as_uint(tw), k < 8 ? k : 0)) : 1.0f;
                            a[0] += w * __builtin_amdgcn_cvt_f32_fp8((int)v[k].x, 0); a[1] += w * __builtin_amdgcn_cvt_f32_fp8((int)v[k].x, 1); a[2] += w * __builtin_amdgcn_cvt_f32_fp8((int)v[k].x, 2); a[3] += w * __builtin_amdgcn_cvt_f32_fp8((int)v[k].x, 3);
                            a[4] += w * __builtin_amdgcn_cvt_f32_fp8((int)v[k].y, 0); a[5] += w * __builtin_amdgcn_cvt_f32_fp8((int)v[k].y, 1); a[6] += w * __builtin_amdgcn_cvt_f32_fp8((int)v[k].y, 2); a[7] += w * __builtin_amdgcn_cvt_f32_fp8((int)v[k].y, 3); }
                        x0.x += g0.x * a[0]; x0.y += g0.y * a[1]; x0.z += g0.z * a[2]; x0.w += g0.w * a[3]; x1.x += g1.x * a[4]; x1.y += g1.y * a[5]; x1.z += g1.z * a[6]; x1.w += g1.w * a[7];
                        if (!(fuse && l == 1)) { u32x4 ow; ow.x = cvt_pk_bf16(x0.x, x0.y); ow.y = cvt_pk_bf16(x0.z, x0.w); ow.z = cvt_pk_bf16(x1.x, x1.y); ow.w = cvt_pk_bf16(x1.z, x1.w); *xp = ow; }
                        if (fuse) {
                            float s = (x0.x * x0.x + x0.y * x0.y) + (x0.z * x0.z + x0.w * x0.w) + (x1.x * x1.x + x1.y * x1.y) + (x1.z * x1.z + x1.w * x1.w)
                                    + (y0.x * y0.x + y0.y * y0.y) + (y0.z * y0.z + y0.w * y0.w) + (y1.x * y1.x + y1.y * y1.y) + (y1.z * y1.z + y1.w * y1.w);
                            const float rstd = rsqrtf(wave_sum(s, lane) * (1.0f / DM) + EPS);
                            const f32x4 o0 = y0 * rstd * nm[0] + ns[0], o1 = y1 * rstd * nm[1] + ns[1], o2 = x0 * rstd * nm[2] + ns[2], o3 = x1 * rstd * nm[3] + ns[3];
                            if (l == 1) { f32x4* op = (f32x4*)(P.out + (size_t)t * DM + lane * 8); __builtin_nontemporal_store(o0, op); __builtin_nontemporal_store(o1, op + 1); __builtin_nontemporal_store(o2, op + 128); __builtin_nontemporal_store(o3, op + 129); }
                            else { u32x4 w0, w1; w0.x = cvt_pk_bf16(o0.x, o0.y); w0.y = cvt_pk_bf16(o0.z, o0.w); w0.z = cvt_pk_bf16(o1.x, o1.y); w0.w = cvt_pk_bf16(o1.z, o1.w);
                                w1.x = cvt_pk_bf16(o2.x, o2.y); w1.y = cvt_pk_bf16(o2.z, o2.w); w1.z = cvt_pk_bf16(o3.x, o3.y); w1.w = cvt_pk_bf16(o3.z, o3.w);
                                bf16_t* hp = P_HQ + (size_t)t * DM + lane * 8; *(u32x4*)hp = w0; *(u32x4*)(hp + 512) = w1; }
                        }
                    }
                }
            }
            if (!(l == 1 && qd == 1) || SELFCHECK || REP_COMB > 1 || GRP_MOE > 1) SEAM(pb + 12 + 2 * qd);
        }
        }
    }

    if (IN(NPHASE - 1)) for (int rep_ = 0; rep_ < REP_PRO; ++rep_) {
        PHASE_BEGIN;
#if SELFCHECK
        const unsigned chk_code = __hip_atomic_load((unsigned*)(wsp + WS_CTL) + CW_CHK, __ATOMIC_RELAXED, __HIP_MEMORY_SCOPE_AGENT);
#endif
        const float* gf = INP(25); f32x4 gm[4]; const bf16_t* XS = P_XS;
#pragma unroll
        for (int j = 0; j < 4; ++j) gm[j] = *(const f32x4*)(gf + 4 * lane + 256 * j);
        for (int r = gw; r < ((REP_COMB > 1) ? TL : (SELFCHECK ? 1 : 0)); r += NGW) {
            const u32x2* xr = (const u32x2*)(XS + (size_t)r * DM) + lane; f32x4 v[4]; float s = 0.f;
#pragma unroll
            for (int j = 0; j < 4; ++j) { const u32x2 a = xr[64 * j]; v[j] = (f32x4){bf_lo(a.x), bf_hi(a.x), bf_lo(a.y), bf_hi(a.y)}; s += (v[j].x * v[j].x + v[j].y * v[j].y) + (v[j].z * v[j].z + v[j].w * v[j].w); }
            const float rstd = rsqrtf(wave_sum(s, lane) * (1.0f / DM) + EPS);
            f32x4* o = (f32x4*)(P.out + (size_t)r * DM) + lane;
#pragma unroll
            for (int j = 0; j < 4; ++j) if (!SELFCHECK) o[64 * j] = v[j] * rstd * gm[j];
#if SELFCHECK
            if (r == 0 && lane == 0) { const unsigned w1 = __hip_atomic_load((unsigned*)(wsp + WS_CTL) + CW_CHK + 1 + SELFCHECK_REPORT, __ATOMIC_RELAXED, __HIP_MEMORY_SCOPE_AGENT); P.out[0] = (float)w1; (void)chk_code; }
#endif
        }
    }
#undef IN
#undef SEAM
#undef tstart
#undef ecnt
#undef ulist
#undef uidx
}

extern "C" void kernel_launch(void* const* d_in, const int* in_sizes, int n_in, void* d_out, int out_size, void* d_ws, size_t ws_size, hipStream_t stream) {
    static int grid = 0;
    if (grid == 0) {
        if (n_in != 26 || out_size != TL * DM || ws_size < WS_END) { fprintf(stderr, "kernel_launch: unexpected problem: n_in %d out %d ws %zu (need %zu)\n", n_in, out_size, ws_size, (size_t)WS_END); grid = -1; return; }
        int dev = 0, cus = 0, per_cu = 0;
        if (hipGetDevice(&dev) != hipSuccess || hipDeviceGetAttribute(&cus, hipDeviceAttributeMultiprocessorCount, dev) != hipSuccess) { grid = -1; return; }
        if (hipFuncSetAttribute((const void*)mk_fwd, hipFuncAttributeMaxDynamicSharedMemorySize, LDS_BYTES) != hipSuccess) { fprintf(stderr, "kernel_launch: hipFuncSetAttribute failed\n"); grid = -1; return; }
        if (hipOccupancyMaxActiveBlocksPerMultiprocessor(&per_cu, (const void*)mk_fwd, 512, LDS_BYTES) != hipSuccess || per_cu < 1) { fprintf(stderr, "kernel_launch: occupancy query says %d\n", per_cu); (void)hipGetLastError(); }
        grid = cus;
    }
    if (grid < 0) return;
    (void)hipMemsetAsync((char*)d_ws + WS_CTL, 0, CTL_ZERO_BYTES, stream);
    Params p{};
    for (int i = 0; i < 26; ++i) p.in[i] = (const float*)d_in[i];
    p.out = (float*)d_out; p.ws = (unsigned char*)d_ws; p.pad = 0;
#if MK_N_LAUNCHES == 1
    p.ph_lo = 0; p.ph_hi = NPHASE; p.use_bar = 1;
    hipLaunchKernelGGL(mk_fwd, dim3(grid), dim3(512), LDS_BYTES, stream, p);
#else
    for (int ph = 0; ph < NPHASE; ++ph) { p.ph_lo = ph; p.ph_hi = ph + 1; p.use_bar = 0; hipLaunchKernelGGL(mk_fwd, dim3(grid), dim3(512), LDS_BYTES, stream, p); }
#endif
}
```

```cpp
#include <hip/hip_runtime.h>
#include <cstdio>
#include <cstdint>
#include <cmath>

#ifndef MK_N_LAUNCHES
#define MK_N_LAUNCHES 1
#endif

#ifndef REP_NORM
#define REP_NORM 1
#endif
#ifndef REP_DENSE
#define REP_DENSE 1
#endif
#ifndef REP_ROWS
#define REP_ROWS 1
#endif
#ifndef REP_MOE
#define REP_MOE 1
#endif
#ifndef REP_FFT
#define REP_FFT 1
#endif
#ifndef REP_PRO
#define REP_PRO 1
#endif
#ifndef REP_COMB
#define REP_COMB 1
#endif
#ifndef REP_OUT
#define REP_OUT 1
#endif
#ifndef REP_BAR
#define REP_BAR 1
#endif
#ifndef REP_ATT
#define REP_ATT 1
#endif
#ifndef ATT_VAR
#define ATT_VAR 0
#endif
#ifndef REP_P7
#define REP_P7 1
#endif
#ifndef REP_DOWN
#define REP_DOWN 1
#endif
#ifndef REP_VT
#define REP_VT 1
#endif
#ifndef GRP_MIX
#define GRP_MIX 1
#endif
#ifndef GRP_MOE
#define GRP_MOE 1
#endif
#ifndef REP_ROUTE
#define REP_ROUTE 1
#endif
#define LAS __attribute__((address_space(3)))
#define GAS __attribute__((address_space(1)))
typedef unsigned short bf16_t;
typedef short bf16x8 __attribute__((ext_vector_type(8)));
typedef short s16x4 __attribute__((ext_vector_type(4)));
typedef float f32x4 __attribute__((ext_vector_type(4)));
typedef float f32x2 __attribute__((ext_vector_type(2)));
typedef float f32x16 __attribute__((ext_vector_type(16)));
typedef unsigned u32x4 __attribute__((ext_vector_type(4)));
typedef unsigned u32x2 __attribute__((ext_vector_type(2)));

constexpr int DM = 1024, NB = 2, SEQ = 16384, CTXL = 256, TL = NB * SEQ, TC = NB * CTXL, RT = TL + TC;
constexpr int NINP = 1280;
constexpr int NH = 8, DQK = 96, DV = 64, LK = SEQ + CTXL;
constexpr int NE = 64, DE = 256, NEX = NE + 1;
constexpr int COL_FNO = 256, COL_Q = 512, COL_KV = 896, COL_KR = 1152;
constexpr float EPS = 1e-6f;
constexpr int NSLOT_MAX = 282624 + RT;
constexpr int MAXU = 12;

constexpr size_t MiB = 1u << 20;
constexpr size_t WS_CTL = 0, CTL_ZERO_BYTES = 65536;
constexpr size_t WS_MODS = 65536;
constexpr size_t WS_DW = 1 * MiB, DW_LAYER = 7 * MiB;
constexpr size_t DW_WIN = 0, DW_WUQ = 2560 * 1024, DW_WUKV = 3200 * 1024, DW_WCOMB = 3712 * 1024, DW_WR = 6272 * 1024;
constexpr size_t WS_F1 = 15 * MiB, WS_F2 = WS_F1 + 65536, WS_FC = WS_F2 + 131072, WS_WCS = WS_FC + 262144;
constexpr size_t WS_XS = 17 * MiB;
constexpr size_t WS_X0 = 147 * MiB;
constexpr size_t WS_HQ = WS_X0;
constexpr size_t WS_U = WS_X0 + 65 * MiB;
constexpr size_t WS_KB = WS_U + 83200 * 1024;
constexpr size_t WS_VB = WS_KB + 49920 * 1024;
constexpr size_t WS_YA = WS_VB + 33280 * 1024;
constexpr size_t WS_YP = WS_YA + 83200 * 1024;
constexpr size_t WS_VT8 = WS_YP + 32 * MiB;
constexpr size_t WS_MIX_END = WS_VT8 + (size_t)16 * 260 * 4096;
constexpr size_t WS_EW = WS_X0;
constexpr size_t EW_GU_BYTES = (size_t)NEX * 512 * 1024 * 2, EW_D_BYTES = (size_t)NEX * 1024 * 256 * 2;
constexpr size_t WS_ACT = WS_EW + EW_GU_BYTES + EW_D_BYTES;
constexpr size_t WS_TOKL = WS_ACT + (size_t)NSLOT_MAX * 512;
constexpr size_t WS_TPOS = WS_TOKL + (size_t)NE * RT * 4;
constexpr size_t WS_TW = WS_TPOS + (size_t)RT * 32;
constexpr size_t WS_LOG = WS_TW + (size_t)RT * 32;
constexpr size_t WS_YB = WS_LOG + (size_t)RT * 256;
constexpr size_t WS_END = WS_YB + (size_t)NSLOT_MAX * 512;
static_assert(WS_MIX_END <= 590 * MiB && WS_END <= 590 * MiB, "workspace map must fit the guaranteed 590 MiB");
static_assert(WS_WCS + 262144 <= WS_XS && WS_DW + 2 * DW_LAYER <= WS_F1 && DW_WR + 512 * 1024 <= DW_LAYER, "dense weight map");
static_assert((size_t)RT * 2048 <= (size_t)NSLOT_MAX * 512, "H2 fits in the head of YB");
constexpr int CW_TMO = 0, CW_BAR = 1024, CW_CNT = 8192;

constexpr int LDS_WORK = 131072, IDX_OFF = LDS_WORK, ULIST_OFF = IDX_OFF + MAXU * 1024, TAB_OFF = ULIST_OFF + 512, MISC_OFF = TAB_OFF + 1024, VOC_OFF = MISC_OFF + 512, LDS_BYTES = VOC_OFF + 16384;
static_assert(LDS_BYTES <= 163840, "LDS");

__device__ __forceinline__ unsigned cvt_pk_bf16(float lo, float hi) { unsigned r; asm volatile("v_cvt_pk_bf16_f32 %0, %1, %2" : "=v"(r) : "v"(lo), "v"(hi)); return r; }
__device__ __forceinline__ float bf_lo(unsigned w) { return __uint_as_float(w << 16); }
__device__ __forceinline__ float bf_hi(unsigned w) { return __uint_as_float(w & 0xffff0000u); }
__device__ __forceinline__ float shx(float v, int o, int lane) { return __int_as_float(__builtin_amdgcn_ds_bpermute((lane ^ o) << 2, __float_as_int(v))); }
__device__ __forceinline__ int shxi(int v, int o, int lane) { return __builtin_amdgcn_ds_bpermute((lane ^ o) << 2, v); }
__device__ __forceinline__ float wave_sum(float v, int lane) {
#pragma unroll
    for (int o = 1; o < 32; o <<= 1) v += shx(v, o, lane);
    { auto rr = __builtin_amdgcn_permlane32_swap(__float_as_uint(v), __float_as_uint(v), false, false); v = __uint_as_float(rr[0]) + __uint_as_float(rr[1]); }
    return v;
}
__device__ __forceinline__ float silu_f(float v) { return v * __builtin_amdgcn_rcpf(1.0f + __builtin_amdgcn_exp2f(v * -1.4426950408889634f)); }
typedef int i32x8 __attribute__((ext_vector_type(8)));
__device__ __forceinline__ unsigned pk4_fp8(float a, float b, float c, float d) { unsigned w = __float_as_uint(a); w = __builtin_amdgcn_cvt_pk_fp8_f32(a, b, w, false); w = __builtin_amdgcn_cvt_pk_fp8_f32(c, d, w, true); return w; }
#define LDS_WAIT() asm volatile("s_waitcnt lgkmcnt(0)" ::: "memory")
#define VM_WAIT() asm volatile("s_waitcnt vmcnt(0)" ::: "memory")

#define XB_TMO      128
#define XB_XCNT(j)  (256  + 64 * (j))
#define XB_XSUB(j)  (1280 + 64 * (j))
#define XB_XGEN(j)  (2304 + 64 * (j))
#define XB_TOP      3328
#define XB_TOPGEN   3392
#define XCD_BAR_WORDS 3456
#define XB_SPIN_CAP (1u << 22)
__device__ __forceinline__ unsigned xb_ld(unsigned* p)              { return __hip_atomic_load(p, __ATOMIC_RELAXED, __HIP_MEMORY_SCOPE_AGENT); }
__device__ __forceinline__ unsigned xb_add(unsigned* p, unsigned v) { return __hip_atomic_fetch_add(p, v, __ATOMIC_RELAXED, __HIP_MEMORY_SCOPE_AGENT); }
__device__ __forceinline__ unsigned xb_xcc_id() { return (unsigned)__builtin_amdgcn_s_getreg((3 << 11) | 20) & 0xFu; }
#define XB_SPIN(cond, bar) do { unsigned _sp = 0; while (cond) { __builtin_amdgcn_s_sleep(1); \
    if ((++_sp & 255u) == 0u) { if (xb_ld(&(bar)[XB_TMO])) break; if (_sp > XB_SPIN_CAP) { atomicAdd(&(bar)[XB_TMO], 1u); break; } } } } while (0)
struct XcdBarrier { unsigned* bar; unsigned x; volatile LAS unsigned* st; };
__device__ __forceinline__ XcdBarrier xcd_barrier_post(unsigned* bar, volatile LAS unsigned* st) {
    XcdBarrier b; b.bar = bar; b.x = xb_xcc_id(); b.st = st;
    if (threadIdx.x == 0) (void)xb_add(&bar[XB_XCNT(b.x)], 1u);
    return b;
}
__device__ __forceinline__ void xcd_barrier_complete(unsigned* bar, unsigned x, unsigned& nloc, unsigned& nx) {
    const unsigned G = gridDim.x * gridDim.y * gridDim.z;
    unsigned sum, cnt, mine, sp = 0u;
    for (;;) {
        sum = 0u; cnt = 0u; mine = 0u;
#pragma unroll
        for (unsigned j = 0; j < 16; ++j) { const unsigned c = xb_ld(&bar[XB_XCNT(j)]); sum += c; cnt += (c > 0u) ? 1u : 0u; mine = (j == x) ? c : mine; }
        if (sum == G) break;
        __builtin_amdgcn_s_sleep(1);
        if ((++sp & 255u) == 0u) { if (xb_ld(&bar[XB_TMO])) break; if (sp > XB_SPIN_CAP) { atomicAdd(&bar[XB_TMO], 1u); break; } }
    }
    nloc = mine > 0u ? mine : 1u; nx = cnt > 0u ? cnt : 1u;
}
__device__ __forceinline__ void xcd_barrier(const XcdBarrier& b, const int tid0) {
    asm volatile("s_waitcnt vmcnt(0)" ::: "memory");
    __syncthreads();
    if (tid0 == 0) {
        unsigned* bar = b.bar;
        __builtin_amdgcn_s_waitcnt(0);
        unsigned nloc = b.st[0], nx = b.st[1];
        if (nloc == 0u) { xcd_barrier_complete(bar, b.x, nloc, nx); b.st[0] = nloc; b.st[1] = nx; }
        const unsigned old = xb_add(&bar[XB_XSUB(b.x)], 1u);
        const unsigned gen = old / nloc;
        if (old + 1u == (gen + 1u) * nloc) {
            __builtin_amdgcn_fence(__ATOMIC_RELEASE, "agent");
            asm volatile("s_waitcnt vmcnt(0)" ::: "memory");
            const unsigned og = xb_add(&bar[XB_TOP], 1u);
            const unsigned tg = og / nx;
            if (og + 1u == (tg + 1u) * nx) xb_add(&bar[XB_TOPGEN], 1u);
            else XB_SPIN(xb_ld(&bar[XB_TOPGEN]) == tg, bar);
            __builtin_amdgcn_fence(__ATOMIC_ACQUIRE, "agent");
            xb_add(&bar[XB_XGEN(b.x)], 1u);
            asm volatile("s_waitcnt vmcnt(0)" ::: "memory");
        } else {
            XB_SPIN(xb_ld(&bar[XB_XGEN(b.x)]) == gen, bar);
            __builtin_amdgcn_fence(__ATOMIC_ACQUIRE, "agent");
            asm volatile("s_waitcnt vmcnt(0)" ::: "memory");
        }
    }
    __syncthreads();
}

namespace pg8 {
constexpr int BM = 256, BK = 64, HALF = 128, HTB = HALF * BK * 2, STAGE_BYTES = 8 * HTB, NXCD = 8, WGM = 8;
__device__ __forceinline__ int lds_byte(int r, int c) { const int st = (r >> 4) * 2 + (c >> 5), rr = r & 15, cc = c & 31, ob = rr * 64 + cc * 2; return st * 1024 + (ob ^ (((ob >> 9) & 1) << 5)); }
__device__ __forceinline__ void stage_rc(int b, int& R, int& C) { const int st = b / 1024, sb = b % 1024, swz = sb ^ (((sb >> 9) & 1) << 5); R = (st >> 1) * 16 + swz / 64; C = (st & 1) * 32 + (swz % 64) / 2; }
__device__ __forceinline__ int perm32(int rho) { const int n = rho >> 4, i = rho & 15; return 8 * (i >> 2) + 4 * n + (i & 3); }
struct Unit { int pm, pn, e, aux; };

template <class Epi, class Sched, bool F8 = false>
__device__ __forceinline__ void gemm_phase(LAS unsigned char* lds, const int K, const Sched& S, const Epi& E, const int tid) {
    const int wid = __builtin_amdgcn_readfirstlane(tid >> 6), lane = tid & 63, wr = wid >> 2, wc = wid & 3, fr = lane & 15, fq = lane >> 4;
    const int nt = F8 ? K / 128 : K / BK;
    int Rr[2], Cc[2]; unsigned voffB[2]; const unsigned vstepB = F8 ? (unsigned)(64 * K) : (unsigned)(64 * K) * 2u;
#pragma unroll
    for (int i = 0; i < 2; ++i) { int R, C; stage_rc(tid * 16 + i * 8192, R, C); const int Rb = Epi::PERM ? ((R & ~31) + perm32(R & 31)) : R; Rr[i] = R; Cc[i] = C; voffB[i] = F8 ? (unsigned)(Rb * K + 2 * C) : (unsigned)(Rb * K + C) * 2u; }
    const size_t kstep = (size_t)(BK * 2);
    const size_t hstep = F8 ? (size_t)HALF * K : (size_t)HALF * K * 2;
    const unsigned ldsw = (unsigned)wid * 1024u;
    const int aoff = lds_byte(wr * 64 + fr, fq * 8), boff = lds_byte(wc * 32 + fr, fq * 8);
    const int f8in = (fq >> 1) * 1024 + ((fr * 64 + 32 * (fq & 1)) ^ ((fr >> 3) << 5)); const int aoff8 = 8 * wr * 1024 + f8in; const int bdiff8 = (4 * wc - 8 * wr) * 1024;
#define PG8_SA(b, h) (((b) * 2 + (h)) * HTB)
#define PG8_SB(b, h) ((4 + (b) * 2 + (h)) * HTB)
#define PG8_STAGE(bufoff, gbase, voff) do { _Pragma("unroll") for (int _i = 0; _i < 2; ++_i) { unsigned vo_ = (voff)[0] + (unsigned)_i * vstepB; asm volatile("" : "+v"(vo_));         \
        __builtin_amdgcn_global_load_lds((const unsigned*)((const char*)(gbase) + vo_), (LAS unsigned*)(lds + (bufoff) + ldsw + _i * 8192), 16, 0, 0); } } while (0)
#define PG8_STAGEA(bufoff, o0, o1) do { \
        __builtin_amdgcn_global_load_lds((const unsigned*)(aB + (size_t)(o0)), (LAS unsigned*)(lds + (bufoff) + ldsw), 16, 0, 0); \
        __builtin_amdgcn_global_load_lds((const unsigned*)(aB + (size_t)(o1)), (LAS unsigned*)(lds + (bufoff) + ldsw + 8192), 16, 0, 0); } while (0)
#define PG8_LDA(dst, b, h) do { if constexpr (F8) { _Pragma("unroll") for (int m = 0; m < 4; ++m) { typedef int i32x4_ __attribute__((ext_vector_type(4))); const i32x4_ x_ = *(const LAS i32x4_*)(lds + PG8_SA(b, h) + aoff8 + m * 2048), y_ = *(const LAS i32x4_*)(lds + PG8_SA(b, h) + aoff8 + m * 2048 + 16); \
            dst##8[m] = __builtin_shufflevector(x_, y_, 0, 1, 2, 3, 4, 5, 6, 7); } } \
        else { _Pragma("unroll") for (int m = 0; m < 4; ++m) _Pragma("unroll") for (int k = 0; k < 2; ++k) dst[m][k] = *(const LAS bf16x8*)(lds + PG8_SA(b, h) + aoff + m * 2048 + k * 1024); } } while (0)
#define PG8_LDB(dst, b, h) do { if constexpr (F8) { int boff8 = aoff8 + bdiff8; asm volatile("" : "+v"(boff8)); _Pragma("unroll") for (int n = 0; n < 2; ++n) { typedef int i32x4_ __attribute__((ext_vector_type(4))); const i32x4_ x_ = *(const LAS i32x4_*)(lds + PG8_SB(b, h) + boff8 + n * 2048), y_ = *(const LAS i32x4_*)(lds + PG8_SB(b, h) + boff8 + n * 2048 + 16); \
            dst##8[n] = __builtin_shufflevector(x_, y_, 0, 1, 2, 3, 4, 5, 6, 7); } } \
        else { _Pragma("unroll") for (int n = 0; n < 2; ++n) _Pragma("unroll") for (int k = 0; k < 2; ++k) dst[n][k] = *(const LAS bf16x8*)(lds + PG8_SB(b, h) + boff + n * 2048 + k * 1024); } } while (0)
#define PG8_MMA(ai, bj, At, Bt) do { __builtin_amdgcn_s_setprio(1); if constexpr (F8) { _Pragma("unroll") for (int m = 0; m < 4; ++m) _Pragma("unroll") for (int n = 0; n < 2; ++n) \
            acc[ai][bj][m][n] = __builtin_amdgcn_mfma_scale_f32_16x16x128_f8f6f4(Bt##8[n], At##8[m], acc[ai][bj][m][n], 0, 0, 0, 0, 0, 0); } \
        else { _Pragma("unroll") for (int m = 0; m < 4; ++m) _Pragma("unroll") for (int n = 0; n < 2; ++n) _Pragma("unroll") for (int k = 0; k < 2; ++k) \
            acc[ai][bj][m][n] = __builtin_amdgcn_mfma_f32_16x16x32_bf16(Bt[n][k], At[m][k], acc[ai][bj][m][n], 0, 0, 0); } __builtin_amdgcn_s_setprio(0); } while (0)
#define PG8_WAIT_V(n) asm volatile("s_waitcnt vmcnt(" #n ")" ::: "memory")
#define PG8_WAIT_L(n) asm volatile("s_waitcnt lgkmcnt(" #n ")" ::: "memory")
#define PG8_BAR __builtin_amdgcn_s_barrier()
#define PG8_SCHED __builtin_amdgcn_sched_barrier(0)
    Unit cur, nxt; int ui = 0;
    if (!S.next(0, cur)) return;
    f32x4 acc[2][2][4][2];
#pragma unroll
    for (int a = 0; a < 2; ++a)
#pragma unroll
        for (int b = 0; b < 2; ++b)
#pragma unroll
            for (int m = 0; m < 4; ++m)
#pragma unroll
                for (int n = 0; n < 2; ++n) acc[a][b][m][n] = (f32x4){0.f, 0.f, 0.f, 0.f};
    bf16x8 At[4][2], B0[2][2], B1[2][2]; i32x8 At8[4], B08[2], B18[2];
    unsigned voc[2][2];
    S.a_off(cur, Rr, Cc, voc);
    const int vso = VOC_OFF + wid * 2048 - 8 * wr * 1024; int csel = 0;
    if constexpr (F8) *(LAS u32x4*)(lds + vso + aoff8) = (u32x4){voc[0][0], voc[0][1], voc[1][0], voc[1][1]};
#define PG8_RDV(sel, h) (*(const LAS u32x2*)(lds + vso + aoff8 + (sel) + (h) * 8))
    const char* const aB = S.a_base();
    const char* cB = S.b_base(cur);
    PG8_STAGE(PG8_SB(0, 0), cB, voffB); PG8_STAGE(PG8_SB(0, 1), cB + hstep, voffB); PG8_STAGEA(PG8_SA(0, 0), voc[0][0], voc[0][1]); PG8_STAGEA(PG8_SA(0, 1), voc[1][0], voc[1][1]);
    if (wr == 1) PG8_BAR;
    PG8_WAIT_V(2); PG8_BAR;
    PG8_STAGE(PG8_SB(1, 0), cB + kstep, voffB); PG8_STAGEA(PG8_SA(1, 0), voc[0][0] + 128u, voc[0][1] + 128u); PG8_STAGE(PG8_SB(1, 1), cB + hstep + kstep, voffB);
    PG8_WAIT_V(6); PG8_BAR;
    for (;;) {
        const bool has_next = S.next(ui + 1, nxt);
        const char* nB = has_next ? S.b_base(nxt) : cB;
#pragma unroll 1
        for (int t = 0; t < nt; t += 2) {
            const bool last = (t == nt - 2);
            const unsigned k1b = (unsigned)(t + 1) * 128u, k2b = last ? 0u : (unsigned)(t + 2) * 128u;
            const char* b2 = last ? nB : cB + (size_t)(t + 2) * kstep; const char* b3 = b2 + kstep;
            if constexpr (F8) {
                int tl0_; asm volatile("v_mbcnt_lo_u32_b32 %0, -1, 0\n\tv_mbcnt_hi_u32_b32 %0, -1, %0" : "=v"(tl0_));
                const int fr0_ = tl0_ & 15, fq0_ = tl0_ >> 4; const int aoff8 = 8 * wr * 1024 + (fq0_ >> 1) * 1024 + ((fr0_ * 64 + 32 * (fq0_ & 1)) ^ ((fr0_ >> 3) << 5));
                const bool sw = last && has_next; const int nsel = sw ? (csel ^ 16) : csel;
                if (sw) {
                    unsigned vn[2][2]; int tl_; asm volatile("v_mbcnt_lo_u32_b32 %0, -1, 0\n\tv_mbcnt_hi_u32_b32 %0, -1, %0" : "=v"(tl_)); tl_ += wid * 64; int R2[2], C2[2];
#pragma unroll
                    for (int i = 0; i < 2; ++i) stage_rc(tl_ * 16 + i * 8192, R2[i], C2[i]);
                    S.a_off(nxt, R2, C2, vn); *(LAS u32x4*)(lds + vso + aoff8 + nsel) = (u32x4){vn[0][0], vn[0][1], vn[1][0], vn[1][1]};
                }
                { const u32x2 o_ = PG8_RDV(csel, 1);
                  PG8_LDB(B0, 0, 0); PG8_LDB(B1, 0, 1); PG8_SCHED; PG8_LDA(At, 0, 0); PG8_STAGEA(PG8_SA(1, 1), o_.x + k1b, o_.y + k1b); }
                PG8_WAIT_V(8); PG8_WAIT_L(0); PG8_BAR; PG8_MMA(0, 0, At, B0); PG8_MMA(0, 1, At, B1); PG8_BAR; PG8_SCHED;
                { const u32x2 o_ = PG8_RDV(nsel, 0);
                  PG8_LDA(At, 0, 1); PG8_STAGE(PG8_SB(0, 0), b2, voffB); PG8_STAGE(PG8_SB(0, 1), b2 + hstep, voffB); PG8_STAGEA(PG8_SA(0, 0), o_.x + k2b, o_.y + k2b); }
                PG8_WAIT_V(8); PG8_WAIT_L(0); PG8_BAR; PG8_MMA(1, 0, At, B0); PG8_MMA(1, 1, At, B1); PG8_BAR; PG8_SCHED;
                { const u32x2 o_ = PG8_RDV(nsel, 1);
                  PG8_LDB(B0, 1, 0); PG8_LDB(B1, 1, 1); PG8_SCHED; PG8_LDA(At, 1, 0); PG8_STAGEA(PG8_SA(0, 1), o_.x + k2b, o_.y + k2b); }
                PG8_WAIT_V(8); PG8_WAIT_L(0); PG8_BAR; PG8_MMA(0, 0, At, B0); PG8_MMA(0, 1, At, B1); PG8_BAR; PG8_SCHED;
                { const u32x2 o_ = PG8_RDV(nsel, 0);
                  PG8_LDA(At, 1, 1); PG8_STAGE(PG8_SB(1, 0), b3, voffB); PG8_STAGE(PG8_SB(1, 1), b3 + hstep, voffB); PG8_STAGEA(PG8_SA(1, 0), o_.x + (k2b + 128u), o_.y + (k2b + 128u)); }
                PG8_WAIT_V(8); PG8_WAIT_L(0); PG8_BAR; PG8_MMA(1, 0, At, B0); PG8_MMA(1, 1, At, B1); PG8_BAR; PG8_SCHED;
            } else {
            unsigned s00 = voc[0][0] + k2b, s01 = voc[0][1] + k2b, s10 = voc[1][0] + k2b, s11 = voc[1][1] + k2b;
            if (last && has_next) {
                unsigned vn[2][2]; int tl_; asm volatile("v_mbcnt_lo_u32_b32 %0, -1, 0\n\tv_mbcnt_hi_u32_b32 %0, -1, %0" : "=v"(tl_)); tl_ += wid * 64; int R2[2], C2[2];
#pragma unroll
                for (int i = 0; i < 2; ++i) stage_rc(tl_ * 16 + i * 8192, R2[i], C2[i]);
                S.a_off(nxt, R2, C2, vn); s00 = vn[0][0]; s01 = vn[0][1]; s10 = vn[1][0]; s11 = vn[1][1];
            }
            PG8_LDB(B0, 0, 0); PG8_LDB(B1, 0, 1); PG8_SCHED; PG8_LDA(At, 0, 0); PG8_STAGEA(PG8_SA(1, 1), voc[1][0] + k1b, voc[1][1] + k1b);
            PG8_WAIT_V(8); PG8_WAIT_L(0); PG8_BAR; PG8_MMA(0, 0, At, B0); PG8_MMA(0, 1, At, B1); PG8_BAR; PG8_SCHED;
            PG8_LDA(At, 0, 1); PG8_STAGE(PG8_SB(0, 0), b2, voffB); PG8_STAGE(PG8_SB(0, 1), b2 + hstep, voffB); PG8_STAGEA(PG8_SA(0, 0), s00, s01);
            PG8_WAIT_V(8); PG8_WAIT_L(0); PG8_BAR; PG8_MMA(1, 0, At, B0); PG8_MMA(1, 1, At, B1); PG8_BAR; PG8_SCHED;
            PG8_LDB(B0, 1, 0); PG8_LDB(B1, 1, 1); PG8_SCHED; PG8_LDA(At, 1, 0); PG8_STAGEA(PG8_SA(0, 1), s10, s11);
            PG8_WAIT_V(8); PG8_WAIT_L(0); PG8_BAR; PG8_MMA(0, 0, At, B0); PG8_MMA(0, 1, At, B1); PG8_BAR; PG8_SCHED;
            PG8_LDA(At, 1, 1); PG8_STAGE(PG8_SB(1, 0), b3, voffB); PG8_STAGE(PG8_SB(1, 1), b3 + hstep, voffB); PG8_STAGEA(PG8_SA(1, 0), s00 + 128u, s01 + 128u);
            PG8_WAIT_V(8); PG8_WAIT_L(0); PG8_BAR; PG8_MMA(1, 0, At, B0); PG8_MMA(1, 1, At, B1); PG8_BAR; PG8_SCHED;
            }
        }
        if (wr == 0) PG8_BAR;
        if constexpr (F8) { int tl_; asm volatile("v_mbcnt_lo_u32_b32 %0, -1, 0\n\tv_mbcnt_hi_u32_b32 %0, -1, %0" : "=v"(tl_)); E(acc, cur, wr, wc, tl_ & 15, tl_ >> 4); }
        else E(acc, cur, wr, wc, fr, fq);
        if (!has_next) break;
#pragma unroll
        for (int a = 0; a < 2; ++a)
#pragma unroll
            for (int b = 0; b < 2; ++b)
#pragma unroll
                for (int m = 0; m < 4; ++m)
#pragma unroll
                    for (int n = 0; n < 2; ++n) acc[a][b][m][n] = (f32x4){0.f, 0.f, 0.f, 0.f};
        cur = nxt; cB = nB; ++ui;
        if constexpr (F8) csel ^= 16;
        else { int tl_; asm volatile("v_mbcnt_lo_u32_b32 %0, -1, 0\n\tv_mbcnt_hi_u32_b32 %0, -1, %0" : "=v"(tl_)); tl_ += wid * 64; int R2[2], C2[2];
#pragma unroll
          for (int i = 0; i < 2; ++i) stage_rc(tl_ * 16 + i * 8192, R2[i], C2[i]);
          S.a_off(cur, R2, C2, voc); }
        if (wr == 1) PG8_BAR;
    }
    PG8_WAIT_V(0);
    PG8_BAR;
#undef PG8_SA
#undef PG8_SB
#undef PG8_STAGE
#undef PG8_STAGEA
#undef PG8_RDV
#undef PG8_LDA
#undef PG8_LDB
#undef PG8_MMA
#undef PG8_WAIT_V
#undef PG8_WAIT_L
#undef PG8_BAR
#undef PG8_SCHED
}

struct DenseSched {
    int nM, nN, nwg, G, c; const char* A; unsigned lda_b; const char* Bt; int K;
    __device__ __forceinline__ void init(int M, int N, int G_, int c_, const void* A_, int lda_elems, const void* Bt_, int K_) { nM = M / BM; nN = N / BM; nwg = nM * nN; G = G_; c = c_; A = (const char*)A_; lda_b = (unsigned)lda_elems * 2u; Bt = (const char*)Bt_; K = K_; }
    __device__ __forceinline__ bool next(int i, Unit& u) const {
        const long L = (long)i * G + c; if (L >= nwg) return false;
        int wgid = (int)L; { const int q = nwg / NXCD, r = nwg % NXCD, xcd = wgid % NXCD, off = wgid / NXCD; wgid = (xcd < r ? xcd * (q + 1) : r * (q + 1) + (xcd - r) * q) + off; }
        const int nig = WGM * nN, gid = wgid / nig, fm = gid * WGM, gsz = (nM - fm) < WGM ? (nM - fm) : WGM;
        u.pm = fm + ((wgid % nig) % gsz); u.pn = (wgid % nig) / gsz; u.e = 0; u.aux = 0; return true;
    }
    __device__ __forceinline__ void a_off(const Unit& u, const int (&R)[2], const int (&C)[2], unsigned (&vo)[2][2]) const {
#pragma unroll
        for (int h = 0; h < 2; ++h)
#pragma unroll
            for (int i = 0; i < 2; ++i) vo[h][i] = (unsigned)(u.pm * BM + h * HALF + R[i]) * lda_b + (unsigned)C[i] * 2u;
    }
    __device__ __forceinline__ const char* a_base() const { return A; }
    __device__ __forceinline__ const char* b_base(const Unit& u) const { return Bt + (size_t)u.pn * BM * K * 2; }
};
struct MoeSched {
    const LAS int* ulist; const LAS int* uidx; int nu; const char* A; const char* Bt; int mode  ; int quarter;
    __device__ __forceinline__ bool next(int i, Unit& u) const {
        if (i >= nu) return false;
        u.e = __builtin_amdgcn_readfirstlane(ulist[i * 4 + 0]); u.pm = __builtin_amdgcn_readfirstlane(ulist[i * 4 + 1]); u.pn = __builtin_amdgcn_readfirstlane(ulist[i * 4 + 2]); u.aux = i; return true;
    }
    __device__ __forceinline__ void a_off(const Unit& u, const int (&R)[2], const int (&C)[2], unsigned (&vo)[2][2]) const {
        if (mode == 0) {
#pragma unroll
            for (int i = 0; i < 2; ++i) { const LAS int* p = uidx + u.aux * 256 + R[i]; vo[0][i] = (unsigned)p[0] * 1024u + (unsigned)C[i] * 2u; vo[1][i] = (unsigned)p[HALF] * 1024u + (unsigned)C[i] * 2u; }
        } else {
#pragma unroll
            for (int h = 0; h < 2; ++h)
#pragma unroll
                for (int i = 0; i < 2; ++i) vo[h][i] = (unsigned)(u.pm * BM + h * HALF + R[i]) * 256u + (unsigned)C[i] * 2u;
        }
    }
    __device__ __forceinline__ const char* a_base() const { return A; }
    __device__ __forceinline__ const char* b_base(const Unit& u) const {
        return mode == 0 ? Bt + ((size_t)u.e * 512 + (size_t)u.pn * 256) * 1024 : Bt + ((size_t)u.e * 1024 + (size_t)quarter * 512 + (size_t)u.pn * 256) * 256;
    }
};

struct EpiBf16 {
    static constexpr bool PERM = true;
    bf16_t* O; int ldc; int col_tile0;
    __device__ __forceinline__ void operator()(const f32x4 (&acc)[2][2][4][2], const Unit& u, int wr, int wc, int fr, int fq) const {
        const int row0 = u.pm * BM + wr * 64 + fr; const int col0 = (col_tile0 ? 0 : u.pn * BM) + wc * 32 + 8 * fq;
#pragma unroll
        for (int ai = 0; ai < 2; ++ai)
#pragma unroll
            for (int m = 0; m < 4; ++m) { bf16_t* rowp = O + (size_t)(row0 + ai * HALF + m * 16) * ldc + col0;
#pragma unroll
                for (int bj = 0; bj < 2; ++bj) { const f32x4 v0 = acc[ai][bj][m][0], v1 = acc[ai][bj][m][1];
                    u32x4 w; w.x = cvt_pk_bf16(v0[0], v0[1]); w.y = cvt_pk_bf16(v0[2], v0[3]); w.z = cvt_pk_bf16(v1[0], v1[1]); w.w = cvt_pk_bf16(v1[2], v1[3]);
                    *(u32x4*)(rowp + bj * HALF) = w; } }
    }
};
struct EpiFp8 {
    static constexpr bool PERM = false;
    unsigned char* O; int ldc; float oscale;
    __device__ __forceinline__ void operator()(const f32x4 (&acc)[2][2][4][2], const Unit& u, int wr, int wc, int fr, int fq) const {
        const int row0 = u.pm * BM + wr * 64 + fr; const int col0 = u.pn * BM + wc * 64 + 16 * fq;
#pragma unroll
        for (int ai = 0; ai < 2; ++ai)
#pragma unroll
            for (int m = 0; m < 4; ++m) { u32x4 w;
                { const f32x4 a0 = acc[ai][0][m][0] * oscale, a1 = acc[ai][0][m][1] * oscale, b0 = acc[ai][1][m][0] * oscale, b1 = acc[ai][1][m][1] * oscale;
                  w.x = pk4_fp8(a0[0], a0[1], a0[2], a0[3]); w.y = pk4_fp8(a1[0], a1[1], a1[2], a1[3]); w.z = pk4_fp8(b0[0], b0[1], b0[2], b0[3]); w.w = pk4_fp8(b1[0], b1[1], b1[2], b1[3]); }
                *(u32x4*)(O + (unsigned)((row0 + ai * HALF + m * 16) * ldc + col0)) = w; }
    }
};
struct EpiKV {
    static constexpr bool PERM = true;
    unsigned char* K8; bf16_t* Vb;
    __device__ __forceinline__ void operator()(const f32x4 (&acc)[2][2][4][2], const Unit& u, int wr, int wc, int fr, int fq) const {
        const int row0 = u.pm * BM + wr * 64 + fr;
#pragma unroll
        for (int ai = 0; ai < 2; ++ai)
#pragma unroll
            for (int m = 0; m < 4; ++m) { const int row = row0 + ai * HALF + m * 16; int b, key;
                if (row < TL) { b = row >> 14; key = CTXL + (row & (SEQ - 1)); } else { const int rr = row - TL; b = rr >> 8; key = rr & (CTXL - 1); }
#pragma unroll
                for (int bj = 0; bj < 2; ++bj) { const int col0 = u.pn * BM + bj * HALF + wc * 32 + 8 * fq, h = col0 >> 7, j = col0 & 127;
                    const f32x4 v0 = acc[ai][bj][m][0], v1 = acc[ai][bj][m][1];
                    if (j < 64) { u32x2 w; w.x = pk4_fp8(v0[0], v0[1], v0[2], v0[3]); w.y = pk4_fp8(v1[0], v1[1], v1[2], v1[3]);
                        *(u32x2*)(K8 + ((size_t)(b * NH + h) * LK + key) * 128 + j) = w; }
                    else { u32x4 w; w.x = cvt_pk_bf16(v0[0], v0[1]); w.y = cvt_pk_bf16(v0[2], v0[3]); w.z = cvt_pk_bf16(v1[0], v1[1]); w.w = cvt_pk_bf16(v1[2], v1[3]);
                        *(u32x4*)(Vb + ((size_t)(b * NH + h) * LK + key) * DV + (j - 64)) = w; } } }
    }
};
struct EpiResid {
    static constexpr bool PERM = false;
    const float* xlat; const float* xctx; const bf16_t* xsin; bf16_t* XS; const float* mods; float gscale;
    __device__ __forceinline__ void operator()(const f32x4 (&acc)[2][2][4][2], const Unit& u, int wr, int wc, int fr, int fq) const {
        const int rowt = u.pm * BM; const int vec = rowt < SEQ ? 0 : (rowt < TL ? 1 : 2);
        const float* gate = mods + vec * 6144 + 2 * DM;
        const float* xin = rowt < TL ? xlat + (size_t)rowt * DM : xctx + (size_t)(rowt - TL) * DM;
        const bf16_t* xib = xsin + (size_t)rowt * DM;
        bf16_t* xo = XS + (size_t)rowt * DM;
        const int r0 = wr * 64 + fr, col0 = u.pn * BM + wc * 32 + 4 * fq;
        f32x4 gv[2][2];
#pragma unroll
        for (int bj = 0; bj < 2; ++bj)
#pragma unroll
            for (int n = 0; n < 2; ++n) { gv[bj][n] = *(const f32x4*)(gate + col0 + bj * HALF + n * 16); if (REP_OUT > 1) gv[bj][n] = gv[bj][n] * gscale; }
#pragma unroll
        for (int ai = 0; ai < 2; ++ai)
#pragma unroll
            for (int m = 0; m < 4; ++m) { const unsigned off = (unsigned)((r0 + ai * HALF + m * 16) * DM + col0);
#pragma unroll
                for (int bj = 0; bj < 2; ++bj)
#pragma unroll
                    for (int n = 0; n < 2; ++n) { f32x4 xv;
                        if (xsin) { const u32x2 w = *(const u32x2*)(xib + off + bj * HALF + n * 16); xv = (f32x4){bf_lo(w.x), bf_hi(w.x), bf_lo(w.y), bf_hi(w.y)}; }
                        else xv = __builtin_nontemporal_load((const f32x4*)(xin + off + bj * HALF + n * 16));
                        const f32x4 y = xv + gv[bj][n] * acc[ai][bj][m][n]; u32x2 o; o.x = cvt_pk_bf16(y.x, y.y); o.y = cvt_pk_bf16(y.z, y.w);
                        *(u32x2*)(xo + off + bj * HALF + n * 16) = o; }
                asm volatile("" ::: "memory"); }
    }
};
struct EpiLogits {
    static constexpr bool PERM = false;
    float* Lg;
    __device__ __forceinline__ void operator()(const f32x4 (&acc)[2][2][4][2], const Unit& u, int wr, int wc, int fr, int fq) const {
        if (wc >= 2) return;
        const int row0 = u.pm * BM + wr * 64 + fr, col0 = wc * 32 + 4 * fq;
#pragma unroll
        for (int ai = 0; ai < 2; ++ai)
#pragma unroll
            for (int m = 0; m < 4; ++m)
#pragma unroll
                for (int n = 0; n < 2; ++n) *(f32x4*)(Lg + (size_t)(row0 + ai * HALF + m * 16) * NE + col0 + n * 16) = acc[ai][0][m][n];
    }
};
struct EpiSwiGLU {
    static constexpr bool PERM = false;
    bf16_t* ACT; float wscale;
    __device__ __forceinline__ void operator()(const f32x4 (&acc)[2][2][4][2], const Unit& u, int wr, int wc, int fr, int fq) const {
        const unsigned off0 = (unsigned)(u.pm * BM + wr * 64 + fr) * DE + (unsigned)(u.pn * 128 + wc * 32 + 8 * fq);
#pragma unroll
        for (int ai = 0; ai < 2; ++ai)
#pragma unroll
            for (int m = 0; m < 4; ++m) { u32x2 w;
#pragma unroll
                for (int bj = 0; bj < 2; ++bj) { const f32x4 g = acc[ai][bj][m][0] * wscale, v = acc[ai][bj][m][1] * wscale;
                    w[bj] = pk4_fp8(silu_f(g[0]) * v[0], silu_f(g[1]) * v[1], silu_f(g[2]) * v[2], silu_f(g[3]) * v[3]); }
                *(u32x2*)((char*)ACT + (off0 + (unsigned)((ai * HALF + m * 16) * DE))) = w; }
    }
};
}

namespace att {
constexpr int NW = 8, QBLK = 32, KVBLK = 64, KROW = 208;
constexpr int SHM_V = KVBLK * DV * 2, SHM_K = KVBLK * KROW, OFF_K = 2 * SHM_V, OFF_WS = OFF_K + 2 * SHM_K, OFF_OST = OFF_WS + NW * 64 * 4, LDS_ATT = OFF_OST + NW * 4096;
static_assert(LDS_ATT <= LDS_WORK, "attention LDS");
constexpr float SCALE = 0.10206207261596575f;
constexpr float THR = 8.f;
#define SBAR() __builtin_amdgcn_sched_barrier(0)
__device__ __forceinline__ int crow(int r, int hi) { return (r & 3) + 8 * (r >> 2) + 4 * hi; }
__device__ __forceinline__ void partialSM(f32x16& p0, f32x16& p1, float& m_reg, float& mn, float& alpha) {
    constexpr float C = SCALE * 1.4426950408889634f;
    float pmax = p0[0];
#pragma unroll
    for (int r = 1; r < 16; ++r) pmax = fmaxf(pmax, p0[r]);
#pragma unroll
    for (int r = 0; r < 16; ++r) pmax = fmaxf(pmax, p1[r]);
    { auto rr = __builtin_amdgcn_permlane32_swap(__float_as_uint(pmax), __float_as_uint(pmax), false, false);
      pmax = fmaxf(__uint_as_float(rr[0]), __uint_as_float(rr[1])); }
    if (__builtin_expect(__all(pmax - m_reg <= THR / SCALE), 1)) { mn = m_reg; alpha = 1.f; }
    else { mn = fmaxf(m_reg, pmax); alpha = __builtin_amdgcn_exp2f((m_reg - mn) * C); m_reg = mn; }
    const float mnC = -mn * C;
#pragma unroll
    for (int r = 0; r < 16; ++r) p0[r] = fmaf(p0[r], C, mnC);
#pragma unroll
    for (int r = 0; r < 16; ++r) p1[r] = fmaf(p1[r], C, mnC);
#pragma unroll
    for (int r = 0; r < 16; ++r) p0[r] = __builtin_amdgcn_exp2f(p0[r]);
}
__device__ __forceinline__ void finishSM(f32x16& p0, f32x16& p1, float alpha, float& l_reg, bf16x8& pa0, bf16x8& pa1, bf16x8& pa2, bf16x8& pa3) {
#pragma unroll
    for (int r = 0; r < 16; ++r) p1[r] = __builtin_amdgcn_exp2f(p1[r]);
    float ps = 0;
#pragma unroll
    for (int r = 0; r < 16; ++r) ps += p0[r];
#pragma unroll
    for (int r = 0; r < 16; ++r) ps += p1[r];
    { auto rr = __builtin_amdgcn_permlane32_swap(__float_as_uint(ps), __float_as_uint(ps), false, false);
      ps = __uint_as_float(rr[0]) + __uint_as_float(rr[1]); }
    l_reg = l_reg * alpha + ps;
#define PK4(P, BASE, OUT) do { unsigned a0 = cvt_pk_bf16(P[BASE + 0], P[BASE + 1]), a1 = cvt_pk_bf16(P[BASE + 2], P[BASE + 3]);   \
    unsigned b0 = cvt_pk_bf16(P[BASE + 4], P[BASE + 5]), b1 = cvt_pk_bf16(P[BASE + 6], P[BASE + 7]);                              \
    auto r0 = __builtin_amdgcn_permlane32_swap(a0, b0, false, false); auto r1 = __builtin_amdgcn_permlane32_swap(a1, b1, false, false); \
    u32x4 w = {r0[0], r1[0], r0[1], r1[1]}; OUT = *reinterpret_cast<bf16x8*>(&w); } while (0)
    PK4(p0, 0, pa0); PK4(p0, 8, pa1); PK4(p1, 0, pa2); PK4(p1, 8, pa3);
#undef PK4
}
__device__ __forceinline__ void qkt(f32x16& p0, f32x16& p1, const LAS char* Ks, const bf16x8* qr, int r32, int hi) {
    p0 = f32x16{}; p1 = f32x16{};
#pragma unroll
    for (int d0 = 0; d0 < 6; ++d0) { const int cb = (d0 * 16 + hi * 8) * 2;
        const bf16x8 b0 = *reinterpret_cast<const LAS bf16x8*>(Ks + r32 * KROW + cb);
        const bf16x8 b1 = *reinterpret_cast<const LAS bf16x8*>(Ks + (32 + r32) * KROW + cb);
        p0 = __builtin_amdgcn_mfma_f32_32x32x16_bf16(b0, qr[d0], p0, 0, 0, 0);
        p1 = __builtin_amdgcn_mfma_f32_32x32x16_bf16(b1, qr[d0], p1, 0, 0, 0); }
}
__device__ __forceinline__ int v_st(int k, int c) { const int kk = (k & ~0xC) | ((k & 4) << 1) | ((k & 8) >> 1); return ((kk >> 3) * 2 + (c >> 5)) * 512 + ((kk & 7) * 32 + (c & 31)) * 2; }
__device__ __forceinline__ int v_rd_base(int lane) { return ((lane & 3) << 3) | (((lane >> 2) & 3) << 6) | (((lane >> 4) & 1) << 5) | (((lane >> 5) & 1) << 8); }
template <int OFF> __device__ __forceinline__ s16x4 tr_read(int vb) {
    s16x4 r; asm volatile("ds_read_b64_tr_b16 %0, %1 offset:%2" : "=&v"(r) : "v"(vb), "i"(OFF) : "memory"); return r;
}
template <int D0> __device__ __forceinline__ void pv_one(f32x16& od, int vb, bf16x8 pa0, bf16x8 pa1, bf16x8 pa2, bf16x8 pa3) {
    const s16x4 l0 = tr_read<D0 * 512 + 0 * 2048>(vb), h0 = tr_read<D0 * 512 + 0 * 2048 + 1024>(vb), l1 = tr_read<D0 * 512 + 1 * 2048>(vb), h1 = tr_read<D0 * 512 + 1 * 2048 + 1024>(vb);
    const s16x4 l2 = tr_read<D0 * 512 + 2 * 2048>(vb), h2 = tr_read<D0 * 512 + 2 * 2048 + 1024>(vb), l3 = tr_read<D0 * 512 + 3 * 2048>(vb), h3 = tr_read<D0 * 512 + 3 * 2048 + 1024>(vb);
    asm volatile("s_waitcnt lgkmcnt(0)" ::: "memory"); SBAR();
#define PK(L, H) (bf16x8){L[0], L[1], L[2], L[3], H[0], H[1], H[2], H[3]}
    od = __builtin_amdgcn_mfma_f32_32x32x16_bf16(pa0, PK(l0, h0), od, 0, 0, 0);
    od = __builtin_amdgcn_mfma_f32_32x32x16_bf16(pa1, PK(l1, h1), od, 0, 0, 0);
    od = __builtin_amdgcn_mfma_f32_32x32x16_bf16(pa2, PK(l2, h2), od, 0, 0, 0);
    od = __builtin_amdgcn_mfma_f32_32x32x16_bf16(pa3, PK(l3, h3), od, 0, 0, 0);
#undef PK
}
__device__ __forceinline__ void pv_d0(f32x16* o, int vb, bf16x8 pa0, bf16x8 pa1, bf16x8 pa2, bf16x8 pa3) {
    pv_one<0>(o[0], vb, pa0, pa1, pa2, pa3); pv_one<1>(o[1], vb, pa0, pa1, pa2, pa3);
}
__device__ __forceinline__ void attn_unit(const bf16_t* __restrict__ Qb, const bf16_t* __restrict__ Kh, const bf16_t* __restrict__ Vh, bf16_t* __restrict__ Ob, int ldo, int seq, bool rope, int pos0, LAS char* lds, const int tid) {
    const int wid = __builtin_amdgcn_readfirstlane(tid >> 6), lane = tid & 63, r32 = lane & 31, hi = lane >> 5;
    LAS char* V_lds = lds; LAS char* K_lds = lds + OFF_K;
    LAS float* ws = (LAS float*)(lds + OFF_WS) + wid * 64; LAS float* li_l = ws; LAS float* al_l = ws + 32;
    float m_reg = -1e30f, l_reg = 0; f32x16 o[2] = {}; bf16x8 qr[6];
    const bf16_t* Qw = Qb + (size_t)(wid * QBLK + r32) * 768 + hi * 8;
#pragma unroll
    for (int d0 = 0; d0 < 6; ++d0) qr[d0] = *reinterpret_cast<const bf16x8*>(Qw + d0 * 16);
    if (rope) {
        const int t = pos0 + wid * QBLK + r32;
#pragma unroll
        for (int ax = 0; ax < 2; ++ax) {
            const float pos = (float)(ax == 0 ? (t >> 6) : (t & 63));
            u32x4 mine = *reinterpret_cast<u32x4*>(&qr[4 + ax]); u32x4 oth;
#pragma unroll
            for (int j = 0; j < 4; ++j) { auto rr = __builtin_amdgcn_permlane32_swap(mine[j], mine[j], false, false); oth[j] = hi ? rr[1] : rr[0]; }
            u32x4 res;
#pragma unroll
            for (int j = 0; j < 4; ++j) {
                float cs[2], sn[2];
#pragma unroll
                for (int q = 0; q < 2; ++q) { const float ang = pos * __powf(10000.0f, -(float)(2 * j + q) * 0.125f); sn[q] = __sinf(ang); cs[q] = __cosf(ang); }
                const float m0 = bf_lo(mine[j]), m1 = bf_hi(mine[j]), o0 = bf_lo(oth[j]), o1 = bf_hi(oth[j]);
                const float r0 = hi == 0 ? m0 * cs[0] - o0 * sn[0] : m0 * cs[0] + o0 * sn[0];
                const float r1 = hi == 0 ? m1 * cs[1] - o1 * sn[1] : m1 * cs[1] + o1 * sn[1];
                res[j] = cvt_pk_bf16(r0, r1);
            }
            qr[4 + ax] = *reinterpret_cast<bf16x8*>(&res);
        }
    }
    const int vk = tid >> 3, vc = (tid & 7) * 8, vst = v_st(vk, vc);
    const int kc0 = tid, kc1 = 512 + (tid & 255); const int kst0 = (kc0 / 12) * KROW + (kc0 % 12) * 16, kst1 = (kc1 / 12) * KROW + (kc1 % 12) * 16;
    const bool k2 = wid < 4;
    const int vb0 = (int)(uintptr_t)V_lds + v_rd_base(lane);
    struct { bf16x8 vs0, ks0, ks1; } sr_[2];
#define SLOAD(i, k0) do { sr_[i].vs0 = *reinterpret_cast<const bf16x8*>(Vh + (size_t)(k0) * DV + tid * 8); sr_[i].ks0 = *reinterpret_cast<const bf16x8*>(Kh + (size_t)(k0) * DQK + kc0 * 8); \
    if (k2) sr_[i].ks1 = *reinterpret_cast<const bf16x8*>(Kh + (size_t)(k0) * DQK + kc1 * 8); } while (0)
#define SWRITE(b, i) do { *(LAS bf16x8*)(V_lds + (b) * SHM_V + vst) = sr_[i].vs0; *(LAS bf16x8*)(K_lds + (b) * SHM_K + kst0) = sr_[i].ks0; \
    if (k2) *(LAS bf16x8*)(K_lds + (b) * SHM_K + kst1) = sr_[i].ks1; } while (0)
#define RESC(a) do { if (__any((a) < 1.f)) { if (hi == 0) al_l[r32] = (a); asm volatile("s_waitcnt lgkmcnt(0)" ::: "memory"); \
    _Pragma("unroll") for (int d = 0; d < 2; ++d) _Pragma("unroll") for (int r = 0; r < 16; ++r) o[d][r] *= al_l[crow(r, hi)]; } } while (0)
    f32x16 pA0, pA1, pB0, pB1; float mnA, mnB, alA, alB; bf16x8 pa0, pa1, pa2, pa3; const int NT = seq / KVBLK;
    constexpr int SE = 0, SO = 1;
    SLOAD(SE, 0); asm volatile("s_waitcnt vmcnt(0)" ::: "memory"); SWRITE(0, SE); __syncthreads();
    qkt(pA0, pA1, K_lds, qr, r32, hi); partialSM(pA0, pA1, m_reg, mnA, alA);
    SLOAD(SO, KVBLK); if (2 < NT) SLOAD(SE, 2 * KVBLK);
    SWRITE(1, SO); __syncthreads();
    for (int j = 1; j + 1 < NT; j += 2) {
        SBAR(); qkt(pB0, pB1, K_lds + SHM_K, qr, r32, hi);
        finishSM(pA0, pA1, alA, l_reg, pa0, pa1, pa2, pa3); SBAR();
        SLOAD(SO, (j + 2) * KVBLK); SBAR();
        pv_d0(o, vb0, pa0, pa1, pa2, pa3); partialSM(pB0, pB1, m_reg, mnB, alB);
        __syncthreads(); SWRITE(0, SE);
        RESC(alB); __syncthreads();
        SBAR(); qkt(pA0, pA1, K_lds, qr, r32, hi);
        finishSM(pB0, pB1, alB, l_reg, pa0, pa1, pa2, pa3); SBAR();
        if (j + 3 < NT) SLOAD(SE, (j + 3) * KVBLK); SBAR();
        pv_d0(o, vb0 + SHM_V, pa0, pa1, pa2, pa3); partialSM(pA0, pA1, m_reg, mnA, alA);
        __syncthreads(); SWRITE(1, SO);
        RESC(alA); __syncthreads();
    }
    SBAR(); qkt(pB0, pB1, K_lds + SHM_K, qr, r32, hi);
    finishSM(pA0, pA1, alA, l_reg, pa0, pa1, pa2, pa3); SBAR();
    pv_d0(o, vb0, pa0, pa1, pa2, pa3); partialSM(pB0, pB1, m_reg, mnB, alB);
    __syncthreads(); RESC(alB);
    finishSM(pB0, pB1, alB, l_reg, pa0, pa1, pa2, pa3); SBAR();
    pv_d0(o, vb0 + SHM_V, pa0, pa1, pa2, pa3);
    if (hi == 0) li_l[r32] = l_reg; asm volatile("s_waitcnt lgkmcnt(0)" ::: "memory");
    float rli[16];
#pragma unroll
    for (int r = 0; r < 16; ++r) rli[r] = __builtin_amdgcn_rcpf(li_l[crow(r, hi)]);
    { LAS bf16_t* stg = (LAS bf16_t*)(lds + OFF_OST) + wid * 2048;
#pragma unroll
      for (int r = 0; r < 16; ++r) { const int orow = crow(r, hi);
#pragma unroll
          for (int d0 = 0; d0 < 2; ++d0) stg[orow * 64 + d0 * 32 + r32] = (bf16_t)(cvt_pk_bf16(o[d0][r] * rli[r], 0.f) & 0xffffu); }
      asm volatile("s_waitcnt lgkmcnt(0)" ::: "memory");
      bf16_t* Ow = Ob + (size_t)(wid * QBLK) * ldo;
#pragma unroll
      for (int i = 0; i < 4; ++i) { const int row = i * 8 + (lane >> 3), ch = lane & 7; const u32x4 v = *(const LAS u32x4*)(stg + row * 64 + ch * 8); *(u32x4*)(Ow + (size_t)row * ldo + ch * 8) = v; } }
    asm volatile("s_waitcnt lgkmcnt(0)" ::: "memory"); __syncthreads();
#undef SLOAD
#undef SWRITE
#undef RESC
}
}


namespace att8 {
constexpr int KROW = 144, VROW = 80, SLOT_K = 64 * KROW, SLOT_V = 64 * VROW, NSLOT = 3;
constexpr int OFF_V = NSLOT * SLOT_K, OFF_WS = OFF_V + NSLOT * SLOT_V, OFF_OST = OFF_WS + 8 * 512, LDS_ATT = OFF_OST + 8 * 8192;
static_assert(LDS_ATT <= LDS_WORK, "attention LDS");
constexpr float C2 = 0.10206207261596575f * 1.4426950408889634f;
constexpr float THR = 6.f, PSH = 2.f;
__device__ __forceinline__ int crow(int r, int hi) { return (r & 3) + 8 * (r >> 2) + 4 * hi; }
#define MFMA8(a, b, c) __builtin_amdgcn_mfma_scale_f32_32x32x64_f8f6f4(a, b, c, 0, 0, 0, 0, 0, 0)
__device__ __forceinline__ float max3f(float a, float b, float c) { float r; asm("v_max3_f32 %0, %1, %2, %3" : "=v"(r) : "v"(a), "v"(b), "v"(c)); return r; }
__device__ __forceinline__ i32x8 ld32(const LAS char* p) { const u32x4 a = *(const LAS u32x4*)p, b = *(const LAS u32x4*)(p + 16); return (i32x8){(int)a.x, (int)a.y, (int)a.z, (int)a.w, (int)b.x, (int)b.y, (int)b.z, (int)b.w}; }
__device__ __forceinline__ i32x8 softmax_blk(f32x16& p0, f32x16& p1, float& m_reg, float& l_reg, f32x16 (&o)[2], LAS float* al_l, int r32, int hi) {
    float a = fmaxf(fmaxf(p0[0], p0[1]), p1[0]), b = fmaxf(fmaxf(p0[2], p0[3]), p1[1]); a = fmaxf(fmaxf(a, p1[2]), p1[3]);
#pragma unroll
    for (int r = 4; r < 16; r += 4) { a = fmaxf(fmaxf(a, p0[r]), p0[r + 1]); b = fmaxf(fmaxf(b, p0[r + 2]), p0[r + 3]); a = fmaxf(fmaxf(a, p1[r]), p1[r + 1]); b = fmaxf(fmaxf(b, p1[r + 2]), p1[r + 3]); }
    float pmax = fmaxf(a, b);
    { auto rr = __builtin_amdgcn_permlane32_swap(__float_as_uint(pmax), __float_as_uint(pmax), false, false); pmax = fmaxf(__uint_as_float(rr[0]), __uint_as_float(rr[1])); }
    if (__builtin_expect(!__all(pmax - m_reg <= THR), 0)) {
        const float mn = fmaxf(m_reg, pmax), alpha = __builtin_amdgcn_exp2f(m_reg - mn); m_reg = mn; l_reg *= alpha;
        if (hi == 0) al_l[r32] = alpha; asm volatile("s_waitcnt lgkmcnt(0)" ::: "memory");
        int hi_ = hi; asm volatile("" : "+v"(hi_));
#pragma unroll
        for (int d = 0; d < 2; ++d)
#pragma unroll
            for (int r = 0; r < 16; ++r) o[d][r] *= al_l[crow(r, hi_)];
    }
    const float ms = m_reg - PSH;
#pragma unroll
    for (int r = 0; r < 16; ++r) { p0[r] = __builtin_amdgcn_exp2f(p0[r] - ms); p1[r] = __builtin_amdgcn_exp2f(p1[r] - ms); }
    float ps = 0.f;
#pragma unroll
    for (int r = 0; r < 16; ++r) ps += p0[r];
#pragma unroll
    for (int r = 0; r < 16; ++r) ps += p1[r];
    { auto rr = __builtin_amdgcn_permlane32_swap(__float_as_uint(ps), __float_as_uint(ps), false, false); ps = __uint_as_float(rr[0]) + __uint_as_float(rr[1]); }
    l_reg += ps;
    i32x8 pa;
#pragma unroll
    for (int w = 0; w < 4; ++w) { pa[w] = (int)pk4_fp8(p0[4 * w], p0[4 * w + 1], p0[4 * w + 2], p0[4 * w + 3]); pa[4 + w] = (int)pk4_fp8(p1[4 * w], p1[4 * w + 1], p1[4 * w + 2], p1[4 * w + 3]); }
    return pa;
}
__device__ __forceinline__ void load_q(i32x8 (&q)[2], const char* __restrict__ qbase, unsigned qoff, int hi, bool rope, int t) {
    { const u32x4* p = (const u32x4*)(qbase + (qoff + (unsigned)hi * 64u)); float f[32];
#pragma unroll
      for (int c = 0; c < 4; ++c) { const u32x4 v = p[c];
#pragma unroll
          for (int j = 0; j < 4; ++j) { f[8 * c + 2 * j] = bf_lo(v[j]) * C2; f[8 * c + 2 * j + 1] = bf_hi(v[j]) * C2; } }
#pragma unroll
      for (int w = 0; w < 8; ++w) q[0][w] = (int)pk4_fp8(f[4 * w], f[4 * w + 1], f[4 * w + 2], f[4 * w + 3]); }
    { const u32x4* p = (const u32x4*)(qbase + (qoff + 128u)); float f[32];
#pragma unroll
      for (int c = 0; c < 4; ++c) { const u32x4 v = p[c];
#pragma unroll
          for (int j = 0; j < 4; ++j) { f[8 * c + 2 * j] = bf_lo(v[j]) * C2; f[8 * c + 2 * j + 1] = bf_hi(v[j]) * C2; } }
      if (rope) {
#pragma unroll
          for (int ax = 0; ax < 2; ++ax) { const float pos = (float)(ax == 0 ? (t >> 6) : (t & 63));
#pragma unroll
              for (int j = 0; j < 8; ++j) { const float ang = pos * __powf(10000.0f, -(float)j * 0.125f); const float sn = __sinf(ang), cs = __cosf(ang);
                  const float x1 = f[16 * ax + j], x2 = f[16 * ax + 8 + j]; f[16 * ax + j] = x1 * cs - x2 * sn; f[16 * ax + 8 + j] = x2 * cs + x1 * sn; } } }
#pragma unroll
      for (int w = 0; w < 8; ++w) q[1][w] = hi ? 0 : (int)pk4_fp8(f[4 * w], f[4 * w + 1], f[4 * w + 2], f[4 * w + 3]); }
}
__device__ __forceinline__ void attn_unit(const bf16_t* __restrict__ Qb, const unsigned char* __restrict__ K8t, const unsigned char* __restrict__ VTt, bf16_t* __restrict__ Ob, int ldo, int ntile, bool rope, int pos0, int nvalid, LAS char* lds, const int tid) {
    const int wid = __builtin_amdgcn_readfirstlane(tid >> 6), lane = tid & 63, r32 = lane & 31, hi = lane >> 5;
    LAS float* wsf = (LAS float*)(lds + OFF_WS) + wid * 128;
    i32x8 qX[2], qY[2];
    { const int rx = wid * 64 + r32, ry = rx + 32; const int cx = rx < nvalid ? rx : rx % nvalid, cy = ry < nvalid ? ry : ry % nvalid;
      load_q(qX, (const char*)Qb, (unsigned)cx * 1536u, hi, rope, pos0 + rx); load_q(qY, (const char*)Qb, (unsigned)cy * 1536u, hi, rope, pos0 + ry); }
    float mX = -1e30f, mY = -1e30f, lX = 0.f, lY = 0.f; f32x16 oX[2] = {}, oY[2] = {};
    const int kst = (tid >> 3) * KROW + (tid & 7) * 16, vst = OFF_V + (tid >> 2) * VROW + (tid & 3) * 16; const bool vth = wid < 4;
    const int kfo = r32 * KROW + hi * 32, vfo = OFF_V + r32 * VROW + hi * 32;
    unsigned zz_ = 0u; asm volatile("" : "+v"(zz_));
    u32x4 sk, sv = {zz_, zz_, zz_, zz_};
    const unsigned toff = (unsigned)tid * 16u;
#define SLOAD8(t) do { sk = *(const u32x4*)(K8t + (size_t)(t) * 8192 + toff); if (vth) sv = *(const u32x4*)(VTt + (size_t)(t) * 4096 + toff); } while (0)
#define SWRITE8(s) do { *(LAS u32x4*)(lds + (s) * SLOT_K + kst) = sk; if (vth) *(LAS u32x4*)(lds + (s) * SLOT_V + vst) = sv; } while (0)
    SLOAD8(0); SWRITE8(0); if (1 < ntile) SLOAD8(1);
    int sc = 0, sn = 1;
    for (int t = 0; t < ntile; ++t) {
        __syncthreads();
        if (t + 1 < ntile) SWRITE8(sn);
        if (t + 2 < ntile) SLOAD8(t + 2);
        const LAS char* kb = lds + sc * SLOT_K + kfo; const LAS char* vb = lds + sc * SLOT_V + vfo;
        f32x16 pX0, pX1, pY0, pY1;
        { const i32x8 k0 = ld32(kb), k1 = ld32(kb + 32 * KROW); const f32x16 z = {};
          pX0 = MFMA8(k0, qX[0], z); pX1 = MFMA8(k1, qX[0], z); pY0 = MFMA8(k0, qY[0], z); pY1 = MFMA8(k1, qY[0], z); }
        { const i32x8 k0 = ld32(kb + 64), k1 = ld32(kb + 32 * KROW + 64);
          pX0 = MFMA8(k0, qX[1], pX0); pX1 = MFMA8(k1, qX[1], pX1); pY0 = MFMA8(k0, qY[1], pY0); pY1 = MFMA8(k1, qY[1], pY1); }
        const i32x8 paX = softmax_blk(pX0, pX1, mX, lX, oX, wsf, r32, hi);
        { const i32x8 v0 = ld32(vb), v1 = ld32(vb + 32 * VROW);
          oX[0] = MFMA8(paX, v0, oX[0]); oX[1] = MFMA8(paX, v1, oX[1]); }
        const i32x8 paY = softmax_blk(pY0, pY1, mY, lY, oY, wsf + 32, r32, hi);
        { const i32x8 v0 = ld32(vb), v1 = ld32(vb + 32 * VROW);
          oY[0] = MFMA8(paY, v0, oY[0]); oY[1] = MFMA8(paY, v1, oY[1]); }
        sc = sn; sn = (sn == NSLOT - 1) ? 0 : sn + 1;
    }
#undef SLOAD8
#undef SWRITE8
    if (hi == 0) { wsf[64 + r32] = lX; wsf[96 + r32] = lY; } asm volatile("s_waitcnt lgkmcnt(0)" ::: "memory");
    LAS bf16_t* stg = (LAS bf16_t*)(lds + OFF_OST) + wid * 4096;
#pragma unroll
    for (int r = 0; r < 16; ++r) { const int orow = crow(r, hi); const float rx = __builtin_amdgcn_rcpf(wsf[64 + orow]), ry = __builtin_amdgcn_rcpf(wsf[96 + orow]);
#pragma unroll
        for (int d0 = 0; d0 < 2; ++d0) { stg[orow * 64 + d0 * 32 + r32] = (bf16_t)(cvt_pk_bf16(oX[d0][r] * rx, 0.f) & 0xffffu); stg[(32 + orow) * 64 + d0 * 32 + r32] = (bf16_t)(cvt_pk_bf16(oY[d0][r] * ry, 0.f) & 0xffffu); } }
    asm volatile("s_waitcnt lgkmcnt(0)" ::: "memory");
#pragma unroll
    for (int i = 0; i < 8; ++i) { const int row = i * 8 + (lane >> 3), ch = lane & 7; const u32x4 v = *(const LAS u32x4*)(stg + row * 64 + ch * 8);
        if (wid * 64 + row < nvalid) *(u32x4*)(Ob + (size_t)(wid * 64 + row) * ldo + ch * 8) = v; }
    asm volatile("s_waitcnt lgkmcnt(0)" ::: "memory"); __syncthreads();
}
#undef MFMA8

__device__ __forceinline__ void sm_max(f32x16& p0, f32x16& p1, float& m_reg, float& l_reg, f32x16 (&o)[2], i32x8& qpad, LAS float* al_l, int r32, int hi, bool first) {
    float a = fmaxf(fmaxf(p0[0], p0[1]), p1[0]), b = fmaxf(fmaxf(p0[2], p0[3]), p1[1]); a = fmaxf(fmaxf(a, p1[2]), p1[3]);
#pragma unroll
    for (int r = 4; r < 16; r += 4) { a = fmaxf(fmaxf(a, p0[r]), p0[r + 1]); b = fmaxf(fmaxf(b, p0[r + 2]), p0[r + 3]); a = fmaxf(fmaxf(a, p1[r]), p1[r + 1]); b = fmaxf(fmaxf(b, p1[r + 2]), p1[r + 3]); }
    float pmax = fmaxf(a, b);
    { auto rr = __builtin_amdgcn_permlane32_swap(__float_as_uint(pmax), __float_as_uint(pmax), false, false); pmax = fmaxf(__uint_as_float(rr[0]), __uint_as_float(rr[1])); }
    if (__builtin_expect(first || !__all(pmax <= THR + PSH), 0)) {
        const float tm = ceilf(pmax + (m_reg - PSH)); float x = (first ? tm : fmaxf(m_reg, tm)) - PSH;
        const unsigned qb_ = __builtin_amdgcn_cvt_pk_fp8_f32(-x, 0.f, 0u, false) & 0xffu; x = -__builtin_amdgcn_cvt_f32_fp8((int)qb_, 0);
        const float mn = x + PSH, d = mn - m_reg, alpha = __builtin_amdgcn_exp2f(-d); m_reg = mn; l_reg *= alpha;
        if (hi == 0) al_l[r32] = alpha; asm volatile("s_waitcnt lgkmcnt(0)" ::: "memory");
        int hi_ = hi; asm volatile("" : "+v"(hi_));
#pragma unroll
        for (int dd = 0; dd < 2; ++dd)
#pragma unroll
            for (int r = 0; r < 16; ++r) o[dd][r] *= al_l[crow(r, hi_)];
#pragma unroll
        for (int r = 0; r < 16; ++r) { p0[r] -= d; p1[r] -= d; }
        if (hi_) qpad[0] = (int)qb_;
    }
}
__device__ __forceinline__ i32x8 sm_exp(f32x16& p0, f32x16& p1, const float m_reg, float& l_reg) {
    const float ms = m_reg - PSH;
#pragma unroll
    for (int r = 0; r < 16; ++r) { p0[r] = __builtin_amdgcn_exp2f(p0[r] - ms); p1[r] = __builtin_amdgcn_exp2f(p1[r] - ms); }
    float ps = 0.f;
#pragma unroll
    for (int r = 0; r < 16; ++r) ps += p0[r];
#pragma unroll
    for (int r = 0; r < 16; ++r) ps += p1[r];
    { auto rr = __builtin_amdgcn_permlane32_swap(__float_as_uint(ps), __float_as_uint(ps), false, false); ps = __uint_as_float(rr[0]) + __uint_as_float(rr[1]); }
    l_reg += ps;
    i32x8 pa;
#pragma unroll
    for (int w = 0; w < 4; ++w) { pa[w] = (int)pk4_fp8(p0[4 * w], p0[4 * w + 1], p0[4 * w + 2], p0[4 * w + 3]); pa[4 + w] = (int)pk4_fp8(p1[4 * w], p1[4 * w + 1], p1[4 * w + 2], p1[4 * w + 3]); }
    return pa;
}
#define MFMA8(a, b, c) __builtin_amdgcn_mfma_scale_f32_32x32x64_f8f6f4(a, b, c, 0, 0, 0, 0, 0, 0)
#ifndef ATT_FENCE
#define ATT_FENCE 1
#endif
#if ATT_FENCE
#define SB0() __builtin_amdgcn_sched_barrier(0)
#else
#define SB0() do {} while (0)
#endif
#define ATT_EXP(x) (VAR == 1 ? (x) * 1.0009765625f : __builtin_amdgcn_exp2f(x))
#define SM_CHUNK(P0, P1, PA, PS, c) do { if constexpr (VAR == 3) { PA[c] = __float_as_int(P0[4 * (c)]); PA[4 + (c)] = __float_as_int(P1[4 * (c)]); } else { \
    _Pragma("unroll") for (int r_ = 4 * (c); r_ < 4 * (c) + 4; ++r_) { P0[r_] = ATT_EXP(P0[r_]); P1[r_] = ATT_EXP(P1[r_]); } \
    _Pragma("unroll") for (int r_ = 4 * (c); r_ < 4 * (c) + 4; ++r_) { PS += P0[r_]; PS += P1[r_]; } \
    PA[c] = (int)pk4_fp8(P0[4 * (c)], P0[4 * (c) + 1], P0[4 * (c) + 2], P0[4 * (c) + 3]); PA[4 + (c)] = (int)pk4_fp8(P1[4 * (c)], P1[4 * (c) + 1], P1[4 * (c) + 2], P1[4 * (c) + 3]); } } while (0)
__device__ __forceinline__ void sm_rescale(f32x16& p0, f32x16& p1, i32x8& pa, float& s_row, float& m_reg, float& l_reg, f32x16 (&o)[2], i32x8& qpad, LAS float* al_l, int r32, int hi, bool first) {
    float d = ceilf(__log2f(fmaxf(s_row, 1e-30f))) - 4.f; d = fminf(fmaxf(d, first ? -100.f : 0.f), 100.f);
    const float xo = m_reg - PSH; const float xn = xo + d;
    unsigned qb_ = __builtin_amdgcn_cvt_pk_fp8_f32(-xn, 0.f, 0u, false) & 0xffu; float xq = -__builtin_amdgcn_cvt_f32_fp8((int)qb_, 0);
    if (xq < xn) { const float st = __builtin_amdgcn_exp2f(floorf(__log2f(fabsf(xq) + 1e-9f)) - 3.f); qb_ = __builtin_amdgcn_cvt_pk_fp8_f32(-(xq + st), 0.f, 0u, false) & 0xffu; xq = -__builtin_amdgcn_cvt_f32_fp8((int)qb_, 0); }
    const float dd = xq - xo, f = __builtin_amdgcn_exp2f(-dd);
    m_reg = xq + PSH; l_reg *= f; s_row *= f;
    if (hi == 0) al_l[r32] = f; asm volatile("s_waitcnt lgkmcnt(0)" ::: "memory");
    int hi_ = hi; asm volatile("" : "+v"(hi_));
#pragma unroll
    for (int dq = 0; dq < 2; ++dq)
#pragma unroll
        for (int r = 0; r < 16; ++r) o[dq][r] *= al_l[crow(r, hi_)];
#pragma unroll
    for (int r = 0; r < 16; ++r) { p0[r] *= f; p1[r] *= f; }
#pragma unroll
    for (int w = 0; w < 4; ++w) { pa[w] = (int)pk4_fp8(p0[4 * w], p0[4 * w + 1], p0[4 * w + 2], p0[4 * w + 3]); pa[4 + w] = (int)pk4_fp8(p1[4 * w], p1[4 * w + 1], p1[4 * w + 2], p1[4 * w + 3]); }
    if (hi_) qpad[0] = (int)qb_;
}
#define SM_FIN(PS, L, P0, P1, PA, M, O, QP, AL, FIRST) do { float s_ = PS; { auto rr_ = __builtin_amdgcn_permlane32_swap(__float_as_uint(s_), __float_as_uint(s_), false, false); s_ = __uint_as_float(rr_[0]) + __uint_as_float(rr_[1]); } \
    if (__builtin_expect((FIRST) || !__all(s_ <= 256.f), 0)) sm_rescale(P0, P1, PA, s_, M, L, O, QP, AL, r32, hi, FIRST); \
    L += s_; } while (0)
template <int VAR> __device__ __forceinline__ f32x16 mfv(const i32x8& a, const i32x8& b, f32x16 c) {
    if constexpr (VAR == 2) { asm volatile("" : "+v"(c)); return c; } else return __builtin_amdgcn_mfma_scale_f32_32x32x64_f8f6f4(a, b, c, 0, 0, 0, 0, 0, 0);
}
template <int VAR = 0>
__device__ __forceinline__ void attn_unit_p(const bf16_t* __restrict__ Qb, const unsigned char* __restrict__ K8t, const unsigned char* __restrict__ VTt, bf16_t* __restrict__ Ob, int ldo, int ntile, bool rope, int pos0, int nvalid, LAS char* lds, const int tid) {
#define MF(a, b, c) mfv<VAR>(a, b, c)
#define MFZ(a, b, cold) (VAR == 2 ? mfv<VAR>(a, b, cold) : mfv<VAR>(a, b, z))

    const int wid = __builtin_amdgcn_readfirstlane(tid >> 6), lane = tid & 63, r32 = lane & 31, hi = lane >> 5;
    LAS float* wsf = (LAS float*)(lds + OFF_WS) + wid * 128;
    i32x8 qX[2], qY[2];
    { const int rx = wid * 64 + r32, ry = rx + 32; const int cx = rx < nvalid ? rx : rx % nvalid, cy = ry < nvalid ? ry : ry % nvalid;
      load_q(qX, (const char*)Qb, (unsigned)cx * 1536u, hi, rope, pos0 + rx); load_q(qY, (const char*)Qb, (unsigned)cy * 1536u, hi, rope, pos0 + ry); }
    if (wid >= 4) __builtin_amdgcn_s_setprio(1);
    float mX = 0.f, mY = 0.f, lX = 0.f, lY = 0.f; f32x16 oX[2] = {}, oY[2] = {};
    { const unsigned qb_ = __builtin_amdgcn_cvt_pk_fp8_f32(PSH, 0.f, 0u, false) & 0xffu; if (hi) { qX[1][0] = (int)qb_; qY[1][0] = (int)qb_; } }
    const int kst = (tid >> 3) * KROW + (tid & 7) * 16, vst = OFF_V + (tid >> 2) * VROW + (tid & 3) * 16; const bool vth = wid < 4;
    const int kfo = r32 * KROW + hi * 32, vfo = OFF_V + r32 * VROW + hi * 32;
    const unsigned toff = (unsigned)tid * 16u;
    unsigned zz_ = 0u; asm volatile("" : "+v"(zz_));
    u32x4 sk, sv = {zz_, zz_, zz_, zz_};
#define LDK(t) (sk = *(const u32x4*)(K8t + (size_t)(t) * 8192 + toff))
#define LDV(t) do { if (vth) sv = *(const u32x4*)(VTt + (size_t)(t) * 4096 + toff); } while (0)
#define WRK(s) (*(LAS u32x4*)(lds + (s) * SLOT_K + kst) = sk)
#define WRV(s) do { if (vth) *(LAS u32x4*)(lds + (s) * SLOT_V + vst) = sv; } while (0)
    LDK(0); LDV(0); WRK(0); WRV(0); if (1 < ntile) { LDK(1); WRK(1); } if (2 < ntile) LDK(2); if (1 < ntile) LDV(1);
    if (tid < 320) *(LAS u32x4*)(lds + OFF_V + 2 * SLOT_V + tid * 16) = (u32x4){zz_, zz_, zz_, zz_};
    __syncthreads();
    f32x16 pX0, pX1, pY0, pY1; i32x8 paX, paY = {};
    i32x8 kc0, kc1;
    { const LAS char* kb = lds + kfo; const f32x16 z = {};
      kc0 = ld32(kb); kc1 = ld32(kb + 32 * KROW); pX0 = MFZ(kc0, qX[0], pX0); pX1 = MFZ(kc1, qX[0], pX1);
      { const i32x8 k0 = ld32(kb + 64), k1 = ld32(kb + 32 * KROW + 64); pX0 = MF(k0, qX[1], pX0); pX1 = MF(k1, qX[1], pX1); } }
    int s0 = 0, s1 = 1, s2 = 2;
    for (int t = 0; t < ntile; ++t) {
        if constexpr (VAR != 4) __syncthreads();
        i32x8 w0, w1;
        {   const LAS char* vb = lds + s2 * SLOT_V + vfo; const LAS char* kb = lds + s0 * SLOT_K + kfo; const LAS char* vb2 = lds + s0 * SLOT_V + vfo; const f32x16 z = {};
            float ps = 0.f; SB0();
            pY0 = MFZ(kc0, qY[0], pY0); const i32x8 k2 = ld32(kb + 64);
            if (t + 2 < ntile) WRK(s2); if (t + 1 < ntile) WRV(s1);
            if (t + 3 < ntile) LDK(t + 3); if (t + 2 < ntile) LDV(t + 2);
            SM_CHUNK(pX0, pX1, paX, ps, 0); SB0();
            pY1 = MFZ(kc1, qY[0], pY1); const i32x8 k3 = ld32(kb + 32 * KROW + 64);
            SM_CHUNK(pX0, pX1, paX, ps, 1); SB0();
            pY0 = MF(k2, qY[1], pY0); const i32x8 v0 = ld32(vb);
            SM_CHUNK(pX0, pX1, paX, ps, 2); SB0();
            pY1 = MF(k3, qY[1], pY1); const i32x8 v1 = ld32(vb + 32 * VROW);
            SM_CHUNK(pX0, pX1, paX, ps, 3); SB0();
            oY[0] = MF(paY, v0, oY[0]); w0 = ld32(vb2); oY[1] = MF(paY, v1, oY[1]); w1 = ld32(vb2 + 32 * VROW);
            SM_FIN(ps, lX, pX0, pX1, paX, mX, oX, qX[1], wsf, t == 0); SB0();
        }
        {   const LAS char* kb = lds + s1 * SLOT_K + kfo; const f32x16 z = {};
            float ps = 0.f; SB0();
            oX[0] = MF(paX, w0, oX[0]); kc0 = ld32(kb);
            SM_CHUNK(pY0, pY1, paY, ps, 0); SB0();
            oX[1] = MF(paX, w1, oX[1]); kc1 = ld32(kb + 32 * KROW);
            SM_CHUNK(pY0, pY1, paY, ps, 1); SB0();
            pX0 = MFZ(kc0, qX[0], pX0); const i32x8 k2 = ld32(kb + 64);
            SM_CHUNK(pY0, pY1, paY, ps, 2); SB0();
            pX1 = MFZ(kc1, qX[0], pX1); const i32x8 k3 = ld32(kb + 32 * KROW + 64);
            SM_CHUNK(pY0, pY1, paY, ps, 3); SB0();
            pX0 = MF(k2, qX[1], pX0); pX1 = MF(k3, qX[1], pX1);
            SM_FIN(ps, lY, pY0, pY1, paY, mY, oY, qY[1], wsf + 32, t == 0); SB0();
        }
        { const int ts = s0; s0 = s1; s1 = s2; s2 = ts; }
    }
    { const LAS char* vb = lds + s2 * SLOT_V + vfo; const i32x8 v0 = ld32(vb), v1 = ld32(vb + 32 * VROW); oY[0] = MF(paY, v0, oY[0]); oY[1] = MF(paY, v1, oY[1]); }
#undef LDK
#undef LDV
#undef WRK
#undef WRV
    if (hi == 0) { wsf[64 + r32] = lX; wsf[96 + r32] = lY; } asm volatile("s_waitcnt lgkmcnt(0)" ::: "memory");
    LAS bf16_t* stg = (LAS bf16_t*)(lds + OFF_OST) + wid * 4096;
#pragma unroll
    for (int r = 0; r < 16; ++r) { const int orow = crow(r, hi); const float rx = __builtin_amdgcn_rcpf(wsf[64 + orow]), ry = __builtin_amdgcn_rcpf(wsf[96 + orow]);
#pragma unroll
        for (int d0 = 0; d0 < 2; ++d0) { stg[orow * 64 + d0 * 32 + r32] = (bf16_t)(cvt_pk_bf16(oX[d0][r] * rx, 0.f) & 0xffffu); stg[(32 + orow) * 64 + d0 * 32 + r32] = (bf16_t)(cvt_pk_bf16(oY[d0][r] * ry, 0.f) & 0xffffu); } }
    asm volatile("s_waitcnt lgkmcnt(0)" ::: "memory");
#pragma unroll
    for (int i = 0; i < 8; ++i) { const int row = i * 8 + (lane >> 3), ch = lane & 7; const u32x4 v = *(const LAS u32x4*)(stg + row * 64 + ch * 8);
        if (wid * 64 + row < nvalid) *(u32x4*)((char*)Ob + (unsigned)(((wid * 64 + row) * ldo + ch * 8) * 2)) = v; }
    asm volatile("s_waitcnt lgkmcnt(0)" ::: "memory"); __builtin_amdgcn_s_setprio(0); __syncthreads();
}
#undef SB0
#undef MF
#undef MFZ
#undef ATT_EXP
#undef SM_CHUNK
#undef SM_FIN
#undef MFMA8
}

namespace dft {
__device__ __forceinline__ int v_st8(int k, int c) { const int kk = (k & ~0xC) | ((k & 4) << 1) | ((k & 8) >> 1); return ((kk >> 3) * 8 + (c >> 5)) * 512 + ((kk & 7) * 32 + (c & 31)) * 2; }
template <int MODE, int K>
__device__ __forceinline__ void unit(LAS char* lds, const bf16_t* __restrict__ F, const char* __restrict__ in, size_t in_stride, char* __restrict__ dst, int p0, int p1, const int tid) {
    const int wid = __builtin_amdgcn_readfirstlane(tid >> 6), lane = tid & 63, r32 = lane & 31, hi = lane >> 5;
    { constexpr int NJ = K / 16; bf16x8 v[NJ];
#pragma unroll
      for (int j = 0; j < NJ; ++j) v[j] = *reinterpret_cast<const bf16x8*>(in + (size_t)((tid >> 5) + 16 * j) * in_stride + (tid & 31) * 16);
#pragma unroll
      for (int j = 0; j < NJ; ++j) *(LAS bf16x8*)(lds + v_st8((tid >> 5) + 16 * j, (tid & 31) * 8)) = v[j];
    }
    __syncthreads();
    f32x16 acc[8];
#pragma unroll
    for (int d = 0; d < 8; ++d) acc[d] = f32x16{};
    const int vb0 = (int)(uintptr_t)lds + att::v_rd_base(lane);
    const bf16_t* Fw = F + (size_t)(wid * 32 + r32) * K + hi * 8;
#pragma unroll 1
    for (int ks = 0; ks < K / 16; ++ks) {
        const bf16x8 a = *reinterpret_cast<const bf16x8*>(Fw + ks * 16);
        const int vb = vb0 + ks * 8192;
        {   s16x4 lo[4], hh[4];
            lo[0] = att::tr_read<0 * 512>(vb); hh[0] = att::tr_read<0 * 512 + 4096>(vb); lo[1] = att::tr_read<1 * 512>(vb); hh[1] = att::tr_read<1 * 512 + 4096>(vb);
            lo[2] = att::tr_read<2 * 512>(vb); hh[2] = att::tr_read<2 * 512 + 4096>(vb); lo[3] = att::tr_read<3 * 512>(vb); hh[3] = att::tr_read<3 * 512 + 4096>(vb);
            asm volatile("s_waitcnt lgkmcnt(0)" ::: "memory"); __builtin_amdgcn_sched_barrier(0);
#pragma unroll
            for (int d = 0; d < 4; ++d) { const bf16x8 b = (bf16x8){lo[d][0], lo[d][1], lo[d][2], lo[d][3], hh[d][0], hh[d][1], hh[d][2], hh[d][3]};
                acc[d] = __builtin_amdgcn_mfma_f32_32x32x16_bf16(a, b, acc[d], 0, 0, 0); } }
        {   s16x4 lo[4], hh[4];
            lo[0] = att::tr_read<4 * 512>(vb); hh[0] = att::tr_read<4 * 512 + 4096>(vb); lo[1] = att::tr_read<5 * 512>(vb); hh[1] = att::tr_read<5 * 512 + 4096>(vb);
            lo[2] = att::tr_read<6 * 512>(vb); hh[2] = att::tr_read<6 * 512 + 4096>(vb); lo[3] = att::tr_read<7 * 512>(vb); hh[3] = att::tr_read<7 * 512 + 4096>(vb);
            asm volatile("s_waitcnt lgkmcnt(0)" ::: "memory"); __builtin_amdgcn_sched_barrier(0);
#pragma unroll
            for (int d = 0; d < 4; ++d) { const bf16x8 b = (bf16x8){lo[d][0], lo[d][1], lo[d][2], lo[d][3], hh[d][0], hh[d][1], hh[d][2], hh[d][3]};
                acc[4 + d] = __builtin_amdgcn_mfma_f32_32x32x16_bf16(a, b, acc[4 + d], 0, 0, 0); } }
    }
    if (MODE == 0) {
#pragma unroll
        for (int g = 0; g < 2; ++g)
#pragma unroll
            for (int i = 0; i < 4; ++i) { const int k1 = 16 * wid + 8 * g + 4 * hi + i; float sn, cs; sincospif((float)(k1 * p1) * (1.0f / 8192.0f), &sn, &cs);
#pragma unroll
                for (int d = 0; d < 8; ++d) { const float yr = acc[d][8 * g + i], yi = acc[d][8 * g + 4 + i]; acc[d][8 * g + i] = yr * cs + yi * sn; acc[d][8 * g + 4 + i] = yi * cs - yr * sn; } }
    }
    __syncthreads();
    LAS bf16_t* stg = (LAS bf16_t*)lds + wid * 8192;
#pragma unroll
    for (int r = 0; r < 16; ++r) { const int orow = att::crow(r, hi);
#pragma unroll
        for (int d = 0; d < 8; ++d) stg[orow * 256 + d * 32 + r32] = (bf16_t)(cvt_pk_bf16(acc[d][r], 0.f) & 0xffffu); }
    asm volatile("s_waitcnt lgkmcnt(0)" ::: "memory");
#pragma unroll
    for (int it = 0; it < 16; ++it) { const int id = it * 64 + lane, rho = id >> 5, ch = id & 31; const u32x4 v = *(const LAS u32x4*)(stg + rho * 256 + ch * 8);
        size_t off;
        if (MODE == 0) { const int part = (rho >> 3) & 1, k1 = 16 * wid + (((rho >> 4) << 3) | (rho & 7)); off = ((((size_t)p0 * 128 + k1) * 128 + p1) * 2 + part) * 512; }
        else if (MODE == 1) { const int m = wid * 32 + rho, zp = m >> 7, k2 = m & 127; off = ((size_t)(p0 * SEQ + p1 + 128 * k2) * NINP + 256 + zp * 256) * 2; }
        else { const int m = wid * 32 + rho; off = ((size_t)(TL + p0 * CTXL + m) * NINP + 256 + p1 * 256) * 2; }
        *(u32x4*)(dst + off + ch * 16) = v; }
    asm volatile("s_waitcnt lgkmcnt(0)" ::: "memory"); __syncthreads();
}
}


#ifndef SELFCHECK
#define SELFCHECK 0
#endif
#ifndef SELFCHECK_REPORT
#define SELFCHECK_REPORT 1
#endif
#if SELFCHECK
constexpr int CW_CHK = 64;
__device__ __forceinline__ float fp8q(float x) { const unsigned w = __builtin_amdgcn_cvt_pk_fp8_f32(x, 0.f, 0u, false); return __builtin_amdgcn_cvt_f32_fp8((int)w, 0); }
__device__ __forceinline__ float bf2f(bf16_t v) { return __uint_as_float(((unsigned)v) << 16); }
__device__ __forceinline__ float chk_invfreq(int j) { return j == 0 ? 1.0f : j == 1 ? 0.316227766f : j == 2 ? 0.1f : j == 3 ? 0.0316227766f : j == 4 ? 0.01f : j == 5 ? 0.00316227766f : j == 6 ? 0.001f : 0.000316227766f; }
__device__ __forceinline__ void chk_sincos(float a, float& s, float& c) { const float k = rintf(a * 0.15915494309189535f); float r = fmaf(-k, 6.28125f, a); r = fmaf(-k, 1.9353071795864769e-3f, r); s = __sinf(r); c = __cosf(r); }
__device__ __forceinline__ void selfcheck_attn(int l, const bf16_t* Q, const unsigned char* K8, const bf16_t* Vb, const unsigned char* VT8, const bf16_t* YA, const bf16_t* Ub, const bf16_t* WuqT, const bf16_t* WukvT, unsigned* flag, LAS float* sm, int wave_g, int lane) {
    if (wave_g < 32) {
        const int i = wave_g, b = i & 1, h = (i >> 1) & 7, t = (i * 521 + 37 + 4099 * (i >> 4)) & (SEQ - 1); const int row = b * SEQ + t;
        LAS float* q = sm;
        for (int d = lane; d < 96; d += 64) q[d] = bf2f(Q[(size_t)row * 768 + h * 96 + d]);
        __builtin_amdgcn_s_waitcnt(0);
        float nv[2] = {0.f, 0.f};
        if (lane < 16) { const int ax = lane >> 3, j = lane & 7; const float pos = (float)(ax == 0 ? (t >> 6) : (t & 63)); const float ang = pos * chk_invfreq(j);
            float cs, sn; chk_sincos(ang, sn, cs); const float x1 = q[64 + 16 * ax + j], x2 = q[64 + 16 * ax + 8 + j]; nv[0] = x1 * cs - x2 * sn; nv[1] = x2 * cs + x1 * sn; }
        __builtin_amdgcn_s_waitcnt(0);
        if (lane < 16) { const int ax = lane >> 3, j = lane & 7; q[64 + 16 * ax + j] = nv[0]; q[64 + 16 * ax + 8 + j] = nv[1]; }
        __builtin_amdgcn_s_waitcnt(0);
        for (int d = lane; d < 96; d += 64) q[d] = fp8q(q[d] * (0.10206207261596575f * 1.4426950408889634f));
        __builtin_amdgcn_s_waitcnt(0);
        const unsigned char* Kh = K8 + (size_t)(b * NH + h) * LK * 128; const bf16_t* Vh = Vb + (size_t)(b * NH + h) * LK * DV;
        float mx = -1e30f, m0 = -1e30f;
        for (int k0 = 0; k0 < LK; k0 += 64) { const unsigned char* kr = Kh + (size_t)(k0 + lane) * 128; float s = 0.f;
            for (int d = 0; d < 96; d += 4) { const unsigned w = *(const unsigned*)(kr + d);
                s += q[d] * __builtin_amdgcn_cvt_f32_fp8((int)w, 0) + q[d + 1] * __builtin_amdgcn_cvt_f32_fp8((int)w, 1) + q[d + 2] * __builtin_amdgcn_cvt_f32_fp8((int)w, 2) + q[d + 3] * __builtin_amdgcn_cvt_f32_fp8((int)w, 3); }
            mx = fmaxf(mx, s); if (k0 == 0) m0 = s; }
        for (int o = 1; o < 64; o <<= 1) { mx = fmaxf(mx, shx(mx, o, lane)); m0 = fmaxf(m0, shx(m0, o, lane)); }
        const float mref = ceilf(m0); const bool skip = (mx - mref) > 5.9f;
        float acc[64]; float lsum = 0.f;
#pragma unroll
        for (int d = 0; d < 64; ++d) acc[d] = 0.f;
        for (int k0 = 0; k0 < LK; k0 += 64) { const unsigned char* kr = Kh + (size_t)(k0 + lane) * 128; float s = 0.f;
            for (int d = 0; d < 96; d += 4) { const unsigned w = *(const unsigned*)(kr + d);
                s += q[d] * __builtin_amdgcn_cvt_f32_fp8((int)w, 0) + q[d + 1] * __builtin_amdgcn_cvt_f32_fp8((int)w, 1) + q[d + 2] * __builtin_amdgcn_cvt_f32_fp8((int)w, 2) + q[d + 3] * __builtin_amdgcn_cvt_f32_fp8((int)w, 3); }
            const float p = __builtin_amdgcn_exp2f(s - (mref - 2.0f)); lsum += p; const float pq = fp8q(p); const bf16_t* vr = Vh + (size_t)(k0 + lane) * DV;
#pragma unroll
            for (int d = 0; d < 64; ++d) acc[d] += pq * fp8q(bf2f(vr[d])); }
        lsum = wave_sum(lsum, lane);
        float worst = 0.f;
#pragma unroll
        for (int d = 0; d < 64; ++d) { const float o = wave_sum(acc[d], lane) / lsum; const float got = bf2f(YA[(size_t)row * NINP + 768 + h * 64 + d]); worst = fmaxf(worst, fabsf(got - o) - 0.0042f * fabsf(o)); }
        if (skip) worst = 0.f;
        if (lane == 0) atomicMax(flag + 1 + l, (unsigned)(worst * 1.0e6f));
        if (lane == 0 && !(worst < 3e-3f)) atomicOr(flag, 1u << l);
    }
    else if (wave_g < 64) {
        const int i = wave_g - 32, b = i & 1, t = (i * 977 + 13) & (SEQ - 1); const int row = b * SEQ + t, key = CTXL + t;
        unsigned bad = 0;
        if (lane < 32) { const int d = lane, ax = d >> 4, j = d & 7, second = (d >> 3) & 1; const float pos = (float)(ax == 0 ? (t >> 6) : (t & 63)); const float ang = pos * chk_invfreq(j);
            float cs, sn; chk_sincos(ang, sn, cs); const float x1 = bf2f(Ub[(size_t)row * NINP + COL_KR + 16 * ax + j]), x2 = bf2f(Ub[(size_t)row * NINP + COL_KR + 16 * ax + 8 + j]);
            const float ref = second ? x2 * cs + x1 * sn : x1 * cs - x2 * sn; const float rq = fp8q(ref);
            for (int h = 0; h < NH; ++h) { const unsigned char* kr = K8 + ((size_t)(b * NH + h) * LK + key) * 128; const float got = __builtin_amdgcn_cvt_f32_fp8((int)kr[64 + d], 0);
                if (fabsf(got - rq) > 0.13f * fabsf(rq) + 1e-3f) bad |= 1u; if (kr[96 + d] != (d == 0 ? 0x38 : 0)) bad |= 2u; } }
        { const int h = lane & 7, jj = lane >> 3; float ak = 0.f, av = 0.f, aq = 0.f; const int jk = jj & 3; const int qd = (jj < 4) ? jj : 88 + jj;
          for (int k = 0; k < 256; ++k) { const float u = bf2f(Ub[(size_t)row * NINP + COL_KV + k]); ak += u * bf2f(WukvT[(size_t)(h * 128 + 17 * jk) * 256 + k]); av += u * bf2f(WukvT[(size_t)(h * 128 + 64 + 15 * jk) * 256 + k]); }
          for (int k = 0; k < 384; ++k) aq += bf2f(Ub[(size_t)row * NINP + COL_Q + k]) * bf2f(WuqT[(size_t)(h * 96 + qd) * 384 + k]);
          const float gk = __builtin_amdgcn_cvt_f32_fp8((int)K8[((size_t)(b * NH + h) * LK + key) * 128 + 17 * jk], 0), gv = bf2f(Vb[((size_t)(b * NH + h) * LK + key) * DV + 15 * jk]), gq = bf2f(Q[(size_t)row * 768 + h * 96 + qd]);
          if (fabsf(gk - ak) > 0.08f * fabsf(ak) + 0.02f) bad |= 4u; if (fabsf(gv - av) > 0.02f * fabsf(av) + 0.01f) bad |= 8u; if (fabsf(gq - aq) > 0.02f * fabsf(aq) + 0.01f) bad |= 16u;
          const int tl = key >> 6, kin = key & 63, kk = kin & 31, khi = (kk >> 2) & 1, kr_ = (kk & 3) + 4 * (kk >> 3), kpos = khi * 32 + (kin >> 5) * 16 + kr_;
          const float gt = __builtin_amdgcn_cvt_f32_fp8((int)VT8[((size_t)(b * NH + h) * 260 + tl) * 4096 + (15 * jk) * 64 + kpos], 0);
          if (gt != fp8q(gv)) bad |= 32u; }
        if (bad) atomicOr(flag, bad << (8 + 8 * l));
    }
}
#endif
__device__ __forceinline__ void tr_item(const float* __restrict__ W, int ldS, const float* __restrict__ rs, bf16_t* __restrict__ WT, int ldD, int col0D, int nblk, int rowmode, LAS float* scr, int item, int lane, float f8scale = 0.f) {
    const int kb = item / nblk, nb = item % nblk, k0 = 64 * kb, n0 = 32 * nb;
#pragma unroll
    for (int i = 0; i < 32; ++i) { const int kk = 2 * i + (lane >> 5); float v = W[(size_t)(k0 + kk) * ldS + n0 + (lane & 31)]; if (rs) v *= rs[k0 + kk]; scr[kk * 33 + (lane & 31)] = v; }
    LDS_WAIT(); asm volatile("" ::: "memory");
    const int c = lane & 7;
#pragma unroll
    for (int j = 0; j < 4; ++j) { const int n = (lane >> 3) + 8 * j; const LAS float* s = scr + (8 * c) * 33 + n;
        u32x4 o; o.x = cvt_pk_bf16(s[0 * 33], s[1 * 33]); o.y = cvt_pk_bf16(s[2 * 33], s[3 * 33]); o.z = cvt_pk_bf16(s[4 * 33], s[5 * 33]); o.w = cvt_pk_bf16(s[6 * 33], s[7 * 33]);
        const int ns = n0 + n; const int nd = rowmode == 0 ? ns : (8 * (ns >> 2) + (ns & 3) + (rowmode == 2 ? 4 : 0));
        if (f8scale != 0.f) { u32x2 o8; o8.x = pk4_fp8(s[0 * 33] * f8scale, s[1 * 33] * f8scale, s[2 * 33] * f8scale, s[3 * 33] * f8scale); o8.y = pk4_fp8(s[4 * 33] * f8scale, s[5 * 33] * f8scale, s[6 * 33] * f8scale, s[7 * 33] * f8scale);
            *(u32x2*)((unsigned char*)WT + (size_t)nd * ldD + col0D + k0 + 8 * c) = o8; }
        else *(u32x4*)(WT + (size_t)nd * ldD + col0D + k0 + 8 * c) = o; }
    LDS_WAIT(); asm volatile("" ::: "memory");
}

struct TrDesc { const float* W; unsigned char* WT; int ldS, ldD, rowmode, k0, n0; float sc; };
__device__ __forceinline__ void tr8_load(const TrDesc& d, float (&v)[32], int lane) {
    unsigned off = (unsigned)((d.k0 + (lane >> 5)) * d.ldS + d.n0 + (lane & 31)) * 4u; const unsigned step = (unsigned)d.ldS * 8u;
#pragma unroll
    for (int i = 0; i < 32; ++i) { v[i] = __builtin_nontemporal_load((const float*)((const char*)d.W + off)); off += step; }
}
__device__ __forceinline__ void tr8_store(const TrDesc& d, const float (&v)[32], LAS float* scr, int lane) {
#pragma unroll
    for (int i = 0; i < 32; ++i) scr[(2 * i + (lane >> 5)) * 33 + (lane & 31)] = v[i];
    LDS_WAIT(); asm volatile("" ::: "memory");
    const int c = lane & 7;
#pragma unroll
    for (int j = 0; j < 4; ++j) { const int n = (lane >> 3) + 8 * j; const LAS float* s = scr + (8 * c) * 33 + n;
        const int ns = d.n0 + n; int nd;
        if (d.rowmode == 0) { const int c = ns & 255; nd = (ns & ~255) + 128 * ((c >> 3) & 1) + 32 * (c >> 6) + 16 * ((c >> 2) & 1) + 4 * ((c >> 4) & 3) + (c & 3); }
        else { const int a = ns & 127; nd = 256 * (ns >> 7) + 128 * ((a >> 2) & 1) + 32 * (a >> 5) + (d.rowmode == 2 ? 16 : 0) + 4 * ((a >> 3) & 3) + (a & 3); }
        u32x2 o8; o8.x = pk4_fp8(s[0 * 33] * d.sc, s[1 * 33] * d.sc, s[2 * 33] * d.sc, s[3 * 33] * d.sc); o8.y = pk4_fp8(s[4 * 33] * d.sc, s[5 * 33] * d.sc, s[6 * 33] * d.sc, s[7 * 33] * d.sc);
        *(u32x2*)(d.WT + (unsigned)(nd * d.ldD + d.k0 + 8 * c)) = o8; }
    LDS_WAIT(); asm volatile("" ::: "memory");
}

struct Params { const float* in[26]; float* out; unsigned char* ws; int ph_lo, ph_hi, use_bar, pad; };
constexpr int NPH_L = 15, NPHASE = 2 + 2 * NPH_L;

template <bool XB16 = false>
__device__ __forceinline__ void norm_rows(const void* __restrict__ xin_, bf16_t* __restrict__ hout, const float* __restrict__ g, const float* __restrict__ sh, const float* __restrict__ sc, int nrows, int lane, unsigned char* __restrict__ h8 = nullptr) {
    f32x4 gm[4], sv[4];
#pragma unroll
    for (int j = 0; j < 4; ++j) { const f32x4 gv = *(const f32x4*)(g + 4 * lane + 256 * j), s1 = *(const f32x4*)(sc + 4 * lane + 256 * j); gm[j] = gv * (s1 + 1.0f); sv[j] = *(const f32x4*)(sh + 4 * lane + 256 * j); }
    for (int r = 0; r < nrows; r += 2) {
        f32x4 v0[4], v1[4]; float s0 = 0.f, s1 = 0.f;
        if constexpr (XB16) { const u32x2* xr0 = (const u32x2*)((const bf16_t*)xin_ + (size_t)r * DM) + lane; const u32x2* xr1 = xr0 + DM / 4;
#pragma unroll
            for (int j = 0; j < 4; ++j) { const u32x2 a = xr0[64 * j], b = xr1[64 * j]; v0[j] = (f32x4){bf_lo(a.x), bf_hi(a.x), bf_lo(a.y), bf_hi(a.y)}; v1[j] = (f32x4){bf_lo(b.x), bf_hi(b.x), bf_lo(b.y), bf_hi(b.y)}; } }
        else { const f32x4* xr0 = (const f32x4*)((const float*)xin_ + (size_t)r * DM) + lane; const f32x4* xr1 = xr0 + DM / 4;
#pragma unroll
            for (int j = 0; j < 4; ++j) { v0[j] = xr0[64 * j]; v1[j] = xr1[64 * j]; } }
#pragma unroll
        for (int j = 0; j < 4; ++j) { s0 += (v0[j].x * v0[j].x + v0[j].y * v0[j].y) + (v0[j].z * v0[j].z + v0[j].w * v0[j].w); s1 += (v1[j].x * v1[j].x + v1[j].y * v1[j].y) + (v1[j].z * v1[j].z + v1[j].w * v1[j].w); }
        const float rstd0 = rsqrtf(wave_sum(s0, lane) * (1.0f / DM) + EPS), rstd1 = rsqrtf(wave_sum(s1, lane) * (1.0f / DM) + EPS);
        u32x2* o0 = (u32x2*)(hout + (size_t)r * DM) + lane; u32x2* o1 = o0 + DM / 4;
#pragma unroll
        for (int j = 0; j < 4; ++j) { const f32x4 y0 = v0[j] * rstd0 * gm[j] + sv[j], y1 = v1[j] * rstd1 * gm[j] + sv[j]; u32x2 w0, w1; w0.x = cvt_pk_bf16(y0.x, y0.y); w0.y = cvt_pk_bf16(y0.z, y0.w); w1.x = cvt_pk_bf16(y1.x, y1.y); w1.y = cvt_pk_bf16(y1.z, y1.w); o0[64 * j] = w0; o1[64 * j] = w1;
            if (h8) { ((unsigned*)(h8 + (size_t)r * DM))[lane + 64 * j] = pk4_fp8(y0.x, y0.y, y0.z, y0.w); ((unsigned*)(h8 + (size_t)(r + 1) * DM))[lane + 64 * j] = pk4_fp8(y1.x, y1.y, y1.z, y1.w); } }
    }
}

#define PHASE_BEGIN unsigned zo_ = 0; int z_ = 0; int tid; asm volatile("v_mbcnt_lo_u32_b32 %0, -1, 0\n\tv_mbcnt_hi_u32_b32 %0, -1, %0" : "=v"(tid)); tid += wave0_ * 64; int bx = blockIdx.x; int G = gridDim.x; LAS unsigned char* ldsp = lds; asm volatile("" : "+s"(zo_), "+s"(z_), "+v"(tid), "+s"(bx), "+s"(G), "+s"(ldsp)); \
    zo_ = (unsigned)__builtin_amdgcn_readfirstlane((int)zo_); z_ = __builtin_amdgcn_readfirstlane(z_); bx = __builtin_amdgcn_readfirstlane(bx); G = __builtin_amdgcn_readfirstlane(G); ldsp = (LAS unsigned char*)(unsigned)__builtin_amdgcn_readfirstlane((int)(unsigned)(uintptr_t)ldsp);     \
    (void)ldsp; unsigned char* wsp = P.ws + zo_; \
    const int lane = tid & 63, wave = __builtin_amdgcn_readfirstlane(tid >> 6); const int vcu = (G % 8 == 0) ? (bx % 8) * (G / 8) + bx / 8 : bx; const int gw = vcu * 8 + wave, NGW = G * 8; (void)lane; (void)wave; (void)vcu; (void)gw; (void)NGW
#define INP(k) (P.in[(k) + z_])
#define CV_NIT (NEX * 384)
#define CV_ON (G == 256)
#define CV_Q6 8
#define CV_Q8 7
#define CV_A (CV_ON ? 248 * 8 * CV_Q6 : 0)
#define CV_B (CV_ON ? CV_NIT - 126 * 8 * CV_Q8 : CV_NIT)
#define TR_DESC(D, it_) do { const int e_ = (it_) / 384, r_ = (it_) % 384, q_ = r_ & 127; \
                if (r_ < 128) { D.W = e_ < NE ? INP(19) + ((size_t)l * NE + e_) * DM * DE : INP(22) + (size_t)l * DM * DE; D.WT = P_EWGU8 + (size_t)e_ * 512 * 1024; D.ldS = DE; D.ldD = DM; D.rowmode = 1; D.k0 = 64 * (q_ >> 3); D.n0 = 32 * (q_ & 7); D.sc = 32.0f; } \
                else if (r_ < 256) { D.W = e_ < NE ? INP(20) + ((size_t)l * NE + e_) * DM * DE : INP(23) + (size_t)l * DM * DE; D.WT = P_EWGU8 + (size_t)e_ * 512 * 1024; D.ldS = DE; D.ldD = DM; D.rowmode = 2; D.k0 = 64 * (q_ >> 3); D.n0 = 32 * (q_ & 7); D.sc = 32.0f; } \
                else { D.W = e_ < NE ? INP(21) + ((size_t)l * NE + e_) * DE * DM : INP(24) + (size_t)l * DE * DM; D.WT = (unsigned char*)P_EWD + (size_t)e_ * 1024 * 256; D.ldS = DM; D.ldD = DE; D.rowmode = 0; D.k0 = 64 * (q_ >> 5); D.n0 = 32 * (q_ & 31); D.sc = 16.0f; } } while (0)
#define CONVERT_ITEMS(first_, step_, end_) do { int it = (first_); const int st_ = (step_), en_ = (end_);     \
                if (it < en_) { TrDesc d0, d1; float va[32], vb[32]; TR_DESC(d0, it); d1 = d0; \
                    { const float zf_ = (float)z_;                  \
                      _Pragma("unroll") for (int i = 0; i < 32; ++i) vb[i] = zf_; } \
                    tr8_load(d0, va, lane); \
                    for (;;) { \
                        const int it1 = it + st_; const bool h1 = it1 < en_; if (h1) { TR_DESC(d1, it1); tr8_load(d1, vb, lane); } \
                        tr8_store(d0, va, scr, lane); if (!h1) break; \
                        const int it2 = it1 + st_; const bool h2 = it2 < en_; if (h2) { TR_DESC(d0, it2); tr8_load(d0, va, lane); } \
                        tr8_store(d1, vb, scr, lane); if (!h2) break; \
                        it = it2; } } } while (0)
#define P_MODS ((float*)(wsp + WS_MODS))
#define P_XS ((bf16_t*)(wsp + WS_XS))
#define P_HQ ((bf16_t*)(wsp + WS_HQ))
#define P_U ((bf16_t*)(wsp + WS_U))
#define P_KB ((bf16_t*)(wsp + WS_KB))
#define P_VB ((bf16_t*)(wsp + WS_VB))
#define P_YA ((bf16_t*)(wsp + WS_YA))
#define P_YP ((bf16_t*)(wsp + WS_YP))
#define P_K8 ((unsigned char*)(wsp + WS_KB))
#define P_VT8 ((unsigned char*)(wsp + WS_VT8))
#define P_EWGU ((bf16_t*)(wsp + WS_EW))
#define P_EWD ((bf16_t*)(wsp + WS_EW + EW_GU_BYTES))
#define P_EWGU8 ((unsigned char*)(wsp + WS_EW))
#define P_H2F8 ((unsigned char*)(wsp + WS_EW + EW_GU_BYTES / 2))
#define P_ACT ((bf16_t*)(wsp + WS_ACT))
#define P_TOKL ((int*)(wsp + WS_TOKL))
#define P_TPOS ((int*)(wsp + WS_TPOS))
#define P_TW ((float*)(wsp + WS_TW))
#define P_LOG ((float*)(wsp + WS_LOG))
#define P_YB ((bf16_t*)(wsp + WS_YB))
#define P_F1 ((bf16_t*)(wsp + WS_F1))
#define P_F2 ((bf16_t*)(wsp + WS_F2))
#define P_FC ((bf16_t*)(wsp + WS_FC))
#define P_WCS ((float*)(wsp + WS_WCS))
#define P_DW(l) (wsp + WS_DW + (size_t)(l) * DW_LAYER)
#define P_GCNT(l) ((unsigned*)(wsp + WS_CTL) + CW_CNT + (l) * 64)

__global__ void __launch_bounds__(512, 2) mk_fwd(Params P) {
    extern __shared__ __attribute__((aligned(16))) unsigned char lds_raw[];
    LAS unsigned char* lds = (LAS unsigned char*)lds_raw;
    const int wave0_ = __builtin_amdgcn_readfirstlane((int)threadIdx.x >> 6);
    volatile LAS unsigned* MISC = (volatile LAS unsigned*)(lds + MISC_OFF);
    for (int u = threadIdx.x; u < 128; u += 512) MISC[u] = 0u;
    __syncthreads();
    XcdBarrier bar; bar.bar = (unsigned*)(P.ws + WS_CTL) + CW_BAR; bar.x = 0; bar.st = nullptr;
    if (P.use_bar) bar = xcd_barrier_post((unsigned*)(P.ws + WS_CTL) + CW_BAR, MISC + 8);
    const int lo = P.ph_lo, hi = P.ph_hi;
#define IN(k) ({ int lo_ = lo; asm volatile("" : "+s"(lo_)); lo_ = __builtin_amdgcn_readfirstlane(lo_); (lo_ <= (k) && (k) < hi); })
#define SEAM(k) do { if (IN(k) && IN((k) + 1)) { XcdBarrier bb_ = bar; unsigned zb_ = 0; int t0_; asm volatile("v_mbcnt_lo_u32_b32 %0, -1, 0\n\tv_mbcnt_hi_u32_b32 %0, -1, %0" : "=v"(t0_)); t0_ += wave0_ * 64; asm volatile("" : "+s"(zb_), "+s"(bb_.x)); zb_ = (unsigned)__builtin_amdgcn_readfirstlane((int)zb_); bb_.x = (unsigned)__builtin_amdgcn_readfirstlane((int)bb_.x); bb_.bar = (unsigned*)(P.ws + WS_CTL + zb_) + CW_BAR; for (int rb_ = 0; rb_ < REP_BAR; ++rb_) xcd_barrier(bb_, t0_); } } while (0)

    if (IN(0)) for (int rep_ = 0; rep_ < REP_PRO; ++rep_) {
        PHASE_BEGIN;
        {
            LAS float* sl = (LAS float*)lds;
            const float* c_in = INP(1); const float* cctx_in = INP(3);
            for (int i = tid; i < 3 * DM; i += 512) { const int v = i >> 10, d = i & 1023; const float cv = v < 2 ? c_in[v * DM + d] : cctx_in[d]; sl[i] = silu_f(cv); }
            __syncthreads();
            LAS float* red = sl + 3 * DM;
            for (int it = vcu; it < 192; it += G) {
                const int l = it / 96, n = (it % 96) * 64 + lane; const float* w = INP(4) + (size_t)l * DM * 6144 + n;
                float a0 = 0.f, a1 = 0.f, a2 = 0.f;
#pragma unroll 8
                for (int d = wave * 128; d < wave * 128 + 128; ++d) { const float wv = __builtin_nontemporal_load(w + (size_t)d * 6144); a0 += sl[d] * wv; a1 += sl[DM + d] * wv; a2 += sl[2 * DM + d] * wv; }
                red[(wave * 3 + 0) * 64 + lane] = a0; red[(wave * 3 + 1) * 64 + lane] = a1; red[(wave * 3 + 2) * 64 + lane] = a2;
                __syncthreads();
                if (wave < 3) { float s = 0.f;
#pragma unroll
                    for (int w8 = 0; w8 < 8; ++w8) s += red[(w8 * 3 + wave) * 64 + lane];
                    P_MODS[(l * 3 + wave) * 6144 + n] = s + INP(5)[l * 6144 + n]; }
                __syncthreads();
            }
            __syncthreads();
        }
        {
            LAS float* scr = (LAS float*)(lds + wave * 16384);
            constexpr int I_IN = 16 * 37, I_UQ = 6 * 24, I_UKV = 4 * 32, I_OUT = 8 * 32, I_R = 16 * 2, I_L = I_IN + I_UQ + I_UKV + I_OUT + I_R;
            for (int it = gw; it < 2 * I_L; it += NGW) {
                const int l = it / I_L; int r = it % I_L; unsigned char* dw = P_DW(l);
                if (r < I_IN) { tr_item(INP(8) + (size_t)l * DM * 1184, 1184, nullptr, (bf16_t*)(dw + DW_WIN), DM, 0, 37, 0, scr, r, lane); continue; } r -= I_IN;
                if (r < I_UQ) { tr_item(INP(13) + (size_t)l * 384 * 768, 768, INP(12) + l * 384, (bf16_t*)(dw + DW_WUQ), 384, 0, 24, 0, scr, r, lane); continue; } r -= I_UQ;
                if (r < I_UKV) { tr_item(INP(15) + (size_t)l * 256 * 1024, 1024, INP(14) + l * 256, (bf16_t*)(dw + DW_WUKV), 256, 0, 32, 0, scr, r, lane); continue; } r -= I_UKV;
                if (r < I_OUT) { tr_item(INP(16) + (size_t)l * DM * DM + (size_t)512 * DM, DM, nullptr, (bf16_t*)(dw + DW_WCOMB), NINP, 768, 32, 0, scr, r, lane); continue; } r -= I_OUT;
                tr_item(INP(17) + (size_t)l * DM * NE, NE, nullptr, (bf16_t*)(dw + DW_WR), DM, 0, 2, 0, scr, r, lane);
            }
            for (int l = 0; l < 2; ++l) {
                u32x4* z1 = (u32x4*)(P_DW(l) + DW_WIN + (size_t)1184 * DM * 2); const int n1 = 96 * DM * 2 / 16;
                for (int i = bx * 512 + tid; i < n1; i += G * 512) z1[i] = (u32x4){(unsigned)z_, (unsigned)z_, (unsigned)z_, (unsigned)z_};
                u32x4* z2 = (u32x4*)(P_DW(l) + DW_WR + (size_t)64 * DM * 2); const int n2 = 192 * DM * 2 / 16;
                for (int i = bx * 512 + tid; i < n2; i += G * 512) z2[i] = (u32x4){(unsigned)z_, (unsigned)z_, (unsigned)z_, (unsigned)z_};
            }
        }
        { bf16_t* F1 = P_F1; bf16_t* F2 = P_F2; bf16_t* FC = P_FC;
        for (int i = bx * 512 + tid; i < 256 * 128; i += G * 512) { const int m = i >> 7, l1 = i & 127, w = m >> 5, rho = m & 31, part = (rho >> 3) & 1, k1 = 16 * w + (((rho >> 4) << 3) | (rho & 7));
            float sn, cs; sincospif((float)((k1 * l1) & 127) * (1.0f / 64.0f), &sn, &cs); const float v = (part ? -sn : cs) * (1.0f / 128.0f); F1[i] = (bf16_t)(cvt_pk_bf16(v, 0.f) & 0xffffu); }
        for (int i = bx * 512 + tid; i < 256 * 256; i += G * 512) { const int m = i >> 8, j = i & 255, zp = m >> 7, k2 = m & 127, l2 = j >> 1, part = j & 1;
            float sn, cs; sincospif((float)((k2 * l2) & 127) * (1.0f / 64.0f), &sn, &cs); const float v = zp == 0 ? (part ? sn : cs) : (part ? cs : -sn); F2[i] = (bf16_t)(cvt_pk_bf16(v, 0.f) & 0xffffu); }
        for (int i = bx * 512 + tid; i < 512 * 256; i += G * 512) { const int m = i >> 8, l = i & 255, zp = m >> 8, k = m & 255;
            float sn, cs; sincospif((float)((k * l) & 255) * (1.0f / 128.0f), &sn, &cs); const float v = (zp ? -sn : cs) * (1.0f / 16.0f); FC[i] = (bf16_t)(cvt_pk_bf16(v, 0.f) & 0xffffu); } }
        for (int i = bx * 512 + tid; i < 2 * 2 * 4 * 64 * 64; i += G * 512) { const int d = i & 63, c = (i >> 6) & 63, g = (i >> 12) & 3, cs_ = (i >> 14) & 1, l = i >> 15;
            const float* wf = INP(11) + (size_t)(l * 4 + g) * 4096 + d; float a = 0.f;
            for (int m = 0; m < 64; ++m) { float sn, cs; sincospif((float)((m * c) & 63) * (1.0f / 32.0f), &sn, &cs); a += (cs_ ? sn : cs) * wf[m * 64]; }
            P_WCS[i] = a * 0.125f; }
    }
    SEAM(0);

#pragma unroll 1
    for (int l = 0; l < 2; ++l) {
        const int pb = 1 + l * NPH_L;
        const int RL = l == 0 ? RT : TL;

        for (int grp_ = 0; grp_ < GRP_MIX; ++grp_) {
        if (IN(pb + 0)) for (int rep_ = 0; rep_ < REP_NORM; ++rep_) {
            PHASE_BEGIN;
            const float* mods = P_MODS + (size_t)l * 3 * 6144;
            const float* xlat = INP(0); const float* xctx = INP(2);
            if (l == 0)
            for (int ch = gw; ch < RT / 16; ch += NGW) { const int r0 = ch * 16; const int vec = r0 < SEQ ? 0 : (r0 < TL ? 1 : 2);
                const float* xi = r0 < TL ? xlat + (size_t)r0 * DM : xctx + (size_t)(r0 - TL) * DM;
                norm_rows(xi, P_HQ + (size_t)r0 * DM, INP(6) + l * DM, mods + vec * 6144 + 0, mods + vec * 6144 + DM, 16, lane); }
            if (l == 0) {
                for (int it = gw; it < 2 * 96 * 16; it += NGW) {
                    const int itu = __builtin_amdgcn_readfirstlane(it); const int nch = itu & 15, kb = (itu >> 4) % 96, ll = itu / (96 * 16), k0 = kb * 8, n = nch * 64 + lane;
                    const bool pool = k0 < 256; const int kk = pool ? k0 : k0 - 256, cs_ = pool ? 0 : (kk >> 8), g = (kk >> 6) & 3, c0 = kk & 63;
                    const float* wo = INP(16) + (size_t)ll * DM * DM + (size_t)((pool ? 0 : 256) + g * 64) * DM + n;
                    const float* arow = pool ? INP(9) + (size_t)(ll * 4 + g) * 4096 + c0 * 64 : P_WCS + ((size_t)((ll * 2 + cs_) * 4 + g) * 64 + c0) * 64;
                    const float* ps = INP(10) + ll * 256 + g * 64;
                    float acc[8];
#pragma unroll
                    for (int j = 0; j < 8; ++j) acc[j] = 0.f;
#pragma unroll 4
                    for (int d = 0; d < 64; ++d) { const float wv = wo[(size_t)d * DM]; const float sc_ = pool ? ps[d] : 1.0f;
#pragma unroll
                        for (int j = 0; j < 8; ++j) acc[j] += arow[j * 64 + d] * sc_ * wv; }
                    u32x4 w; w.x = cvt_pk_bf16(acc[0], acc[1]); w.y = cvt_pk_bf16(acc[2], acc[3]); w.z = cvt_pk_bf16(acc[4], acc[5]); w.w = cvt_pk_bf16(acc[6], acc[7]);
                    *(u32x4*)((bf16_t*)(P_DW(ll) + DW_WCOMB) + (size_t)n * NINP + k0) = w;
                }
            }
        }
        if (l == 0 || GRP_MOE > 1 || REP_COMB > 1 || GRP_MIX > 1) SEAM(pb + 0);

        if (IN(pb + 1)) for (int rep_ = 0; rep_ < REP_DENSE; ++rep_) {
            PHASE_BEGIN;
            pg8::DenseSched S; S.init(RT, NINP, G, bx, P_HQ, DM, P_DW(l) + DW_WIN, DM);
            pg8::EpiBf16 E{P_U, NINP, 0};
            pg8::gemm_phase<pg8::EpiBf16, pg8::DenseSched>(lds, DM, S, E, tid);
        }
        SEAM(pb + 1);

        if (IN(pb + 2)) for (int rep_ = 0; rep_ < REP_ROWS; ++rep_) {
            PHASE_BEGIN;
            bf16_t* Ub = P_U; bf16_t* YA = P_YA;
            for (int ch = gw; ch < RT / 16; ch += NGW) {
                const int r0 = ch * 16; const bool isc = r0 >= TL; const int b = isc ? (r0 - TL) >> 8 : r0 >> 14; const int t0 = isc ? (r0 - TL) & (CTXL - 1) : r0 & (SEQ - 1); const int Ls = isc ? CTXL : SEQ;
                const bf16_t* useq = Ub + (size_t)(r0 - t0) * NINP;
                if (l == 0 || !isc) {
                    u32x2 x[32];
#pragma unroll
                    for (int j = 0; j < 32; ++j) { const int tt = t0 - 8 + j; const int tc = tt < 0 ? 0 : (tt >= Ls ? Ls - 1 : tt); x[j] = *(const u32x2*)(useq + (size_t)tc * NINP + lane * 4); if (tt < 0 || tt >= Ls) x[j] = (u32x2){(unsigned)z_, (unsigned)z_}; }
                    const int g = lane >> 4, hw = 1 << g;
                    float res[16][4];
#pragma unroll
                    for (int half = 0; half < 2; ++half) {
                        float p0[33], p1[33]; p0[0] = 0.f; p1[0] = 0.f;
#pragma unroll
                        for (int j = 0; j < 32; ++j) { const unsigned w = half ? x[j].y : x[j].x; p0[j + 1] = p0[j] + bf_lo(w); p1[j + 1] = p1[j] + bf_hi(w); }
#pragma unroll
                        for (int i = 0; i < 16; ++i) { const int c = i + 8;
                            const float a1 = p0[c + 1] - p0[c - 1], a2 = p0[c + 2] - p0[c - 2], a4 = p0[c + 4] - p0[c - 4], a8 = p0[c + 8] - p0[c - 8];
                            const float b1 = p1[c + 1] - p1[c - 1], b2 = p1[c + 2] - p1[c - 2], b4 = p1[c + 4] - p1[c - 4], b8 = p1[c + 8] - p1[c - 8];
                            res[i][2 * half] = g == 0 ? a1 : (g == 1 ? a2 : (g == 2 ? a4 : a8)); res[i][2 * half + 1] = g == 0 ? b1 : (g == 1 ? b2 : (g == 2 ? b4 : b8)); }
                    }
#pragma unroll
                    for (int i = 0; i < 16; ++i) { const int t = t0 + i; const int lo_ = (t - hw) < 0 ? 0 : t - hw, hi_ = (t + hw) > Ls ? Ls : t + hw; const float ic = 1.0f / (float)(hi_ - lo_);
                        const u32x2 me = x[i + 8];
                        u32x2 w; w.x = cvt_pk_bf16(res[i][0] * ic - bf_lo(me.x), res[i][1] * ic - bf_hi(me.x)); w.y = cvt_pk_bf16(res[i][2] * ic - bf_lo(me.y), res[i][3] * ic - bf_hi(me.y));
                        *(u32x2*)(YA + (size_t)(r0 + i) * NINP + lane * 4) = w; }
                }
#pragma unroll 1
                for (int rb = 0; rb < 16; rb += 8) {
                    u32x4 qv[8], kv[8], kr[8]; const int cpc = lane & 3;
#pragma unroll
                    for (int k = 0; k < 8; ++k) { bf16_t* ur = Ub + (size_t)(r0 + rb + k) * NINP;
                        qv[k] = (u32x4){(unsigned)z_, (unsigned)z_, (unsigned)z_, (unsigned)z_}; kv[k] = qv[k];
                        if (lane < 48) qv[k] = *(const u32x4*)(ur + COL_Q + lane * 8);
                        if (lane < 32) kv[k] = *(const u32x4*)(ur + COL_KV + lane * 8);
                        kr[k] = *(const u32x4*)(ur + COL_KR + cpc * 8); }
#pragma unroll
                    for (int k = 0; k < 8; ++k) { const int row = r0 + rb + k, t = t0 + rb + k; bf16_t* ur = Ub + (size_t)row * NINP;
                        float sq = 0.f, sk = 0.f;
#pragma unroll
                        for (int j = 0; j < 4; ++j) { const float a = bf_lo(qv[k][j]), c2 = bf_hi(qv[k][j]); sq += a * a + c2 * c2; const float a2 = bf_lo(kv[k][j]), c3 = bf_hi(kv[k][j]); sk += a2 * a2 + c3 * c3; }
                        const float rq = rsqrtf(wave_sum(sq, lane) * (1.0f / 384.0f) + EPS), rk = rsqrtf(wave_sum(sk, lane) * (1.0f / 256.0f) + EPS);
                        if (lane < 48) { u32x4 w;
#pragma unroll
                            for (int j = 0; j < 4; ++j) w[j] = cvt_pk_bf16(bf_lo(qv[k][j]) * rq, bf_hi(qv[k][j]) * rq);
                            *(u32x4*)(ur + COL_Q + lane * 8) = w; }
                        if (lane < 32) { u32x4 w;
#pragma unroll
                            for (int j = 0; j < 4; ++j) w[j] = cvt_pk_bf16(bf_lo(kv[k][j]) * rk, bf_hi(kv[k][j]) * rk);
                            *(u32x4*)(ur + COL_KV + lane * 8) = w; }
                        const u32x4 mine = kr[k]; u32x4 oth;
#pragma unroll
                        for (int j = 0; j < 4; ++j) oth[j] = (unsigned)shxi((int)mine[j], 1, lane);
                        float f[8];
#pragma unroll
                        for (int j = 0; j < 4; ++j) { f[2 * j] = bf_lo(mine[j]); f[2 * j + 1] = bf_hi(mine[j]); }
                        if (!isc) { const float pos = (float)((cpc >> 1) == 0 ? (t >> 6) : (t & 63)); const bool second = cpc & 1;
#pragma unroll
                            for (int j = 0; j < 4; ++j) {
#pragma unroll
                                for (int q = 0; q < 2; ++q) { const float ang = pos * __powf(10000.0f, -(float)(2 * j + q) * 0.125f); const float sn = __sinf(ang), cs = __cosf(ang);
                                    const float m0 = q ? bf_hi(mine[j]) : bf_lo(mine[j]), o0 = q ? bf_hi(oth[j]) : bf_lo(oth[j]);
                                    f[2 * j + q] = second ? m0 * cs + o0 * sn : m0 * cs - o0 * sn; } } }
                        const int h = (lane >> 2) & 7; const int key = isc ? t : CTXL + t;
                        unsigned char* kd = P_K8 + ((size_t)(b * NH + h) * LK + key) * 128;
                        u32x2 w; w.x = pk4_fp8(f[0], f[1], f[2], f[3]); w.y = pk4_fp8(f[4], f[5], f[6], f[7]);
                        if (lane < 32) *(u32x2*)(kd + 64 + cpc * 8) = w; else *(u32x2*)(kd + 96 + cpc * 8) = (u32x2){(unsigned)z_ + (cpc == 0 ? 0x38u : 0u), (unsigned)z_}; }
                }
            }
        }
        SEAM(pb + 2);

        if (IN(pb + 3)) {
            for (int rep_ = 0; rep_ < REP_DENSE; ++rep_) { PHASE_BEGIN; pg8::DenseSched S; S.init(RL, 768, G, bx, P_U + COL_Q, NINP, P_DW(l) + DW_WUQ, 384);
              pg8::EpiBf16 E{P_HQ, 768, 0};
              pg8::gemm_phase<pg8::EpiBf16, pg8::DenseSched>(lds, 384, S, E, tid); }
            for (int rep_ = 0; rep_ < REP_DENSE; ++rep_) { PHASE_BEGIN; pg8::DenseSched S; S.init(RT, 1024, G, (G == 256) ? ((bx + 120) & 255) : bx, P_U + COL_KV, NINP, P_DW(l) + DW_WUKV, 256);
              pg8::EpiKV E{P_K8, P_VB};
              pg8::gemm_phase<pg8::EpiKV, pg8::DenseSched>(lds, 256, S, E, tid); }
            for (int rep_ = 0; rep_ < REP_FFT; ++rep_) { PHASE_BEGIN;
              for (int u = vcu; u < 256; u += G) { const int b = u >> 7, l2 = u & 127;
                dft::unit<0, 128>((LAS char*)lds, P_F1, (const char*)(P_U + (size_t)(b * SEQ + l2) * NINP + COL_FNO), (size_t)128 * NINP * 2, (char*)P_YP, b, l2, tid); } }
            if (l == 0) { PHASE_BEGIN;
              for (int u = vcu; u < 4; u += G) { const int b = u >> 1, zp = u & 1;
                dft::unit<2, 256>((LAS char*)lds, P_FC + (size_t)zp * 256 * 256, (const char*)(P_U + (size_t)(TL + b * CTXL) * NINP + COL_FNO), (size_t)NINP * 2, (char*)P_YA, b, zp, tid); } }
        }
        SEAM(pb + 3);

        if (IN(pb + 4)) for (int rep_ = 0; rep_ < REP_VT; ++rep_) {
            PHASE_BEGIN;
            LAS unsigned char* scr = (LAS unsigned char*)(ldsp + wave * 5120);
            const int k = lane, kk = k & 31, khi = (kk >> 2) & 1, kr = (kk & 3) + 4 * (kk >> 3), kpos = khi * 32 + (k >> 5) * 16 + kr;
            for (int u = gw; u < 16 * 260; u += NGW) { const int bh = u / 260, tl = u % 260;
                const u32x4* srcp = (const u32x4*)(P_VB + ((size_t)bh * LK + tl * 64 + k) * DV);
                u32x4 v[8];
#pragma unroll
                for (int c = 0; c < 8; ++c) v[c] = srcp[c];
#pragma unroll
                for (int c = 0; c < 8; ++c)
#pragma unroll
                    for (int j = 0; j < 4; ++j) { const unsigned w = __builtin_amdgcn_cvt_pk_fp8_f32(bf_lo(v[c][j]), bf_hi(v[c][j]), 0u, false); const int d = 8 * c + 2 * j;
                        scr[d * 80 + kpos] = (unsigned char)(w & 0xffu); scr[(d + 1) * 80 + kpos] = (unsigned char)((w >> 8) & 0xffu); }
                LDS_WAIT(); asm volatile("" ::: "memory");
                u32x4* dstp = (u32x4*)(P_VT8 + ((size_t)bh * 260 + tl) * 4096 + lane * 64);
#pragma unroll
                for (int c = 0; c < 4; ++c) dstp[c] = *(const LAS u32x4*)(scr + lane * 80 + c * 16);
                LDS_WAIT(); asm volatile("" ::: "memory");
            }
        }
        SEAM(pb + 4);

        if (IN(pb + 5)) {
            for (int rep_ = 0; rep_ < REP_FFT; ++rep_) { PHASE_BEGIN;
              for (int u = vcu; u < 256; u += G) { const int b = u >> 7, k1 = u & 127;
                dft::unit<1, 256>((LAS char*)lds, P_F2, (const char*)(P_YP + (size_t)(b * 128 + k1) * 256 * 256), (size_t)512, (char*)P_YA, b, k1, tid); } }
            if (l == 0) { PHASE_BEGIN;
              for (int u = vcu; u < 16; u += G) { const int b = u >> 3, h = u & 7;
                att8::attn_unit(P_HQ + (size_t)(TL + b * CTXL) * 768 + h * DQK, P_K8 + (size_t)(b * NH + h) * LK * 128, P_VT8 + (size_t)(b * NH + h) * 260 * 4096,
                                P_YA + (size_t)(TL + b * CTXL) * NINP + 768 + h * DV, NINP, CTXL / 64, false, 0, CTXL, (LAS char*)lds, tid); } }
            for (int rep_ = 0; rep_ < REP_ATT; ++rep_) { PHASE_BEGIN;
              for (int u = vcu; u < 512; u += G) { const int bh = u >> 5, qb = u & 31, b = bh >> 3, h = bh & 7; int tidu = tid; asm volatile("" : "+v"(tidu));
#if ATT_VAR
                if (rep_ + 1 < REP_ATT) att8::attn_unit_p<ATT_VAR>(P_HQ + (size_t)(b * SEQ + qb * 512) * 768 + h * DQK, P_K8 + (size_t)bh * LK * 128, P_VT8 + (size_t)bh * 260 * 4096,
                                P_YA + (size_t)(b * SEQ + qb * 512) * NINP + 768 + h * DV, NINP, LK / 64, true, qb * 512, 512, (LAS char*)lds, tidu); else
#endif
                att8::attn_unit_p<0>(P_HQ + (size_t)(b * SEQ + qb * 512) * 768 + h * DQK, P_K8 + (size_t)bh * LK * 128, P_VT8 + (size_t)bh * 260 * 4096,
                                P_YA + (size_t)(b * SEQ + qb * 512) * NINP + 768 + h * DV, NINP, LK / 64, true, qb * 512, 512, (LAS char*)lds, tidu); } }
        }
        SEAM(pb + 5);
        }

        if (IN(pb + 6)) for (int rep_ = 0; rep_ < REP_OUT; ++rep_) {
            PHASE_BEGIN;
#if SELFCHECK
            if (gw < 64) selfcheck_attn(l, P_HQ, P_K8, P_VB, P_VT8, P_YA, P_U, (const bf16_t*)(P_DW(l) + DW_WUQ), (const bf16_t*)(P_DW(l) + DW_WUKV), (unsigned*)(wsp + WS_CTL) + CW_CHK, (LAS float*)(ldsp + wave * 1024), gw, lane);
            __syncthreads();
#endif
            const float* xlat = INP(0); const float* xctx = INP(2); const bf16_t* xsin = (l == 0 && rep_ == 0) ? nullptr : P_XS;
            pg8::DenseSched S; S.init(RL, DM, G, bx, P_YA, NINP, P_DW(l) + DW_WCOMB, NINP);
            pg8::EpiResid E{xlat, xctx, xsin, P_XS, P_MODS + (size_t)l * 3 * 6144, (REP_OUT > 1 && rep_ > 0) ? 0.f : 1.f};
            pg8::gemm_phase<pg8::EpiResid, pg8::DenseSched>(lds, NINP, S, E, tid);
            if (CV_ON && bx >= 8 && rep_ == 0) { LAS float* scr = (LAS float*)(lds + wave * 16384);
                CONVERT_ITEMS((bx - 8) * 8 + wave, 248 * 8, CV_A); }
        }
        SEAM(pb + 6);

        for (int grp2_ = 0; grp2_ < GRP_MOE; ++grp2_) {
        if (IN(pb + 7)) for (int rep_ = 0; rep_ < REP_NORM * REP_P7; ++rep_) {
            PHASE_BEGIN;
            const float* mods = P_MODS + (size_t)l * 3 * 6144;
            for (int ch = gw; ch < RL / 16; ch += NGW) { const int r0 = ch * 16; const int vec = r0 < SEQ ? 0 : (r0 < TL ? 1 : 2);
                norm_rows<true>(P_XS + (size_t)r0 * DM, P_YB + (size_t)r0 * DM, INP(7) + l * DM, mods + vec * 6144 + 3 * DM, mods + vec * 6144 + 4 * DM, 16, lane, P_H2F8 + (size_t)r0 * DM); }
            LAS float* scr = (LAS float*)(lds + wave * 16384);
            CONVERT_ITEMS(CV_A + gw, NGW, CV_B);
        }
        SEAM(pb + 7);

        if (IN(pb + 8)) for (int rep_ = 0; rep_ < REP_DENSE; ++rep_) {
            PHASE_BEGIN;
            pg8::DenseSched S; S.init(RL, 256, G, bx, P_YB, DM, P_DW(l) + DW_WR, DM);
            pg8::EpiLogits E{P_LOG};
            pg8::gemm_phase<pg8::EpiLogits, pg8::DenseSched>(lds, DM, S, E, tid);
            if (CV_ON && bx >= 130 && rep_ == 0) { LAS float* scr = (LAS float*)(lds + wave * 16384);
                CONVERT_ITEMS(CV_B + (bx - 130) * 8 + wave, 126 * 8, CV_NIT); }
        }
        SEAM(pb + 8);

        if (IN(pb + 9)) for (int rep_ = 0; rep_ < REP_ROUTE; ++rep_) {
            PHASE_BEGIN;
            LAS int* lcnt = (LAS int*)lds; LAS int* lbase = lcnt + 64; LAS int* rec = lbase + 64;
            if (tid < 64) lcnt[tid] = 0;
            __syncthreads();
            const int per = (RL + G - 1) / G; const int t0 = vcu * per; const int t1 = (t0 + per) < RL ? (t0 + per) : RL;
            const float bias = INP(18)[l * NE + lane]; const float* LOGITS = P_LOG;
            for (int t = t0 + wave; t < t1; t += 8) {
                const float lg = LOGITS[(size_t)t * NE + lane]; const float s = 1.0f / (1.0f + __expf(-lg)); const float sel = s + bias;
                float v1 = sel; int i1 = lane;
#pragma unroll
                for (int off = 1; off < 8; off <<= 1) { const float ov = shx(v1, off, lane); const int oi = shxi(i1, off, lane); if (ov > v1 || (ov == v1 && oi < i1)) { v1 = ov; i1 = oi; } }
                float v2 = (lane == i1) ? -INFINITY : sel;
#pragma unroll
                for (int off = 1; off < 8; off <<= 1) v2 = fmaxf(v2, shx(v2, off, lane));
                const float gs = v1 + v2; const int g = lane >> 3; int grank = 0;
#pragma unroll
                for (int gg = 0; gg < 8; ++gg) { const float og = __uint_as_float(__builtin_amdgcn_readlane(__float_as_uint(gs), gg * 8)); grank += (og > gs || (og == gs && gg < g)) ? 1 : 0; }
                const bool gsel = grank < 4; const float msel = gsel ? sel : -INFINITY; int rank = 0;
                unsigned long long gm = __ballot(gsel && (lane & 7) == 0);
#pragma unroll 1
                for (int gi = 0; gi < 4; ++gi) { const int gb = __builtin_amdgcn_readfirstlane((int)__builtin_ctzll(gm | (1ull << 63))); gm &= gm - 1ull;
#pragma unroll
                    for (int j = 0; j < 8; ++j) { const int e2 = gb + j; const float ov = __uint_as_float(__builtin_amdgcn_readlane(__float_as_uint(msel), e2)); rank += (ov > msel || (ov == msel && e2 < lane)) ? 1 : 0; } }
                const bool chosen = gsel && rank < 8;
                const float ssum = wave_sum(chosen ? s : 0.f, lane);
                if (chosen) { const int lp = __hip_atomic_fetch_add(lcnt + lane, 1, __ATOMIC_RELAXED, __HIP_MEMORY_SCOPE_WORKGROUP); LAS int* rr = rec + ((t - t0) * 8 + rank) * 3; rr[0] = lane; rr[1] = lp; rr[2] = (int)__float_as_uint(s / ssum * 2.5f); }
            }
            __syncthreads();
            if (tid < 64) lbase[tid] = (int)__hip_atomic_fetch_add(P_GCNT(l) + 256 * rep_ + 512 * grp2_ + tid, (unsigned)lcnt[tid], __ATOMIC_RELAXED, __HIP_MEMORY_SCOPE_AGENT);
            __syncthreads();
            int* TOKL = P_TOKL; int* TPOS = P_TPOS; float* TW = P_TW;
            if (REP_ROUTE > 1 && rep_ > 0) { TOKL = (int*)(wsp + WS_YB + 70 * MiB); TPOS = (int*)(wsp + WS_YB + 80 * MiB); TW = (float*)(wsp + WS_YB + 82 * MiB); }
            for (int i = tid; i < (t1 - t0) * 8; i += 512) { const LAS int* rr = rec + i * 3; const int e = rr[0], pos = lbase[e] + rr[1], t = t0 + (i >> 3);
                TOKL[(size_t)e * RT + pos] = t; TPOS[(size_t)t * 8 + (i & 7)] = (e << 20) | pos; TW[(size_t)t * 8 + (i & 7)] = __uint_as_float((unsigned)rr[2]); }
            __syncthreads();
        }
        SEAM(pb + 9);

#define tstart ((LAS int*)(ldsp + TAB_OFF))
#define ecnt ((LAS int*)(ldsp + TAB_OFF + 288))
#define ulist ((LAS int*)(ldsp + ULIST_OFF))
#define uidx ((LAS int*)(ldsp + IDX_OFF))
        const bool need_tab = (hi > pb + 10) && (lo <= pb + 14);
        if (need_tab) {
            PHASE_BEGIN;
            if (tid < 64) {
                const int c = (int)__hip_atomic_load(P_GCNT(l) + 512 * grp2_ + tid, __ATOMIC_RELAXED, __HIP_MEMORY_SCOPE_AGENT); const int nt_ = (c + 255) >> 8; int inc = nt_;
#pragma unroll
                for (int o = 1; o < 64; o <<= 1) { const int v = __builtin_amdgcn_ds_bpermute(((lane - o) & 63) << 2, inc); if (lane >= o) inc += v; }
                ecnt[tid] = c; tstart[tid] = inc - nt_;
                if (tid == 63) { ecnt[NE] = RL; tstart[NE] = inc; tstart[NEX] = inc + RL / 256; } }
            __syncthreads();
        }
        int ntile = 0; if (need_tab) { PHASE_BEGIN; ntile = tstart[NEX]; }

        if (IN(pb + 10)) for (int rep_ = 0; rep_ < REP_MOE; ++rep_) {
            PHASE_BEGIN;
            const int nunits = ntile * 2; int nu = 0;
            for (int i = 0; ; ++i) { const int u = i * G + vcu; if (u >= nunits || i >= MAXU) break; nu = i + 1; }
            if (tid < nu) { const int u = tid * G + vcu, tile = u >> 1; int e = 0;
_Pragma("unroll 1")
                for (int q = 0; q < NEX; ++q) if (tstart[q] <= tile) e = q;
                ulist[tid * 4 + 0] = e; ulist[tid * 4 + 1] = tile; ulist[tid * 4 + 2] = u & 1; ulist[tid * 4 + 3] = tile - tstart[e]; }
            __syncthreads();
            const int* TOKL = P_TOKL;
            for (int i = 0; i < nu; ++i) { const int e = ulist[i * 4 + 0], rt = ulist[i * 4 + 3], cnt = ecnt[e];
                if (tid < 256) { const int pos = rt * 256 + tid; const int pc = pos < cnt ? pos : cnt - 1; uidx[i * 256 + tid] = e < NE ? TOKL[(size_t)e * RT + pc] : pc; } }
            __syncthreads();
            pg8::MoeSched S{ulist, uidx, nu, (const char*)P_H2F8, (const char*)P_EWGU8, 0, 0};
            pg8::EpiSwiGLU E{P_ACT, 1.0f / 32.0f};
            pg8::gemm_phase<pg8::EpiSwiGLU, pg8::MoeSched, true>(lds, DM, S, E, tid);
        }
        SEAM(pb + 10);

#pragma unroll 1
        for (int qd = 0; qd < 2; ++qd) {
            if (IN(pb + 11 + 2 * qd)) for (int rep_ = 0; rep_ < REP_MOE * REP_DOWN; ++rep_) {
                PHASE_BEGIN;
                const int nunits = ntile * 2; int nu = 0;
                for (int i = 0; ; ++i) { const int u = i * G + vcu; if (u >= nunits || i >= MAXU) break; nu = i + 1; }
                __syncthreads();
                if (tid < nu) { const int u = tid * G + vcu, tile = u >> 1; int e = 0;
_Pragma("unroll 1")
                    for (int q = 0; q < NEX; ++q) if (tstart[q] <= tile) e = q;
                    ulist[tid * 4 + 0] = e; ulist[tid * 4 + 1] = tile; ulist[tid * 4 + 2] = u & 1; ulist[tid * 4 + 3] = tile - tstart[e]; }
                __syncthreads();
                pg8::MoeSched S{ulist, uidx, nu, (const char*)P_ACT, (const char*)P_EWD, 1, qd};
                pg8::EpiFp8 E{(unsigned char*)P_YB, 512, 1.0f / 16.0f};
                pg8::gemm_phase<pg8::EpiFp8, pg8::MoeSched, true>(lds, DE, S, E, tid);
            }
            SEAM(pb + 11 + 2 * qd);
            if (IN(pb + 12 + 2 * qd)) for (int rep_ = 0; rep_ < REP_COMB; ++rep_) {
                PHASE_BEGIN;
                const float* mods = P_MODS + (size_t)l * 3 * 6144; const int* TPOS = P_TPOS; const float* TW = P_TW; const unsigned char* YB8 = (const unsigned char*)P_YB; bf16_t* XS = P_XS;
                const bool fuse = (qd == 1) && (GRP_MOE == 1 || grp2_ + 1 == GRP_MOE) && (REP_COMB == 1);
                for (int ch = gw; ch < RL / 8; ch += NGW) {
                    const int tb = ch * 8; const int vec = tb < SEQ ? 0 : (tb < TL ? 1 : 2);
                    const float* gp = mods + vec * 6144 + 5 * DM + qd * 512 + lane * 8; f32x4 g0 = *(const f32x4*)gp, g1 = *(const f32x4*)(gp + 4);
                    if ((REP_COMB > 1 && rep_ > 0) || (GRP_MOE > 1 && grp2_ + 1 < GRP_MOE)) { g0 = g0 * 0.f; g1 = g1 * 0.f; }
                    f32x4 nm[4], ns[4];
                    { const float zf_ = (float)z_;
#pragma unroll
                      for (int q = 0; q < 4; ++q) { nm[q] = (f32x4){zf_, zf_, zf_, zf_}; ns[q] = nm[q]; } }
                    if (fuse) {
                        if (l == 0) { const float* m1 = P_MODS + (size_t)3 * 6144 + vec * 6144; const float* gmx = INP(6) + DM;
#pragma unroll
                            for (int q = 0; q < 4; ++q) { const int col = (q >> 1) * 512 + lane * 8 + (q & 1) * 4; const f32x4 gv = *(const f32x4*)(gmx + col), s1 = *(const f32x4*)(m1 + DM + col); nm[q] = gv * (s1 + 1.0f); ns[q] = *(const f32x4*)(m1 + col); } }
                        else { const float* gf = INP(25);
#pragma unroll
                            for (int q = 0; q < 4; ++q) { const int col = (q >> 1) * 512 + lane * 8 + (q & 1) * 4; nm[q] = *(const f32x4*)(gf + col); ns[q] = nm[q] * 0.f; } }
                    }
#pragma unroll 2
                    for (int t = tb; t < tb + 8; ++t) {
                        int tp = 0; float tw = 0.f; if (lane < 8) { tp = TPOS[(size_t)t * 8 + lane]; tw = TW[(size_t)t * 8 + lane]; }
                        u32x2 v[9];
#pragma unroll
                        for (int k = 0; k < 8; ++k) { const int tpk = __builtin_amdgcn_readlane(tp, k); const int slot = tstart[tpk >> 20] * 256 + (tpk & 0xfffff); v[k] = __builtin_nontemporal_load((const u32x2*)(YB8 + (size_t)slot * 512 + lane * 8)); }
                        v[8] = __builtin_nontemporal_load((const u32x2*)(YB8 + (size_t)(tstart[NE] * 256 + t) * 512 + lane * 8));
                        u32x4* xp = (u32x4*)(XS + (size_t)t * DM + qd * 512 + lane * 8); const u32x4 xw = *xp;
                        f32x4 x0 = {bf_lo(xw.x), bf_hi(xw.x), bf_lo(xw.y), bf_hi(xw.y)}, x1 = {bf_lo(xw.z), bf_hi(xw.z), bf_lo(xw.w), bf_hi(xw.w)};
                        f32x4 y0 = x0, y1 = x1; if (fuse) { const u32x4 yw = *(const u32x4*)(XS + (size_t)t * DM + lane * 8); y0 = (f32x4){bf_lo(yw.x), bf_hi(yw.x), bf_lo(yw.y), bf_hi(yw.y)}; y1 = (f32x4){bf_lo(yw.z), bf_hi(yw.z), bf_lo(yw.w), bf_hi(yw.w)}; }
                        float a[8];
#pragma unroll
                        for (int j = 0; j < 8; ++j) a[j] = 0.f;
#pragma unroll
                        for (int k = 0; k < 9; ++k) { const float w = k < 8 ? __uint_as_float(__builtin_amdgcn_readlane(__float_as_uint(tw), k < 8 ? k : 0)) : 1.0f;
                            a[0] += w * __builtin_amdgcn_cvt_f32_fp8((int)v[k].x, 0); a[1] += w * __builtin_amdgcn_cvt_f32_fp8((int)v[k].x, 1); a[2] += w * __builtin_amdgcn_cvt_f32_fp8((int)v[k].x, 2); a[3] += w * __builtin_amdgcn_cvt_f32_fp8((int)v[k].x, 3);
                            a[4] += w * __builtin_amdgcn_cvt_f32_fp8((int)v[k].y, 0); a[5] += w * __builtin_amdgcn_cvt_f32_fp8((int)v[k].y, 1); a[6] += w * __builtin_amdgcn_cvt_f32_fp8((int)v[k].y, 2); a[7] += w * __builtin_amdgcn_cvt_f32_fp8((int)v[k].y, 3); }
                        x0.x += g0.x * a[0]; x0.y += g0.y * a[1]; x0.z += g0.z * a[2]; x0.w += g0.w * a[3]; x1.x += g1.x * a[4]; x1.y += g1.y * a[5]; x1.z += g1.z * a[6]; x1.w += g1.w * a[7];
                        if (!(fuse && l == 1)) { u32x4 ow; ow.x = cvt_pk_bf16(x0.x, x0.y); ow.y = cvt_pk_bf16(x0.z, x0.w); ow.z = cvt_pk_bf16(x1.x, x1.y); ow.w = cvt_pk_bf16(x1.z, x1.w); *xp = ow; }
                        if (fuse) {
                            float s = (x0.x * x0.x + x0.y * x0.y) + (x0.z * x0.z + x0.w * x0.w) + (x1.x * x1.x + x1.y * x1.y) + (x1.z * x1.z + x1.w * x1.w)
                                    + (y0.x * y0.x + y0.y * y0.y) + (y0.z * y0.z + y0.w * y0.w) + (y1.x * y1.x + y1.y * y1.y) + (y1.z * y1.z + y1.w * y1.w);
                            const float rstd = rsqrtf(wave_sum(s, lane) * (1.0f / DM) + EPS);
                            const f32x4 o0 = y0 * rstd * nm[0] + ns[0], o1 = y1 * rstd * nm[1] + ns[1], o2 = x0 * rstd * nm[2] + ns[2], o3 = x1 * rstd * nm[3] + ns[3];
                            if (l == 1) { f32x4* op = (f32x4*)(P.out + (size_t)t * DM + lane * 8); __builtin_nontemporal_store(o0, op); __builtin_nontemporal_store(o1, op + 1); __builtin_nontemporal_store(o2, op + 128); __builtin_nontemporal_store(o3, op + 129); }
                            else { u32x4 w0, w1; w0.x = cvt_pk_bf16(o0.x, o0.y); w0.y = cvt_pk_bf16(o0.z, o0.w); w0.z = cvt_pk_bf16(o1.x, o1.y); w0.w = cvt_pk_bf16(o1.z, o1.w);
                                w1.x = cvt_pk_bf16(o2.x, o2.y); w1.y = cvt_pk_bf16(o2.z, o2.w); w1.z = cvt_pk_bf16(o3.x, o3.y); w1.w = cvt_pk_bf16(o3.z, o3.w);
                                bf16_t* hp = P_HQ + (size_t)t * DM + lane * 8; *(u32x4*)hp = w0; *(u32x4*)(hp + 512) = w1; }
                        }
                    }
                }
            }
            if (!(l == 1 && qd == 1) || SELFCHECK || REP_COMB > 1 || GRP_MOE > 1) SEAM(pb + 12 + 2 * qd);
        }
        }
    }

    if (IN(NPHASE - 1)) for (int rep_ = 0; rep_ < REP_PRO; ++rep_) {
        PHASE_BEGIN;
#if SELFCHECK
        const unsigned chk_code = __hip_atomic_load((unsigned*)(wsp + WS_CTL) + CW_CHK, __ATOMIC_RELAXED, __HIP_MEMORY_SCOPE_AGENT);
#endif
        const float* gf = INP(25); f32x4 gm[4]; const bf16_t* XS = P_XS;
#pragma unroll
        for (int j = 0; j < 4; ++j) gm[j] = *(const f32x4*)(gf + 4 * lane + 256 * j);
        for (int r = gw; r < ((REP_COMB > 1) ? TL : (SELFCHECK ? 1 : 0)); r += NGW) {
            const u32x2* xr = (const u32x2*)(XS + (size_t)r * DM) + lane; f32x4 v[4]; float s = 0.f;
#pragma unroll
            for (int j = 0; j < 4; ++j) { const u32x2 a = xr[64 * j]; v[j] = (f32x4){bf_lo(a.x), bf_hi(a.x), bf_lo(a.y), bf_hi(a.y)}; s += (v[j].x * v[j].x + v[j].y * v[j].y) + (v[j].z * v[j].z + v[j].w * v[j].w); }
            const float rstd = rsqrtf(wave_sum(s, lane) * (1.0f / DM) + EPS);
            f32x4* o = (f32x4*)(P.out + (size_t)r * DM) + lane;
#pragma unroll
            for (int j = 0; j < 4; ++j) if (!SELFCHECK) o[64 * j] = v[j] * rstd * gm[j];
#if SELFCHECK
            if (r == 0 && lane == 0) { const unsigned w1 = __hip_atomic_load((unsigned*)(wsp + WS_CTL) + CW_CHK + 1 + SELFCHECK_REPORT, __ATOMIC_RELAXED, __HIP_MEMORY_SCOPE_AGENT); P.out[0] = (float)w1; (void)chk_code; }
#endif
        }
    }
#undef IN
#undef SEAM
#undef tstart
#undef ecnt
#undef ulist
#undef uidx
}

extern "C" void kernel_launch(void* const* d_in, const int* in_sizes, int n_in, void* d_out, int out_size, void* d_ws, size_t ws_size, hipStream_t stream) {
    static int grid = 0;
    if (grid == 0) {
        if (n_in != 26 || out_size != TL * DM || ws_size < WS_END) { fprintf(stderr, "kernel_launch: unexpected problem: n_in %d out %d ws %zu (need %zu)\n", n_in, out_size, ws_size, (size_t)WS_END); grid = -1; return; }
        int dev = 0, cus = 0, per_cu = 0;
        if (hipGetDevice(&dev) != hipSuccess || hipDeviceGetAttribute(&cus, hipDeviceAttributeMultiprocessorCount, dev) != hipSuccess) { grid = -1; return; }
        if (hipFuncSetAttribute((const void*)mk_fwd, hipFuncAttributeMaxDynamicSharedMemorySize, LDS_BYTES) != hipSuccess) { fprintf(stderr, "kernel_launch: hipFuncSetAttribute failed\n"); grid = -1; return; }
        if (hipOccupancyMaxActiveBlocksPerMultiprocessor(&per_cu, (const void*)mk_fwd, 512, LDS_BYTES) != hipSuccess || per_cu < 1) { fprintf(stderr, "kernel_launch: occupancy query says %d\n", per_cu); (void)hipGetLastError(); }
        grid = cus;
    }
    if (grid < 0) return;
    (void)hipMemsetAsync((char*)d_ws + WS_CTL, 0, CTL_ZERO_BYTES, stream);
    Params p{};
    for (int i = 0; i < 26; ++i) p.in[i] = (const float*)d_in[i];
    p.out = (float*)d_out; p.ws = (unsigned char*)d_ws; p.pad = 0;
#if MK_N_LAUNCHES == 1
    p.ph_lo = 0; p.ph_hi = NPHASE; p.use_bar = 1;
    hipLaunchKernelGGL(mk_fwd, dim3(grid), dim3(512), LDS_BYTES, stream, p);
#else
    for (int ph = 0; ph < NPHASE; ++ph) { p.ph_lo = ph; p.ph_hi = ph + 1; p.use_bar = 0; hipLaunchKernelGGL(mk_fwd, dim3(grid), dim3(512), LDS_BYTES, stream, p); }
#endif
}
```

```cpp
#include <hip/hip_runtime.h>
#include <cstdio>
#include <cstdint>
#include <cmath>

#ifndef MK_N_LAUNCHES
#define MK_N_LAUNCHES 1
#endif

#ifndef REP_NORM
#define REP_NORM 1
#endif
#ifndef REP_DENSE
#define REP_DENSE 1
#endif
#ifndef REP_ROWS
#define REP_ROWS 1
#endif
#ifndef REP_MOE
#define REP_MOE 1
#endif
#ifndef REP_FFT
#define REP_FFT 1
#endif
#ifndef REP_PRO
#define REP_PRO 1
#endif
#ifndef REP_COMB
#define REP_COMB 1
#endif
#ifndef REP_OUT
#define REP_OUT 1
#endif
#ifndef REP_BAR
#define REP_BAR 1
#endif
#ifndef REP_ATT
#define REP_ATT 1
#endif
#ifndef ATT_VAR
#define ATT_VAR 0
#endif
#ifndef REP_P7
#define REP_P7 1
#endif
#ifndef REP_DOWN
#define REP_DOWN 1
#endif
#ifndef REP_VT
#define REP_VT 1
#endif
#ifndef GRP_MIX
#define GRP_MIX 1
#endif
#ifndef GRP_MOE
#define GRP_MOE 1
#endif
#ifndef REP_ROUTE
#define REP_ROUTE 1
#endif
#define LAS __attribute__((address_space(3)))
#define GAS __attribute__((address_space(1)))
typedef unsigned short bf16_t;
typedef short bf16x8 __attribute__((ext_vector_type(8)));
typedef short s16x4 __attribute__((ext_vector_type(4)));
typedef float f32x4 __attribute__((ext_vector_type(4)));
typedef float f32x2 __attribute__((ext_vector_type(2)));
typedef float f32x16 __attribute__((ext_vector_type(16)));
typedef unsigned u32x4 __attribute__((ext_vector_type(4)));
typedef unsigned u32x2 __attribute__((ext_vector_type(2)));

constexpr int DM = 1024, NB = 2, SEQ = 16384, CTXL = 256, TL = NB * SEQ, TC = NB * CTXL, RT = TL + TC;
constexpr int NINP = 1280;
constexpr int NH = 8, DQK = 96, DV = 64, LK = SEQ + CTXL;
constexpr int NE = 64, DE = 256, NEX = NE + 1;
constexpr int COL_FNO = 256, COL_Q = 512, COL_KV = 896, COL_KR = 1152;
constexpr float EPS = 1e-6f;
constexpr int NSLOT_MAX = 282624 + RT;
constexpr int MAXU = 12;

constexpr size_t MiB = 1u << 20;
constexpr size_t WS_CTL = 0, CTL_ZERO_BYTES = 65536;
constexpr size_t WS_MODS = 65536;
constexpr size_t WS_DW = 1 * MiB, DW_LAYER = 7 * MiB;
constexpr size_t DW_WIN = 0, DW_WUQ = 2560 * 1024, DW_WUKV = 3200 * 1024, DW_WCOMB = 3712 * 1024, DW_WR = 6272 * 1024;
constexpr size_t WS_F1 = 15 * MiB, WS_F2 = WS_F1 + 65536, WS_FC = WS_F2 + 131072, WS_WCS = WS_FC + 262144;
constexpr size_t WS_XS = 17 * MiB;
constexpr size_t WS_X0 = 147 * MiB;
constexpr size_t WS_HQ = WS_X0;
constexpr size_t WS_U = WS_X0 + 65 * MiB;
constexpr size_t WS_KB = WS_U + 83200 * 1024;
constexpr size_t WS_VB = WS_KB + 49920 * 1024;
constexpr size_t WS_YA = WS_VB + 33280 * 1024;
constexpr size_t WS_YP = WS_YA + 83200 * 1024;
constexpr size_t WS_VT8 = WS_YP + 32 * MiB;
constexpr size_t WS_MIX_END = WS_VT8 + (size_t)16 * 260 * 4096;
constexpr size_t WS_EW = WS_X0;
constexpr size_t EW_GU_BYTES = (size_t)NEX * 512 * 1024 * 2, EW_D_BYTES = (size_t)NEX * 1024 * 256 * 2;
constexpr size_t WS_ACT = WS_EW + EW_GU_BYTES + EW_D_BYTES;
constexpr size_t WS_TOKL = WS_ACT + (size_t)NSLOT_MAX * 512;
constexpr size_t WS_TPOS = WS_TOKL + (size_t)NE * RT * 4;
constexpr size_t WS_TW = WS_TPOS + (size_t)RT * 32;
constexpr size_t WS_LOG = WS_TW + (size_t)RT * 32;
constexpr size_t WS_YB = WS_LOG + (size_t)RT * 256;
constexpr size_t WS_END = WS_YB + (size_t)NSLOT_MAX * 512;
static_assert(WS_MIX_END <= 590 * MiB && WS_END <= 590 * MiB, "workspace map must fit the guaranteed 590 MiB");
static_assert(WS_WCS + 262144 <= WS_XS && WS_DW + 2 * DW_LAYER <= WS_F1 && DW_WR + 512 * 1024 <= DW_LAYER, "dense weight map");
static_assert((size_t)RT * 2048 <= (size_t)NSLOT_MAX * 512, "H2 fits in the head of YB");
constexpr int CW_TMO = 0, CW_BAR = 1024, CW_CNT = 8192;

constexpr int LDS_WORK = 131072, IDX_OFF = LDS_WORK, ULIST_OFF = IDX_OFF + MAXU * 1024, TAB_OFF = ULIST_OFF + 512, MISC_OFF = TAB_OFF + 1024, VOC_OFF = MISC_OFF + 512, LDS_BYTES = VOC_OFF + 16384;
static_assert(LDS_BYTES <= 163840, "LDS");

__device__ __forceinline__ unsigned cvt_pk_bf16(float lo, float hi) { unsigned r; asm volatile("v_cvt_pk_bf16_f32 %0, %1, %2" : "=v"(r) : "v"(lo), "v"(hi)); return r; }
__device__ __forceinline__ float bf_lo(unsigned w) { return __uint_as_float(w << 16); }
__device__ __forceinline__ float bf_hi(unsigned w) { return __uint_as_float(w & 0xffff0000u); }
__device__ __forceinline__ float shx(float v, int o, int lane) { return __int_as_float(__builtin_amdgcn_ds_bpermute((lane ^ o) << 2, __float_as_int(v))); }
__device__ __forceinline__ int shxi(int v, int o, int lane) { return __builtin_amdgcn_ds_bpermute((lane ^ o) << 2, v); }
__device__ __forceinline__ float wave_sum(float v, int lane) {
#pragma unroll
    for (int o = 1; o < 32; o <<= 1) v += shx(v, o, lane);
    { auto rr = __builtin_amdgcn_permlane32_swap(__float_as_uint(v), __float_as_uint(v), false, false); v = __uint_as_float(rr[0]) + __uint_as_float(rr[1]); }
    return v;
}
__device__ __forceinline__ float silu_f(float v) { return v * __builtin_amdgcn_rcpf(1.0f + __builtin_amdgcn_exp2f(v * -1.4426950408889634f)); }
typedef int i32x8 __attribute__((ext_vector_type(8)));
__device__ __forceinline__ unsigned pk4_fp8(float a, float b, float c, float d) { unsigned w = __float_as_uint(a); w = __builtin_amdgcn_cvt_pk_fp8_f32(a, b, w, false); w = __builtin_amdgcn_cvt_pk_fp8_f32(c, d, w, true); return w; }
#define LDS_WAIT() asm volatile("s_waitcnt lgkmcnt(0)" ::: "memory")
#define VM_WAIT() asm volatile("s_waitcnt vmcnt(0)" ::: "memory")

#define XB_TMO      128
#define XB_XCNT(j)  (256  + 64 * (j))
#define XB_XSUB(j)  (1280 + 64 * (j))
#define XB_XGEN(j)  (2304 + 64 * (j))
#define XB_TOP      3328
#define XB_TOPGEN   3392
#define XCD_BAR_WORDS 3456
#define XB_SPIN_CAP (1u << 22)
__device__ __forceinline__ unsigned xb_ld(unsigned* p)              { return __hip_atomic_load(p, __ATOMIC_RELAXED, __HIP_MEMORY_SCOPE_AGENT); }
__device__ __forceinline__ unsigned xb_add(unsigned* p, unsigned v) { return __hip_atomic_fetch_add(p, v, __ATOMIC_RELAXED, __HIP_MEMORY_SCOPE_AGENT); }
__device__ __forceinline__ unsigned xb_xcc_id() { return (unsigned)__builtin_amdgcn_s_getreg((3 << 11) | 20) & 0xFu; }
#define XB_SPIN(cond, bar) do { unsigned _sp = 0; while (cond) { __builtin_amdgcn_s_sleep(1); \
    if ((++_sp & 255u) == 0u) { if (xb_ld(&(bar)[XB_TMO])) break; if (_sp > XB_SPIN_CAP) { atomicAdd(&(bar)[XB_TMO], 1u); break; } } } } while (0)
struct XcdBarrier { unsigned* bar; unsigned x; volatile LAS unsigned* st; };
__device__ __forceinline__ XcdBarrier xcd_barrier_post(unsigned* bar, volatile LAS unsigned* st) {
    XcdBarrier b; b.bar = bar; b.x = xb_xcc_id(); b.st = st;
    if (threadIdx.x == 0) (void)xb_add(&bar[XB_XCNT(b.x)], 1u);
    return b;
}
__device__ __forceinline__ void xcd_barrier_complete(unsigned* bar, unsigned x, unsigned& nloc, unsigned& nx) {
    const unsigned G = gridDim.x * gridDim.y * gridDim.z;
    unsigned sum, cnt, mine, sp = 0u;
    for (;;) {
        sum = 0u; cnt = 0u; mine = 0u;
#pragma unroll
        for (unsigned j = 0; j < 16; ++j) { const unsigned c = xb_ld(&bar[XB_XCNT(j)]); sum += c; cnt += (c > 0u) ? 1u : 0u; mine = (j == x) ? c : mine; }
        if (sum == G) break;
        __builtin_amdgcn_s_sleep(1);
        if ((++sp & 255u) == 0u) { if (xb_ld(&bar[XB_TMO])) break; if (sp > XB_SPIN_CAP) { atomicAdd(&bar[XB_TMO], 1u); break; } }
    }
    nloc = mine > 0u ? mine : 1u; nx = cnt > 0u ? cnt : 1u;
}
__device__ __forceinline__ void xcd_barrier(const XcdBarrier& b, const int tid0) {
    asm volatile("s_waitcnt vmcnt(0)" ::: "memory");
    __syncthreads();
    if (tid0 == 0) {
        unsigned* bar = b.bar;
        __builtin_amdgcn_s_waitcnt(0);
        unsigned nloc = b.st[0], nx = b.st[1];
        if (nloc == 0u) { xcd_barrier_complete(bar, b.x, nloc, nx); b.st[0] = nloc; b.st[1] = nx; }
        const unsigned old = xb_add(&bar[XB_XSUB(b.x)], 1u);
        const unsigned gen = old / nloc;
        if (old + 1u == (gen + 1u) * nloc) {
            __builtin_amdgcn_fence(__ATOMIC_RELEASE, "agent");
            asm volatile("s_waitcnt vmcnt(0)" ::: "memory");
            const unsigned og = xb_add(&bar[XB_TOP], 1u);
            const unsigned tg = og / nx;
            if (og + 1u == (tg + 1u) * nx) xb_add(&bar[XB_TOPGEN], 1u);
            else XB_SPIN(xb_ld(&bar[XB_TOPGEN]) == tg, bar);
            __builtin_amdgcn_fence(__ATOMIC_ACQUIRE, "agent");
            xb_add(&bar[XB_XGEN(b.x)], 1u);
            asm volatile("s_waitcnt vmcnt(0)" ::: "memory");
        } else {
            XB_SPIN(xb_ld(&bar[XB_XGEN(b.x)]) == gen, bar);
            __builtin_amdgcn_fence(__ATOMIC_ACQUIRE, "agent");
            asm volatile("s_waitcnt vmcnt(0)" ::: "memory");
        }
    }
    __syncthreads();
}

namespace pg8 {
constexpr int BM = 256, BK = 64, HALF = 128, HTB = HALF * BK * 2, STAGE_BYTES = 8 * HTB, NXCD = 8, WGM = 8;
__device__ __forceinline__ int lds_byte(int r, int c) { const int st = (r >> 4) * 2 + (c >> 5), rr = r & 15, cc = c & 31, ob = rr * 64 + cc * 2; return st * 1024 + (ob ^ (((ob >> 9) & 1) << 5)); }
__device__ __forceinline__ void stage_rc(int b, int& R, int& C) { const int st = b / 1024, sb = b % 1024, swz = sb ^ (((sb >> 9) & 1) << 5); R = (st >> 1) * 16 + swz / 64; C = (st & 1) * 32 + (swz % 64) / 2; }
__device__ __forceinline__ int perm32(int rho) { const int n = rho >> 4, i = rho & 15; return 8 * (i >> 2) + 4 * n + (i & 3); }
struct Unit { int pm, pn, e, aux; };

template <class Epi, class Sched, bool F8 = false>
__device__ __forceinline__ void gemm_phase(LAS unsigned char* lds, const int K, const Sched& S, const Epi& E, const int tid) {
    const int wid = __builtin_amdgcn_readfirstlane(tid >> 6), lane = tid & 63, wr = wid >> 2, wc = wid & 3, fr = lane & 15, fq = lane >> 4;
    const int nt = F8 ? K / 128 : K / BK;
    int Rr[2], Cc[2]; unsigned voffB[2]; const unsigned vstepB = F8 ? (unsigned)(64 * K) : (unsigned)(64 * K) * 2u;
#pragma unroll
    for (int i = 0; i < 2; ++i) { int R, C; stage_rc(tid * 16 + i * 8192, R, C); const int Rb = Epi::PERM ? ((R & ~31) + perm32(R & 31)) : R; Rr[i] = R; Cc[i] = C; voffB[i] = F8 ? (unsigned)(Rb * K + 2 * C) : (unsigned)(Rb * K + C) * 2u; }
    const size_t kstep = (size_t)(BK * 2);
    const size_t hstep = F8 ? (size_t)HALF * K : (size_t)HALF * K * 2;
    const unsigned ldsw = (unsigned)wid * 1024u;
    const int aoff = lds_byte(wr * 64 + fr, fq * 8), boff = lds_byte(wc * 32 + fr, fq * 8);
    const int f8in = (fq >> 1) * 1024 + ((fr * 64 + 32 * (fq & 1)) ^ ((fr >> 3) << 5)); const int aoff8 = 8 * wr * 1024 + f8in; const int bdiff8 = (4 * wc - 8 * wr) * 1024;
#define PG8_SA(b, h) (((b) * 2 + (h)) * HTB)
#define PG8_SB(b, h) ((4 + (b) * 2 + (h)) * HTB)
#define PG8_STAGE(bufoff, gbase, voff) do { _Pragma("unroll") for (int _i = 0; _i < 2; ++_i) { unsigned vo_ = (voff)[0] + (unsigned)_i * vstepB; asm volatile("" : "+v"(vo_));         \
        __builtin_amdgcn_global_load_lds((const unsigned*)((const char*)(gbase) + vo_), (LAS unsigned*)(lds + (bufoff) + ldsw + _i * 8192), 16, 0, 0); } } while (0)
#define PG8_STAGEA(bufoff, o0, o1) do { \
        __builtin_amdgcn_global_load_lds((const unsigned*)(aB + (size_t)(o0)), (LAS unsigned*)(lds + (bufoff) + ldsw), 16, 0, 0); \
        __builtin_amdgcn_global_load_lds((const unsigned*)(aB + (size_t)(o1)), (LAS unsigned*)(lds + (bufoff) + ldsw + 8192), 16, 0, 0); } while (0)
#define PG8_LDA(dst, b, h) do { if constexpr (F8) { _Pragma("unroll") for (int m = 0; m < 4; ++m) { typedef int i32x4_ __attribute__((ext_vector_type(4))); const i32x4_ x_ = *(const LAS i32x4_*)(lds + PG8_SA(b, h) + aoff8 + m * 2048), y_ = *(const LAS i32x4_*)(lds + PG8_SA(b, h) + aoff8 + m * 2048 + 16); \
            dst##8[m] = __builtin_shufflevector(x_, y_, 0, 1, 2, 3, 4, 5, 6, 7); } } \
        else { _Pragma("unroll") for (int m = 0; m < 4; ++m) _Pragma("unroll") for (int k = 0; k < 2; ++k) dst[m][k] = *(const LAS bf16x8*)(lds + PG8_SA(b, h) + aoff + m * 2048 + k * 1024); } } while (0)
#define PG8_LDB(dst, b, h) do { if constexpr (F8) { int boff8 = aoff8 + bdiff8; asm volatile("" : "+v"(boff8)); _Pragma("unroll") for (int n = 0; n < 2; ++n) { typedef int i32x4_ __attribute__((ext_vector_type(4))); const i32x4_ x_ = *(const LAS i32x4_*)(lds + PG8_SB(b, h) + boff8 + n * 2048), y_ = *(const LAS i32x4_*)(lds + PG8_SB(b, h) + boff8 + n * 2048 + 16); \
            dst##8[n] = __builtin_shufflevector(x_, y_, 0, 1, 2, 3, 4, 5, 6, 7); } } \
        else { _Pragma("unroll") for (int n = 0; n < 2; ++n) _Pragma("unroll") for (int k = 0; k < 2; ++k) dst[n][k] = *(const LAS bf16x8*)(lds + PG8_SB(b, h) + boff + n * 2048 + k * 1024); } } while (0)
#define PG8_MMA(ai, bj, At, Bt) do { __builtin_amdgcn_s_setprio(1); if constexpr (F8) { _Pragma("unroll") for (int m = 0; m < 4; ++m) _Pragma("unroll") for (int n = 0; n < 2; ++n) \
            acc[ai][bj][m][n] = __builtin_amdgcn_mfma_scale_f32_16x16x128_f8f6f4(Bt##8[n], At##8[m], acc[ai][bj][m][n], 0, 0, 0, 0, 0, 0); } \
        else { _Pragma("unroll") for (int m = 0; m < 4; ++m) _Pragma("unroll") for (int n = 0; n < 2; ++n) _Pragma("unroll") for (int k = 0; k < 2; ++k) \
            acc[ai][bj][m][n] = __builtin_amdgcn_mfma_f32_16x16x32_bf16(Bt[n][k], At[m][k], acc[ai][bj][m][n], 0, 0, 0); } __builtin_amdgcn_s_setprio(0); } while (0)
#define PG8_WAIT_V(n) asm volatile("s_waitcnt vmcnt(" #n ")" ::: "memory")
#define PG8_WAIT_L(n) asm volatile("s_waitcnt lgkmcnt(" #n ")" ::: "memory")
#define PG8_BAR __builtin_amdgcn_s_barrier()
#define PG8_SCHED __builtin_amdgcn_sched_barrier(0)
    Unit cur, nxt; int ui = 0;
    if (!S.next(0, cur)) return;
    f32x4 acc[2][2][4][2];
#pragma unroll
    for (int a = 0; a < 2; ++a)
#pragma unroll
        for (int b = 0; b < 2; ++b)
#pragma unroll
            for (int m = 0; m < 4; ++m)
#pragma unroll
                for (int n = 0; n < 2; ++n) acc[a][b][m][n] = (f32x4){0.f, 0.f, 0.f, 0.f};
    bf16x8 At[4][2], B0[2][2], B1[2][2]; i32x8 At8[4], B08[2], B18[2];
    unsigned voc[2][2];
    S.a_off(cur, Rr, Cc, voc);
    const int vso = VOC_OFF + wid * 2048 - 8 * wr * 1024; int csel = 0;
    if constexpr (F8) *(LAS u32x4*)(lds + vso + aoff8) = (u32x4){voc[0][0], voc[0][1], voc[1][0], voc[1][1]};
#define PG8_RDV(sel, h) (*(const LAS u32x2*)(lds + vso + aoff8 + (sel) + (h) * 8))
    const char* const aB = S.a_base();
    const char* cB = S.b_base(cur);
    PG8_STAGE(PG8_SB(0, 0), cB, voffB); PG8_STAGE(PG8_SB(0, 1), cB + hstep, voffB); PG8_STAGEA(PG8_SA(0, 0), voc[0][0], voc[0][1]); PG8_STAGEA(PG8_SA(0, 1), voc[1][0], voc[1][1]);
    if (wr == 1) PG8_BAR;
    PG8_WAIT_V(2); PG8_BAR;
    PG8_STAGE(PG8_SB(1, 0), cB + kstep, voffB); PG8_STAGEA(PG8_SA(1, 0), voc[0][0] + 128u, voc[0][1] + 128u); PG8_STAGE(PG8_SB(1, 1), cB + hstep + kstep, voffB);
    PG8_WAIT_V(6); PG8_BAR;
    for (;;) {
        const bool has_next = S.next(ui + 1, nxt);
        const char* nB = has_next ? S.b_base(nxt) : cB;
#pragma unroll 1
        for (int t = 0; t < nt; t += 2) {
            const bool last = (t == nt - 2);
            const unsigned k1b = (unsigned)(t + 1) * 128u, k2b = last ? 0u : (unsigned)(t + 2) * 128u;
            const char* b2 = last ? nB : cB + (size_t)(t + 2) * kstep; const char* b3 = b2 + kstep;
            if constexpr (F8) {
                int tl0_; asm volatile("v_mbcnt_lo_u32_b32 %0, -1, 0\n\tv_mbcnt_hi_u32_b32 %0, -1, %0" : "=v"(tl0_));
                const int fr0_ = tl0_ & 15, fq0_ = tl0_ >> 4; const int aoff8 = 8 * wr * 1024 + (fq0_ >> 1) * 1024 + ((fr0_ * 64 + 32 * (fq0_ & 1)) ^ ((fr0_ >> 3) << 5));
                const bool sw = last && has_next; const int nsel = sw ? (csel ^ 16) : csel;
                if (sw) {
                    unsigned vn[2][2]; int tl_; asm volatile("v_mbcnt_lo_u32_b32 %0, -1, 0\n\tv_mbcnt_hi_u32_b32 %0, -1, %0" : "=v"(tl_)); tl_ += wid * 64; int R2[2], C2[2];
#pragma unroll
                    for (int i = 0; i < 2; ++i) stage_rc(tl_ * 16 + i * 8192, R2[i], C2[i]);
                    S.a_off(nxt, R2, C2, vn); *(LAS u32x4*)(lds + vso + aoff8 + nsel) = (u32x4){vn[0][0], vn[0][1], vn[1][0], vn[1][1]};
                }
                { const u32x2 o_ = PG8_RDV(csel, 1);
                  PG8_LDB(B0, 0, 0); PG8_LDB(B1, 0, 1); PG8_SCHED; PG8_LDA(At, 0, 0); PG8_STAGEA(PG8_SA(1, 1), o_.x + k1b, o_.y + k1b); }
                PG8_WAIT_V(8); PG8_WAIT_L(0); PG8_BAR; PG8_MMA(0, 0, At, B0); PG8_MMA(0, 1, At, B1); PG8_BAR; PG8_SCHED;
                { const u32x2 o_ = PG8_RDV(nsel, 0);
                  PG8_LDA(At, 0, 1); PG8_STAGE(PG8_SB(0, 0), b2, voffB); PG8_STAGE(PG8_SB(0, 1), b2 + hstep, voffB); PG8_STAGEA(PG8_SA(0, 0), o_.x + k2b, o_.y + k2b); }
                PG8_WAIT_V(8); PG8_WAIT_L(0); PG8_BAR; PG8_MMA(1, 0, At, B0); PG8_MMA(1, 1, At, B1); PG8_BAR; PG8_SCHED;
                { const u32x2 o_ = PG8_RDV(nsel, 1);
                  PG8_LDB(B0, 1, 0); PG8_LDB(B1, 1, 1); PG8_SCHED; PG8_LDA(At, 1, 0); PG8_STAGEA(PG8_SA(0, 1), o_.x + k2b, o_.y + k2b); }
                PG8_WAIT_V(8); PG8_WAIT_L(0); PG8_BAR; PG8_MMA(0, 0, At, B0); PG8_MMA(0, 1, At, B1); PG8_BAR; PG8_SCHED;
                { const u32x2 o_ = PG8_RDV(nsel, 0);
                  PG8_LDA(At, 1, 1); PG8_STAGE(PG8_SB(1, 0), b3, voffB); PG8_STAGE(PG8_SB(1, 1), b3 + hstep, voffB); PG8_STAGEA(PG8_SA(1, 0), o_.x + (k2b + 128u), o_.y + (k2b + 128u)); }
                PG8_WAIT_V(8); PG8_WAIT_L(0); PG8_BAR; PG8_MMA(1, 0, At, B0); PG8_MMA(1, 1, At, B1); PG8_BAR; PG8_SCHED;
            } else {
            unsigned s00 = voc[0][0] + k2b, s01 = voc[0][1] + k2b, s10 = voc[1][0] + k2b, s11 = voc[1][1] + k2b;
            if (last && has_next) {
                unsigned vn[2][2]; int tl_; asm volatile("v_mbcnt_lo_u32_b32 %0, -1, 0\n\tv_mbcnt_hi_u32_b32 %0, -1, %0" : "=v"(tl_)); tl_ += wid * 64; int R2[2], C2[2];
#pragma unroll
                for (int i = 0; i < 2; ++i) stage_rc(tl_ * 16 + i * 8192, R2[i], C2[i]);
                S.a_off(nxt, R2, C2, vn); s00 = vn[0][0]; s01 = vn[0][1]; s10 = vn[1][0]; s11 = vn[1][1];
            }
            PG8_LDB(B0, 0, 0); PG8_LDB(B1, 0, 1); PG8_SCHED; PG8_LDA(At, 0, 0); PG8_STAGEA(PG8_SA(1, 1), voc[1][0] + k1b, voc[1][1] + k1b);
            PG8_WAIT_V(8); PG8_WAIT_L(0); PG8_BAR; PG8_MMA(0, 0, At, B0); PG8_MMA(0, 1, At, B1); PG8_BAR; PG8_SCHED;
            PG8_LDA(At, 0, 1); PG8_STAGE(PG8_SB(0, 0), b2, voffB); PG8_STAGE(PG8_SB(0, 1), b2 + hstep, voffB); PG8_STAGEA(PG8_SA(0, 0), s00, s01);
            PG8_WAIT_V(8); PG8_WAIT_L(0); PG8_BAR; PG8_MMA(1, 0, At, B0); PG8_MMA(1, 1, At, B1); PG8_BAR; PG8_SCHED;
            PG8_LDB(B0, 1, 0); PG8_LDB(B1, 1, 1); PG8_SCHED; PG8_LDA(At, 1, 0); PG8_STAGEA(PG8_SA(0, 1), s10, s11);
            PG8_WAIT_V(8); PG8_WAIT_L(0); PG8_BAR; PG8_MMA(0, 0, At, B0); PG8_MMA(0, 1, At, B1); PG8_BAR; PG8_SCHED;
            PG8_LDA(At, 1, 1); PG8_STAGE(PG8_SB(1, 0), b3, voffB); PG8_STAGE(PG8_SB(1, 1), b3 + hstep, voffB); PG8_STAGEA(PG8_SA(1, 0), s00 + 128u, s01 + 128u);
            PG8_WAIT_V(8); PG8_WAIT_L(0); PG8_BAR; PG8_MMA(1, 0, At, B0); PG8_MMA(1, 1, At, B1); PG8_BAR; PG8_SCHED;
            }
        }
        if (wr == 0) PG8_BAR;
        if constexpr (F8) { int tl_; asm volatile("v_mbcnt_lo_u32_b32 %0, -1, 0\n\tv_mbcnt_hi_u32_b32 %0, -1, %0" : "=v"(tl_)); E(acc, cur, wr, wc, tl_ & 15, tl_ >> 4); }
        else E(acc, cur, wr, wc, fr, fq);
        if (!has_next) break;
#pragma unroll
        for (int a = 0; a < 2; ++a)
#pragma unroll
            for (int b = 0; b < 2; ++b)
#pragma unroll
                for (int m = 0; m < 4; ++m)
#pragma unroll
                    for (int n = 0; n < 2; ++n) acc[a][b][m][n] = (f32x4){0.f, 0.f, 0.f, 0.f};
        cur = nxt; cB = nB; ++ui;
        if constexpr (F8) csel ^= 16;
        else { int tl_; asm volatile("v_mbcnt_lo_u32_b32 %0, -1, 0\n\tv_mbcnt_hi_u32_b32 %0, -1, %0" : "=v"(tl_)); tl_ += wid * 64; int R2[2], C2[2];
#pragma unroll
          for (int i = 0; i < 2; ++i) stage_rc(tl_ * 16 + i * 8192, R2[i], C2[i]);
          S.a_off(cur, R2, C2, voc); }
        if (wr == 1) PG8_BAR;
    }
    PG8_WAIT_V(0);
    PG8_BAR;
#undef PG8_SA
#undef PG8_SB
#undef PG8_STAGE
#undef PG8_STAGEA
#undef PG8_RDV
#undef PG8_LDA
#undef PG8_LDB
#undef PG8_MMA
#undef PG8_WAIT_V
#undef PG8_WAIT_L
#undef PG8_BAR
#undef PG8_SCHED
}

struct DenseSched {
    int nM, nN, nwg, G, c; const char* A; unsigned lda_b; const char* Bt; int K;
    __device__ __forceinline__ void init(int M, int N, int G_, int c_, const void* A_, int lda_elems, const void* Bt_, int K_) { nM = M / BM; nN = N / BM; nwg = nM * nN; G = G_; c = c_; A = (const char*)A_; lda_b = (unsigned)lda_elems * 2u; Bt = (const char*)Bt_; K = K_; }
    __device__ __forceinline__ bool next(int i, Unit& u) const {
        const long L = (long)i * G + c; if (L >= nwg) return false;
        int wgid = (int)L; { const int q = nwg / NXCD, r = nwg % NXCD, xcd = wgid % NXCD, off = wgid / NXCD; wgid = (xcd < r ? xcd * (q + 1) : r * (q + 1) + (xcd - r) * q) + off; }
        const int nig = WGM * nN, gid = wgid / nig, fm = gid * WGM, gsz = (nM - fm) < WGM ? (nM - fm) : WGM;
        u.pm = fm + ((wgid % nig) % gsz); u.pn = (wgid % nig) / gsz; u.e = 0; u.aux = 0; return true;
    }
    __device__ __forceinline__ void a_off(const Unit& u, const int (&R)[2], const int (&C)[2], unsigned (&vo)[2][2]) const {
#pragma unroll
        for (int h = 0; h < 2; ++h)
#pragma unroll
            for (int i = 0; i < 2; ++i) vo[h][i] = (unsigned)(u.pm * BM + h * HALF + R[i]) * lda_b + (unsigned)C[i] * 2u;
    }
    __device__ __forceinline__ const char* a_base() const { return A; }
    __device__ __forceinline__ const char* b_base(const Unit& u) const { return Bt + (size_t)u.pn * BM * K * 2; }
};
struct MoeSched {
    const LAS int* ulist; const LAS int* uidx; int nu; const char* A; const char* Bt; int mode  ; int quarter;
    __device__ __forceinline__ bool next(int i, Unit& u) const {
        if (i >= nu) return false;
        u.e = __builtin_amdgcn_readfirstlane(ulist[i * 4 + 0]); u.pm = __builtin_amdgcn_readfirstlane(ulist[i * 4 + 1]); u.pn = __builtin_amdgcn_readfirstlane(ulist[i * 4 + 2]); u.aux = i; return true;
    }
    __device__ __forceinline__ void a_off(const Unit& u, const int (&R)[2], const int (&C)[2], unsigned (&vo)[2][2]) const {
        if (mode == 0) {
#pragma unroll
            for (int i = 0; i < 2; ++i) { const LAS int* p = uidx + u.aux * 256 + R[i]; vo[0][i] = (unsigned)p[0] * 1024u + (unsigned)C[i] * 2u; vo[1][i] = (unsigned)p[HALF] * 1024u + (unsigned)C[i] * 2u; }
        } else {
#pragma unroll
            for (int h = 0; h < 2; ++h)
#pragma unroll
                for (int i = 0; i < 2; ++i) vo[h][i] = (unsigned)(u.pm * BM + h * HALF + R[i]) * 256u + (unsigned)C[i] * 2u;
        }
    }
    __device__ __forceinline__ const char* a_base() const { return A; }
    __device__ __forceinline__ const char* b_base(const Unit& u) const {
        return mode == 0 ? Bt + ((size_t)u.e * 512 + (size_t)u.pn * 256) * 1024 : Bt + ((size_t)u.e * 1024 + (size_t)quarter * 512 + (size_t)u.pn * 256) * 256;
    }
};

struct EpiBf16 {
    static constexpr bool PERM = true;
    bf16_t* O; int ldc; int col_tile0;
    __device__ __forceinline__ void operator()(const f32x4 (&acc)[2][2][4][2], const Unit& u, int wr, int wc, int fr, int fq) const {
        const int row0 = u.pm * BM + wr * 64 + fr; const int col0 = (col_tile0 ? 0 : u.pn * BM) + wc * 32 + 8 * fq;
#pragma unroll
        for (int ai = 0; ai < 2; ++ai)
#pragma unroll
            for (int m = 0; m < 4; ++m) { bf16_t* rowp = O + (size_t)(row0 + ai * HALF + m * 16) * ldc + col0;
#pragma unroll
                for (int bj = 0; bj < 2; ++bj) { const f32x4 v0 = acc[ai][bj][m][0], v1 = acc[ai][bj][m][1];
                    u32x4 w; w.x = cvt_pk_bf16(v0[0], v0[1]); w.y = cvt_pk_bf16(v0[2], v0[3]); w.z = cvt_pk_bf16(v1[0], v1[1]); w.w = cvt_pk_bf16(v1[2], v1[3]);
                    *(u32x4*)(rowp + bj * HALF) = w; } }
    }
};
struct EpiFp8 {
    static constexpr bool PERM = false;
    unsigned char* O; int ldc; float oscale;
    __device__ __forceinline__ void operator()(const f32x4 (&acc)[2][2][4][2], const Unit& u, int wr, int wc, int fr, int fq) const {
        const int row0 = u.pm * BM + wr * 64 + fr; const int col0 = u.pn * BM + wc * 64 + 16 * fq;
#pragma unroll
        for (int ai = 0; ai < 2; ++ai)
#pragma unroll
            for (int m = 0; m < 4; ++m) { u32x4 w;
                { const f32x4 a0 = acc[ai][0][m][0] * oscale, a1 = acc[ai][0][m][1] * oscale, b0 = acc[ai][1][m][0] * oscale, b1 = acc[ai][1][m][1] * oscale;
                  w.x = pk4_fp8(a0[0], a0[1], a0[2], a0[3]); w.y = pk4_fp8(a1[0], a1[1], a1[2], a1[3]); w.z = pk4_fp8(b0[0], b0[1], b0[2], b0[3]); w.w = pk4_fp8(b1[0], b1[1], b1[2], b1[3]); }
                *(u32x4*)(O + (unsigned)((row0 + ai * HALF + m * 16) * ldc + col0)) = w; }
    }
};
struct EpiKV {
    static constexpr bool PERM = true;
    unsigned char* K8; bf16_t* Vb;
    __device__ __forceinline__ void operator()(const f32x4 (&acc)[2][2][4][2], const Unit& u, int wr, int wc, int fr, int fq) const {
        const int row0 = u.pm * BM + wr * 64 + fr;
#pragma unroll
        for (int ai = 0; ai < 2; ++ai)
#pragma unroll
            for (int m = 0; m < 4; ++m) { const int row = row0 + ai * HALF + m * 16; int b, key;
                if (row < TL) { b = row >> 14; key = CTXL + (row & (SEQ - 1)); } else { const int rr = row - TL; b = rr >> 8; key = rr & (CTXL - 1); }
#pragma unroll
                for (int bj = 0; bj < 2; ++bj) { const int col0 = u.pn * BM + bj * HALF + wc * 32 + 8 * fq, h = col0 >> 7, j = col0 & 127;
                    const f32x4 v0 = acc[ai][bj][m][0], v1 = acc[ai][bj][m][1];
                    if (j < 64) { u32x2 w; w.x = pk4_fp8(v0[0], v0[1], v0[2], v0[3]); w.y = pk4_fp8(v1[0], v1[1], v1[2], v1[3]);
                        *(u32x2*)(K8 + ((size_t)(b * NH + h) * LK + key) * 128 + j) = w; }
                    else { u32x4 w; w.x = cvt_pk_bf16(v0[0], v0[1]); w.y = cvt_pk_bf16(v0[2], v0[3]); w.z = cvt_pk_bf16(v1[0], v1[1]); w.w = cvt_pk_bf16(v1[2], v1[3]);
                        *(u32x4*)(Vb + ((size_t)(b * NH + h) * LK + key) * DV + (j - 64)) = w; } } }
    }
};
struct EpiResid {
    static constexpr bool PERM = false;
    const float* xlat; const float* xctx; const bf16_t* xsin; bf16_t* XS; const float* mods; float gscale;
    __device__ __forceinline__ void operator()(const f32x4 (&acc)[2][2][4][2], const Unit& u, int wr, int wc, int fr, int fq) const {
        const int rowt = u.pm * BM; const int vec = rowt < SEQ ? 0 : (rowt < TL ? 1 : 2);
        const float* gate = mods + vec * 6144 + 2 * DM;
        const float* xin = rowt < TL ? xlat + (size_t)rowt * DM : xctx + (size_t)(rowt - TL) * DM;
        const bf16_t* xib = xsin + (size_t)rowt * DM;
        bf16_t* xo = XS + (size_t)rowt * DM;
        const int r0 = wr * 64 + fr, col0 = u.pn * BM + wc * 64 + 16 * fq;
        f32x4 gv[2][2];
#pragma unroll
        for (int bj = 0; bj < 2; ++bj)
#pragma unroll
            for (int n = 0; n < 2; ++n) { gv[bj][n] = *(const f32x4*)(gate + col0 + 8 * bj + 4 * n); if (REP_OUT > 1) gv[bj][n] = gv[bj][n] * gscale; }
#pragma unroll
        for (int ai = 0; ai < 2; ++ai)
#pragma unroll
            for (int m = 0; m < 4; ++m) { const unsigned off = (unsigned)((r0 + ai * HALF + m * 16) * DM + col0); f32x4 xv[2][2];
                if (xsin) { const u32x4 a = *(const u32x4*)(xib + off), b = *(const u32x4*)(xib + off + 8);
                    xv[0][0] = (f32x4){bf_lo(a.x), bf_hi(a.x), bf_lo(a.y), bf_hi(a.y)}; xv[0][1] = (f32x4){bf_lo(a.z), bf_hi(a.z), bf_lo(a.w), bf_hi(a.w)};
                    xv[1][0] = (f32x4){bf_lo(b.x), bf_hi(b.x), bf_lo(b.y), bf_hi(b.y)}; xv[1][1] = (f32x4){bf_lo(b.z), bf_hi(b.z), bf_lo(b.w), bf_hi(b.w)}; }
                else {
#pragma unroll
                    for (int bj = 0; bj < 2; ++bj)
#pragma unroll
                        for (int n = 0; n < 2; ++n) xv[bj][n] = __builtin_nontemporal_load((const f32x4*)(xin + off + 8 * bj + 4 * n)); }
                u32x4 o[2];
#pragma unroll
                for (int bj = 0; bj < 2; ++bj) { const f32x4 y0 = xv[bj][0] + gv[bj][0] * acc[ai][bj][m][0], y1 = xv[bj][1] + gv[bj][1] * acc[ai][bj][m][1];
                    o[bj].x = cvt_pk_bf16(y0.x, y0.y); o[bj].y = cvt_pk_bf16(y0.z, y0.w); o[bj].z = cvt_pk_bf16(y1.x, y1.y); o[bj].w = cvt_pk_bf16(y1.z, y1.w); }
                *(u32x4*)(xo + off) = o[0]; *(u32x4*)(xo + off + 8) = o[1];
                asm volatile("" ::: "memory"); }
    }
};
struct EpiLogits {
    static constexpr bool PERM = false;
    float* Lg;
    __device__ __forceinline__ void operator()(const f32x4 (&acc)[2][2][4][2], const Unit& u, int wr, int wc, int fr, int fq) const {
        if (wc >= 2) return;
        const int row0 = u.pm * BM + wr * 64 + fr, col0 = wc * 32 + 4 * fq;
#pragma unroll
        for (int ai = 0; ai < 2; ++ai)
#pragma unroll
            for (int m = 0; m < 4; ++m)
#pragma unroll
                for (int n = 0; n < 2; ++n) *(f32x4*)(Lg + (size_t)(row0 + ai * HALF + m * 16) * NE + col0 + n * 16) = acc[ai][0][m][n];
    }
};
struct EpiSwiGLU {
    static constexpr bool PERM = false;
    bf16_t* ACT; float wscale;
    __device__ __forceinline__ void operator()(const f32x4 (&acc)[2][2][4][2], const Unit& u, int wr, int wc, int fr, int fq) const {
        const unsigned off0 = (unsigned)(u.pm * BM + wr * 64 + fr) * DE + (unsigned)(u.pn * 128 + wc * 32 + 8 * fq);
#pragma unroll
        for (int ai = 0; ai < 2; ++ai)
#pragma unroll
            for (int m = 0; m < 4; ++m) { u32x2 w;
#pragma unroll
                for (int bj = 0; bj < 2; ++bj) { const f32x4 g = acc[ai][bj][m][0] * wscale, v = acc[ai][bj][m][1] * wscale;
                    w[bj] = pk4_fp8(silu_f(g[0]) * v[0], silu_f(g[1]) * v[1], silu_f(g[2]) * v[2], silu_f(g[3]) * v[3]); }
                *(u32x2*)((char*)ACT + (off0 + (unsigned)((ai * HALF + m * 16) * DE))) = w; }
    }
};
}

namespace att {
constexpr int NW = 8, QBLK = 32, KVBLK = 64, KROW = 208;
constexpr int SHM_V = KVBLK * DV * 2, SHM_K = KVBLK * KROW, OFF_K = 2 * SHM_V, OFF_WS = OFF_K + 2 * SHM_K, OFF_OST = OFF_WS + NW * 64 * 4, LDS_ATT = OFF_OST + NW * 4096;
static_assert(LDS_ATT <= LDS_WORK, "attention LDS");
constexpr float SCALE = 0.10206207261596575f;
constexpr float THR = 8.f;
#define SBAR() __builtin_amdgcn_sched_barrier(0)
__device__ __forceinline__ int crow(int r, int hi) { return (r & 3) + 8 * (r >> 2) + 4 * hi; }
__device__ __forceinline__ void partialSM(f32x16& p0, f32x16& p1, float& m_reg, float& mn, float& alpha) {
    constexpr float C = SCALE * 1.4426950408889634f;
    float pmax = p0[0];
#pragma unroll
    for (int r = 1; r < 16; ++r) pmax = fmaxf(pmax, p0[r]);
#pragma unroll
    for (int r = 0; r < 16; ++r) pmax = fmaxf(pmax, p1[r]);
    { auto rr = __builtin_amdgcn_permlane32_swap(__float_as_uint(pmax), __float_as_uint(pmax), false, false);
      pmax = fmaxf(__uint_as_float(rr[0]), __uint_as_float(rr[1])); }
    if (__builtin_expect(__all(pmax - m_reg <= THR / SCALE), 1)) { mn = m_reg; alpha = 1.f; }
    else { mn = fmaxf(m_reg, pmax); alpha = __builtin_amdgcn_exp2f((m_reg - mn) * C); m_reg = mn; }
    const float mnC = -mn * C;
#pragma unroll
    for (int r = 0; r < 16; ++r) p0[r] = fmaf(p0[r], C, mnC);
#pragma unroll
    for (int r = 0; r < 16; ++r) p1[r] = fmaf(p1[r], C, mnC);
#pragma unroll
    for (int r = 0; r < 16; ++r) p0[r] = __builtin_amdgcn_exp2f(p0[r]);
}
__device__ __forceinline__ void finishSM(f32x16& p0, f32x16& p1, float alpha, float& l_reg, bf16x8& pa0, bf16x8& pa1, bf16x8& pa2, bf16x8& pa3) {
#pragma unroll
    for (int r = 0; r < 16; ++r) p1[r] = __builtin_amdgcn_exp2f(p1[r]);
    float ps = 0;
#pragma unroll
    for (int r = 0; r < 16; ++r) ps += p0[r];
#pragma unroll
    for (int r = 0; r < 16; ++r) ps += p1[r];
    { auto rr = __builtin_amdgcn_permlane32_swap(__float_as_uint(ps), __float_as_uint(ps), false, false);
      ps = __uint_as_float(rr[0]) + __uint_as_float(rr[1]); }
    l_reg = l_reg * alpha + ps;
#define PK4(P, BASE, OUT) do { unsigned a0 = cvt_pk_bf16(P[BASE + 0], P[BASE + 1]), a1 = cvt_pk_bf16(P[BASE + 2], P[BASE + 3]);   \
    unsigned b0 = cvt_pk_bf16(P[BASE + 4], P[BASE + 5]), b1 = cvt_pk_bf16(P[BASE + 6], P[BASE + 7]);                              \
    auto r0 = __builtin_amdgcn_permlane32_swap(a0, b0, false, false); auto r1 = __builtin_amdgcn_permlane32_swap(a1, b1, false, false); \
    u32x4 w = {r0[0], r1[0], r0[1], r1[1]}; OUT = *reinterpret_cast<bf16x8*>(&w); } while (0)
    PK4(p0, 0, pa0); PK4(p0, 8, pa1); PK4(p1, 0, pa2); PK4(p1, 8, pa3);
#undef PK4
}
__device__ __forceinline__ void qkt(f32x16& p0, f32x16& p1, const LAS char* Ks, const bf16x8* qr, int r32, int hi) {
    p0 = f32x16{}; p1 = f32x16{};
#pragma unroll
    for (int d0 = 0; d0 < 6; ++d0) { const int cb = (d0 * 16 + hi * 8) * 2;
        const bf16x8 b0 = *reinterpret_cast<const LAS bf16x8*>(Ks + r32 * KROW + cb);
        const bf16x8 b1 = *reinterpret_cast<const LAS bf16x8*>(Ks + (32 + r32) * KROW + cb);
        p0 = __builtin_amdgcn_mfma_f32_32x32x16_bf16(b0, qr[d0], p0, 0, 0, 0);
        p1 = __builtin_amdgcn_mfma_f32_32x32x16_bf16(b1, qr[d0], p1, 0, 0, 0); }
}
__device__ __forceinline__ int v_st(int k, int c) { const int kk = (k & ~0xC) | ((k & 4) << 1) | ((k & 8) >> 1); return ((kk >> 3) * 2 + (c >> 5)) * 512 + ((kk & 7) * 32 + (c & 31)) * 2; }
__device__ __forceinline__ int v_rd_base(int lane) { return ((lane & 3) << 3) | (((lane >> 2) & 3) << 6) | (((lane >> 4) & 1) << 5) | (((lane >> 5) & 1) << 8); }
template <int OFF> __device__ __forceinline__ s16x4 tr_read(int vb) {
    s16x4 r; asm volatile("ds_read_b64_tr_b16 %0, %1 offset:%2" : "=&v"(r) : "v"(vb), "i"(OFF) : "memory"); return r;
}
template <int D0> __device__ __forceinline__ void pv_one(f32x16& od, int vb, bf16x8 pa0, bf16x8 pa1, bf16x8 pa2, bf16x8 pa3) {
    const s16x4 l0 = tr_read<D0 * 512 + 0 * 2048>(vb), h0 = tr_read<D0 * 512 + 0 * 2048 + 1024>(vb), l1 = tr_read<D0 * 512 + 1 * 2048>(vb), h1 = tr_read<D0 * 512 + 1 * 2048 + 1024>(vb);
    const s16x4 l2 = tr_read<D0 * 512 + 2 * 2048>(vb), h2 = tr_read<D0 * 512 + 2 * 2048 + 1024>(vb), l3 = tr_read<D0 * 512 + 3 * 2048>(vb), h3 = tr_read<D0 * 512 + 3 * 2048 + 1024>(vb);
    asm volatile("s_waitcnt lgkmcnt(0)" ::: "memory"); SBAR();
#define PK(L, H) (bf16x8){L[0], L[1], L[2], L[3], H[0], H[1], H[2], H[3]}
    od = __builtin_amdgcn_mfma_f32_32x32x16_bf16(pa0, PK(l0, h0), od, 0, 0, 0);
    od = __builtin_amdgcn_mfma_f32_32x32x16_bf16(pa1, PK(l1, h1), od, 0, 0, 0);
    od = __builtin_amdgcn_mfma_f32_32x32x16_bf16(pa2, PK(l2, h2), od, 0, 0, 0);
    od = __builtin_amdgcn_mfma_f32_32x32x16_bf16(pa3, PK(l3, h3), od, 0, 0, 0);
#undef PK
}
__device__ __forceinline__ void pv_d0(f32x16* o, int vb, bf16x8 pa0, bf16x8 pa1, bf16x8 pa2, bf16x8 pa3) {
    pv_one<0>(o[0], vb, pa0, pa1, pa2, pa3); pv_one<1>(o[1], vb, pa0, pa1, pa2, pa3);
}
__device__ __forceinline__ void attn_unit(const bf16_t* __restrict__ Qb, const bf16_t* __restrict__ Kh, const bf16_t* __restrict__ Vh, bf16_t* __restrict__ Ob, int ldo, int seq, bool rope, int pos0, LAS char* lds, const int tid) {
    const int wid = __builtin_amdgcn_readfirstlane(tid >> 6), lane = tid & 63, r32 = lane & 31, hi = lane >> 5;
    LAS char* V_lds = lds; LAS char* K_lds = lds + OFF_K;
    LAS float* ws = (LAS float*)(lds + OFF_WS) + wid * 64; LAS float* li_l = ws; LAS float* al_l = ws + 32;
    float m_reg = -1e30f, l_reg = 0; f32x16 o[2] = {}; bf16x8 qr[6];
    const bf16_t* Qw = Qb + (size_t)(wid * QBLK + r32) * 768 + hi * 8;
#pragma unroll
    for (int d0 = 0; d0 < 6; ++d0) qr[d0] = *reinterpret_cast<const bf16x8*>(Qw + d0 * 16);
    if (rope) {
        const int t = pos0 + wid * QBLK + r32;
#pragma unroll
        for (int ax = 0; ax < 2; ++ax) {
            const float pos = (float)(ax == 0 ? (t >> 6) : (t & 63));
            u32x4 mine = *reinterpret_cast<u32x4*>(&qr[4 + ax]); u32x4 oth;
#pragma unroll
            for (int j = 0; j < 4; ++j) { auto rr = __builtin_amdgcn_permlane32_swap(mine[j], mine[j], false, false); oth[j] = hi ? rr[1] : rr[0]; }
            u32x4 res;
#pragma unroll
            for (int j = 0; j < 4; ++j) {
                float cs[2], sn[2];
#pragma unroll
                for (int q = 0; q < 2; ++q) { const float ang = pos * __powf(10000.0f, -(float)(2 * j + q) * 0.125f); sn[q] = __sinf(ang); cs[q] = __cosf(ang); }
                const float m0 = bf_lo(mine[j]), m1 = bf_hi(mine[j]), o0 = bf_lo(oth[j]), o1 = bf_hi(oth[j]);
                const float r0 = hi == 0 ? m0 * cs[0] - o0 * sn[0] : m0 * cs[0] + o0 * sn[0];
                const float r1 = hi == 0 ? m1 * cs[1] - o1 * sn[1] : m1 * cs[1] + o1 * sn[1];
                res[j] = cvt_pk_bf16(r0, r1);
            }
            qr[4 + ax] = *reinterpret_cast<bf16x8*>(&res);
        }
    }
    const int vk = tid >> 3, vc = (tid & 7) * 8, vst = v_st(vk, vc);
    const int kc0 = tid, kc1 = 512 + (tid & 255); const int kst0 = (kc0 / 12) * KROW + (kc0 % 12) * 16, kst1 = (kc1 / 12) * KROW + (kc1 % 12) * 16;
    const bool k2 = wid < 4;
    const int vb0 = (int)(uintptr_t)V_lds + v_rd_base(lane);
    struct { bf16x8 vs0, ks0, ks1; } sr_[2];
#define SLOAD(i, k0) do { sr_[i].vs0 = *reinterpret_cast<const bf16x8*>(Vh + (size_t)(k0) * DV + tid * 8); sr_[i].ks0 = *reinterpret_cast<const bf16x8*>(Kh + (size_t)(k0) * DQK + kc0 * 8); \
    if (k2) sr_[i].ks1 = *reinterpret_cast<const bf16x8*>(Kh + (size_t)(k0) * DQK + kc1 * 8); } while (0)
#define SWRITE(b, i) do { *(LAS bf16x8*)(V_lds + (b) * SHM_V + vst) = sr_[i].vs0; *(LAS bf16x8*)(K_lds + (b) * SHM_K + kst0) = sr_[i].ks0; \
    if (k2) *(LAS bf16x8*)(K_lds + (b) * SHM_K + kst1) = sr_[i].ks1; } while (0)
#define RESC(a) do { if (__any((a) < 1.f)) { if (hi == 0) al_l[r32] = (a); asm volatile("s_waitcnt lgkmcnt(0)" ::: "memory"); \
    _Pragma("unroll") for (int d = 0; d < 2; ++d) _Pragma("unroll") for (int r = 0; r < 16; ++r) o[d][r] *= al_l[crow(r, hi)]; } } while (0)
    f32x16 pA0, pA1, pB0, pB1; float mnA, mnB, alA, alB; bf16x8 pa0, pa1, pa2, pa3; const int NT = seq / KVBLK;
    constexpr int SE = 0, SO = 1;
    SLOAD(SE, 0); asm volatile("s_waitcnt vmcnt(0)" ::: "memory"); SWRITE(0, SE); __syncthreads();
    qkt(pA0, pA1, K_lds, qr, r32, hi); partialSM(pA0, pA1, m_reg, mnA, alA);
    SLOAD(SO, KVBLK); if (2 < NT) SLOAD(SE, 2 * KVBLK);
    SWRITE(1, SO); __syncthreads();
    for (int j = 1; j + 1 < NT; j += 2) {
        SBAR(); qkt(pB0, pB1, K_lds + SHM_K, qr, r32, hi);
        finishSM(pA0, pA1, alA, l_reg, pa0, pa1, pa2, pa3); SBAR();
        SLOAD(SO, (j + 2) * KVBLK); SBAR();
        pv_d0(o, vb0, pa0, pa1, pa2, pa3); partialSM(pB0, pB1, m_reg, mnB, alB);
        __syncthreads(); SWRITE(0, SE);
        RESC(alB); __syncthreads();
        SBAR(); qkt(pA0, pA1, K_lds, qr, r32, hi);
        finishSM(pB0, pB1, alB, l_reg, pa0, pa1, pa2, pa3); SBAR();
        if (j + 3 < NT) SLOAD(SE, (j + 3) * KVBLK); SBAR();
        pv_d0(o, vb0 + SHM_V, pa0, pa1, pa2, pa3); partialSM(pA0, pA1, m_reg, mnA, alA);
        __syncthreads(); SWRITE(1, SO);
        RESC(alA); __syncthreads();
    }
    SBAR(); qkt(pB0, pB1, K_lds + SHM_K, qr, r32, hi);
    finishSM(pA0, pA1, alA, l_reg, pa0, pa1, pa2, pa3); SBAR();
    pv_d0(o, vb0, pa0, pa1, pa2, pa3); partialSM(pB0, pB1, m_reg, mnB, alB);
    __syncthreads(); RESC(alB);
    finishSM(pB0, pB1, alB, l_reg, pa0, pa1, pa2, pa3); SBAR();
    pv_d0(o, vb0 + SHM_V, pa0, pa1, pa2, pa3);
    if (hi == 0) li_l[r32] = l_reg; asm volatile("s_waitcnt lgkmcnt(0)" ::: "memory");
    float rli[16];
#pragma unroll
    for (int r = 0; r < 16; ++r) rli[r] = __builtin_amdgcn_rcpf(li_l[crow(r, hi)]);
    { LAS bf16_t* stg = (LAS bf16_t*)(lds + OFF_OST) + wid * 2048;
#pragma unroll
      for (int r = 0; r < 16; ++r) { const int orow = crow(r, hi);
#pragma unroll
          for (int d0 = 0; d0 < 2; ++d0) stg[orow * 64 + d0 * 32 + r32] = (bf16_t)(cvt_pk_bf16(o[d0][r] * rli[r], 0.f) & 0xffffu); }
      asm volatile("s_waitcnt lgkmcnt(0)" ::: "memory");
      bf16_t* Ow = Ob + (size_t)(wid * QBLK) * ldo;
#pragma unroll
      for (int i = 0; i < 4; ++i) { const int row = i * 8 + (lane >> 3), ch = lane & 7; const u32x4 v = *(const LAS u32x4*)(stg + row * 64 + ch * 8); *(u32x4*)(Ow + (size_t)row * ldo + ch * 8) = v; } }
    asm volatile("s_waitcnt lgkmcnt(0)" ::: "memory"); __syncthreads();
#undef SLOAD
#undef SWRITE
#undef RESC
}
}


namespace att8 {
constexpr int KROW = 144, VROW = 80, SLOT_K = 64 * KROW, SLOT_V = 64 * VROW, NSLOT = 3;
constexpr int OFF_V = NSLOT * SLOT_K, OFF_WS = OFF_V + NSLOT * SLOT_V, OFF_OST = OFF_WS + 8 * 512, LDS_ATT = OFF_OST + 8 * 8192;
static_assert(LDS_ATT <= LDS_WORK, "attention LDS");
constexpr float C2 = 0.10206207261596575f * 1.4426950408889634f;
constexpr float THR = 6.f, PSH = 2.f;
__device__ __forceinline__ int crow(int r, int hi) { return (r & 3) + 8 * (r >> 2) + 4 * hi; }
#define MFMA8(a, b, c) __builtin_amdgcn_mfma_scale_f32_32x32x64_f8f6f4(a, b, c, 0, 0, 0, 0, 0, 0)
__device__ __forceinline__ float max3f(float a, float b, float c) { float r; asm("v_max3_f32 %0, %1, %2, %3" : "=v"(r) : "v"(a), "v"(b), "v"(c)); return r; }
__device__ __forceinline__ i32x8 ld32(const LAS char* p) { const u32x4 a = *(const LAS u32x4*)p, b = *(const LAS u32x4*)(p + 16); return (i32x8){(int)a.x, (int)a.y, (int)a.z, (int)a.w, (int)b.x, (int)b.y, (int)b.z, (int)b.w}; }
__device__ __forceinline__ i32x8 softmax_blk(f32x16& p0, f32x16& p1, float& m_reg, float& l_reg, f32x16 (&o)[2], LAS float* al_l, int r32, int hi) {
    float a = fmaxf(fmaxf(p0[0], p0[1]), p1[0]), b = fmaxf(fmaxf(p0[2], p0[3]), p1[1]); a = fmaxf(fmaxf(a, p1[2]), p1[3]);
#pragma unroll
    for (int r = 4; r < 16; r += 4) { a = fmaxf(fmaxf(a, p0[r]), p0[r + 1]); b = fmaxf(fmaxf(b, p0[r + 2]), p0[r + 3]); a = fmaxf(fmaxf(a, p1[r]), p1[r + 1]); b = fmaxf(fmaxf(b, p1[r + 2]), p1[r + 3]); }
    float pmax = fmaxf(a, b);
    { auto rr = __builtin_amdgcn_permlane32_swap(__float_as_uint(pmax), __float_as_uint(pmax), false, false); pmax = fmaxf(__uint_as_float(rr[0]), __uint_as_float(rr[1])); }
    if (__builtin_expect(!__all(pmax - m_reg <= THR), 0)) {
        const float mn = fmaxf(m_reg, pmax), alpha = __builtin_amdgcn_exp2f(m_reg - mn); m_reg = mn; l_reg *= alpha;
        if (hi == 0) al_l[r32] = alpha; asm volatile("s_waitcnt lgkmcnt(0)" ::: "memory");
        int hi_ = hi; asm volatile("" : "+v"(hi_));
#pragma unroll
        for (int d = 0; d < 2; ++d)
#pragma unroll
            for (int r = 0; r < 16; ++r) o[d][r] *= al_l[crow(r, hi_)];
    }
    const float ms = m_reg - PSH;
#pragma unroll
    for (int r = 0; r < 16; ++r) { p0[r] = __builtin_amdgcn_exp2f(p0[r] - ms); p1[r] = __builtin_amdgcn_exp2f(p1[r] - ms); }
    float ps = 0.f;
#pragma unroll
    for (int r = 0; r < 16; ++r) ps += p0[r];
#pragma unroll
    for (int r = 0; r < 16; ++r) ps += p1[r];
    { auto rr = __builtin_amdgcn_permlane32_swap(__float_as_uint(ps), __float_as_uint(ps), false, false); ps = __uint_as_float(rr[0]) + __uint_as_float(rr[1]); }
    l_reg += ps;
    i32x8 pa;
#pragma unroll
    for (int w = 0; w < 4; ++w) { pa[w] = (int)pk4_fp8(p0[4 * w], p0[4 * w + 1], p0[4 * w + 2], p0[4 * w + 3]); pa[4 + w] = (int)pk4_fp8(p1[4 * w], p1[4 * w + 1], p1[4 * w + 2], p1[4 * w + 3]); }
    return pa;
}
__device__ __forceinline__ void load_q(i32x8 (&q)[2], const char* __restrict__ qbase, unsigned qoff, int hi, bool rope, int t) {
    { const u32x4* p = (const u32x4*)(qbase + (qoff + (unsigned)hi * 64u)); float f[32];
#pragma unroll
      for (int c = 0; c < 4; ++c) { const u32x4 v = p[c];
#pragma unroll
          for (int j = 0; j < 4; ++j) { f[8 * c + 2 * j] = bf_lo(v[j]) * C2; f[8 * c + 2 * j + 1] = bf_hi(v[j]) * C2; } }
#pragma unroll
      for (int w = 0; w < 8; ++w) q[0][w] = (int)pk4_fp8(f[4 * w], f[4 * w + 1], f[4 * w + 2], f[4 * w + 3]); }
    { const u32x4* p = (const u32x4*)(qbase + (qoff + 128u)); float f[32];
#pragma unroll
      for (int c = 0; c < 4; ++c) { const u32x4 v = p[c];
#pragma unroll
          for (int j = 0; j < 4; ++j) { f[8 * c + 2 * j] = bf_lo(v[j]) * C2; f[8 * c + 2 * j + 1] = bf_hi(v[j]) * C2; } }
      if (rope) {
#pragma unroll
          for (int ax = 0; ax < 2; ++ax) { const float pos = (float)(ax == 0 ? (t >> 6) : (t & 63));
#pragma unroll
              for (int j = 0; j < 8; ++j) { const float ang = pos * __powf(10000.0f, -(float)j * 0.125f); const float sn = __sinf(ang), cs = __cosf(ang);
                  const float x1 = f[16 * ax + j], x2 = f[16 * ax + 8 + j]; f[16 * ax + j] = x1 * cs - x2 * sn; f[16 * ax + 8 + j] = x2 * cs + x1 * sn; } } }
#pragma unroll
      for (int w = 0; w < 8; ++w) q[1][w] = hi ? 0 : (int)pk4_fp8(f[4 * w], f[4 * w + 1], f[4 * w + 2], f[4 * w + 3]); }
}
__device__ __forceinline__ void attn_unit(const bf16_t* __restrict__ Qb, const unsigned char* __restrict__ K8t, const unsigned char* __restrict__ VTt, bf16_t* __restrict__ Ob, int ldo, int ntile, bool rope, int pos0, int nvalid, LAS char* lds, const int tid) {
    const int wid = __builtin_amdgcn_readfirstlane(tid >> 6), lane = tid & 63, r32 = lane & 31, hi = lane >> 5;
    LAS float* wsf = (LAS float*)(lds + OFF_WS) + wid * 128;
    i32x8 qX[2], qY[2];
    { const int rx = wid * 64 + r32, ry = rx + 32; const int cx = rx < nvalid ? rx : rx % nvalid, cy = ry < nvalid ? ry : ry % nvalid;
      load_q(qX, (const char*)Qb, (unsigned)cx * 1536u, hi, rope, pos0 + rx); load_q(qY, (const char*)Qb, (unsigned)cy * 1536u, hi, rope, pos0 + ry); }
    float mX = -1e30f, mY = -1e30f, lX = 0.f, lY = 0.f; f32x16 oX[2] = {}, oY[2] = {};
    const int kst = (tid >> 3) * KROW + (tid & 7) * 16, vst = OFF_V + (tid >> 2) * VROW + (tid & 3) * 16; const bool vth = wid < 4;
    const int kfo = r32 * KROW + hi * 32, vfo = OFF_V + r32 * VROW + hi * 32;
    unsigned zz_ = 0u; asm volatile("" : "+v"(zz_));
    u32x4 sk, sv = {zz_, zz_, zz_, zz_};
    const unsigned toff = (unsigned)tid * 16u;
#define SLOAD8(t) do { sk = *(const u32x4*)(K8t + (size_t)(t) * 8192 + toff); if (vth) sv = *(const u32x4*)(VTt + (size_t)(t) * 4096 + toff); } while (0)
#define SWRITE8(s) do { *(LAS u32x4*)(lds + (s) * SLOT_K + kst) = sk; if (vth) *(LAS u32x4*)(lds + (s) * SLOT_V + vst) = sv; } while (0)
    SLOAD8(0); SWRITE8(0); if (1 < ntile) SLOAD8(1);
    int sc = 0, sn = 1;
    for (int t = 0; t < ntile; ++t) {
        __syncthreads();
        if (t + 1 < ntile) SWRITE8(sn);
        if (t + 2 < ntile) SLOAD8(t + 2);
        const LAS char* kb = lds + sc * SLOT_K + kfo; const LAS char* vb = lds + sc * SLOT_V + vfo;
        f32x16 pX0, pX1, pY0, pY1;
        { const i32x8 k0 = ld32(kb), k1 = ld32(kb + 32 * KROW); const f32x16 z = {};
          pX0 = MFMA8(k0, qX[0], z); pX1 = MFMA8(k1, qX[0], z); pY0 = MFMA8(k0, qY[0], z); pY1 = MFMA8(k1, qY[0], z); }
        { const i32x8 k0 = ld32(kb + 64), k1 = ld32(kb + 32 * KROW + 64);
          pX0 = MFMA8(k0, qX[1], pX0); pX1 = MFMA8(k1, qX[1], pX1); pY0 = MFMA8(k0, qY[1], pY0); pY1 = MFMA8(k1, qY[1], pY1); }
        const i32x8 paX = softmax_blk(pX0, pX1, mX, lX, oX, wsf, r32, hi);
        { const i32x8 v0 = ld32(vb), v1 = ld32(vb + 32 * VROW);
          oX[0] = MFMA8(paX, v0, oX[0]); oX[1] = MFMA8(paX, v1, oX[1]); }
        const i32x8 paY = softmax_blk(pY0, pY1, mY, lY, oY, wsf + 32, r32, hi);
        { const i32x8 v0 = ld32(vb), v1 = ld32(vb + 32 * VROW);
          oY[0] = MFMA8(paY, v0, oY[0]); oY[1] = MFMA8(paY, v1, oY[1]); }
        sc = sn; sn = (sn == NSLOT - 1) ? 0 : sn + 1;
    }
#undef SLOAD8
#undef SWRITE8
    if (hi == 0) { wsf[64 + r32] = lX; wsf[96 + r32] = lY; } asm volatile("s_waitcnt lgkmcnt(0)" ::: "memory");
    LAS bf16_t* stg = (LAS bf16_t*)(lds + OFF_OST) + wid * 4096;
#pragma unroll
    for (int r = 0; r < 16; ++r) { const int orow = crow(r, hi); const float rx = __builtin_amdgcn_rcpf(wsf[64 + orow]), ry = __builtin_amdgcn_rcpf(wsf[96 + orow]);
#pragma unroll
        for (int d0 = 0; d0 < 2; ++d0) { stg[orow * 64 + d0 * 32 + r32] = (bf16_t)(cvt_pk_bf16(oX[d0][r] * rx, 0.f) & 0xffffu); stg[(32 + orow) * 64 + d0 * 32 + r32] = (bf16_t)(cvt_pk_bf16(oY[d0][r] * ry, 0.f) & 0xffffu); } }
    asm volatile("s_waitcnt lgkmcnt(0)" ::: "memory");
#pragma unroll
    for (int i = 0; i < 8; ++i) { const int row = i * 8 + (lane >> 3), ch = lane & 7; const u32x4 v = *(const LAS u32x4*)(stg + row * 64 + ch * 8);
        if (wid * 64 + row < nvalid) *(u32x4*)(Ob + (size_t)(wid * 64 + row) * ldo + ch * 8) = v; }
    asm volatile("s_waitcnt lgkmcnt(0)" ::: "memory"); __syncthreads();
}
#undef MFMA8

__device__ __forceinline__ void sm_max(f32x16& p0, f32x16& p1, float& m_reg, float& l_reg, f32x16 (&o)[2], i32x8& qpad, LAS float* al_l, int r32, int hi, bool first) {
    float a = fmaxf(fmaxf(p0[0], p0[1]), p1[0]), b = fmaxf(fmaxf(p0[2], p0[3]), p1[1]); a = fmaxf(fmaxf(a, p1[2]), p1[3]);
#pragma unroll
    for (int r = 4; r < 16; r += 4) { a = fmaxf(fmaxf(a, p0[r]), p0[r + 1]); b = fmaxf(fmaxf(b, p0[r + 2]), p0[r + 3]); a = fmaxf(fmaxf(a, p1[r]), p1[r + 1]); b = fmaxf(fmaxf(b, p1[r + 2]), p1[r + 3]); }
    float pmax = fmaxf(a, b);
    { auto rr = __builtin_amdgcn_permlane32_swap(__float_as_uint(pmax), __float_as_uint(pmax), false, false); pmax = fmaxf(__uint_as_float(rr[0]), __uint_as_float(rr[1])); }
    if (__builtin_expect(first || !__all(pmax <= THR + PSH), 0)) {
        const float tm = ceilf(pmax + (m_reg - PSH)); float x = (first ? tm : fmaxf(m_reg, tm)) - PSH;
        const unsigned qb_ = __builtin_amdgcn_cvt_pk_fp8_f32(-x, 0.f, 0u, false) & 0xffu; x = -__builtin_amdgcn_cvt_f32_fp8((int)qb_, 0);
        const float mn = x + PSH, d = mn - m_reg, alpha = __builtin_amdgcn_exp2f(-d); m_reg = mn; l_reg *= alpha;
        if (hi == 0) al_l[r32] = alpha; asm volatile("s_waitcnt lgkmcnt(0)" ::: "memory");
        int hi_ = hi; asm volatile("" : "+v"(hi_));
#pragma unroll
        for (int dd = 0; dd < 2; ++dd)
#pragma unroll
            for (int r = 0; r < 16; ++r) o[dd][r] *= al_l[crow(r, hi_)];
#pragma unroll
        for (int r = 0; r < 16; ++r) { p0[r] -= d; p1[r] -= d; }
        if (hi_) qpad[0] = (int)qb_;
    }
}
__device__ __forceinline__ i32x8 sm_exp(f32x16& p0, f32x16& p1, const float m_reg, float& l_reg) {
    const float ms = m_reg - PSH;
#pragma unroll
    for (int r = 0; r < 16; ++r) { p0[r] = __builtin_amdgcn_exp2f(p0[r] - ms); p1[r] = __builtin_amdgcn_exp2f(p1[r] - ms); }
    float ps = 0.f;
#pragma unroll
    for (int r = 0; r < 16; ++r) ps += p0[r];
#pragma unroll
    for (int r = 0; r < 16; ++r) ps += p1[r];
    { auto rr = __builtin_amdgcn_permlane32_swap(__float_as_uint(ps), __float_as_uint(ps), false, false); ps = __uint_as_float(rr[0]) + __uint_as_float(rr[1]); }
    l_reg += ps;
    i32x8 pa;
#pragma unroll
    for (int w = 0; w < 4; ++w) { pa[w] = (int)pk4_fp8(p0[4 * w], p0[4 * w + 1], p0[4 * w + 2], p0[4 * w + 3]); pa[4 + w] = (int)pk4_fp8(p1[4 * w], p1[4 * w + 1], p1[4 * w + 2], p1[4 * w + 3]); }
    return pa;
}
#define MFMA8(a, b, c) __builtin_amdgcn_mfma_scale_f32_32x32x64_f8f6f4(a, b, c, 0, 0, 0, 0, 0, 0)
#ifndef ATT_FENCE
#define ATT_FENCE 1
#endif
#if ATT_FENCE
#define SB0() __builtin_amdgcn_sched_barrier(0)
#else
#define SB0() do {} while (0)
#endif
#define ATT_EXP(x) (VAR == 1 ? (x) * 1.0009765625f : __builtin_amdgcn_exp2f(x))
#define SM_CHUNK(P0, P1, PA, PS, c) do { if constexpr (VAR == 3) { PA[c] = __float_as_int(P0[4 * (c)]); PA[4 + (c)] = __float_as_int(P1[4 * (c)]); } else { \
    _Pragma("unroll") for (int r_ = 4 * (c); r_ < 4 * (c) + 4; ++r_) { P0[r_] = ATT_EXP(P0[r_]); P1[r_] = ATT_EXP(P1[r_]); } \
    _Pragma("unroll") for (int r_ = 4 * (c); r_ < 4 * (c) + 4; ++r_) { PS += P0[r_]; PS += P1[r_]; } \
    PA[c] = (int)pk4_fp8(P0[4 * (c)], P0[4 * (c) + 1], P0[4 * (c) + 2], P0[4 * (c) + 3]); PA[4 + (c)] = (int)pk4_fp8(P1[4 * (c)], P1[4 * (c) + 1], P1[4 * (c) + 2], P1[4 * (c) + 3]); } } while (0)
__device__ __forceinline__ void sm_rescale(f32x16& p0, f32x16& p1, i32x8& pa, float& s_row, float& m_reg, float& l_reg, f32x16 (&o)[2], i32x8& qpad, LAS float* al_l, int r32, int hi, bool first) {
    float d = ceilf(__log2f(fmaxf(s_row, 1e-30f))) - 4.f; d = fminf(fmaxf(d, first ? -100.f : 0.f), 100.f);
    const float xo = m_reg - PSH; const float xn = xo + d;
    unsigned qb_ = __builtin_amdgcn_cvt_pk_fp8_f32(-xn, 0.f, 0u, false) & 0xffu; float xq = -__builtin_amdgcn_cvt_f32_fp8((int)qb_, 0);
    if (xq < xn) { const float st = __builtin_amdgcn_exp2f(floorf(__log2f(fabsf(xq) + 1e-9f)) - 3.f); qb_ = __builtin_amdgcn_cvt_pk_fp8_f32(-(xq + st), 0.f, 0u, false) & 0xffu; xq = -__builtin_amdgcn_cvt_f32_fp8((int)qb_, 0); }
    const float dd = xq - xo, f = __builtin_amdgcn_exp2f(-dd);
    m_reg = xq + PSH; l_reg *= f; s_row *= f;
    if (hi == 0) al_l[r32] = f; asm volatile("s_waitcnt lgkmcnt(0)" ::: "memory");
    int hi_ = hi; asm volatile("" : "+v"(hi_));
#pragma unroll
    for (int dq = 0; dq < 2; ++dq)
#pragma unroll
        for (int r = 0; r < 16; ++r) o[dq][r] *= al_l[crow(r, hi_)];
#pragma unroll
    for (int r = 0; r < 16; ++r) { p0[r] *= f; p1[r] *= f; }
#pragma unroll
    for (int w = 0; w < 4; ++w) { pa[w] = (int)pk4_fp8(p0[4 * w], p0[4 * w + 1], p0[4 * w + 2], p0[4 * w + 3]); pa[4 + w] = (int)pk4_fp8(p1[4 * w], p1[4 * w + 1], p1[4 * w + 2], p1[4 * w + 3]); }
    if (hi_) qpad[0] = (int)qb_;
}
#define SM_FIN(PS, L, P0, P1, PA, M, O, QP, AL, FIRST) do { float s_ = PS; { auto rr_ = __builtin_amdgcn_permlane32_swap(__float_as_uint(s_), __float_as_uint(s_), false, false); s_ = __uint_as_float(rr_[0]) + __uint_as_float(rr_[1]); } \
    if (__builtin_expect((FIRST) || !__all(s_ <= 256.f), 0)) sm_rescale(P0, P1, PA, s_, M, L, O, QP, AL, r32, hi, FIRST); \
    L += s_; } while (0)
template <int VAR> __device__ __forceinline__ f32x16 mfv(const i32x8& a, const i32x8& b, f32x16 c) {
    if constexpr (VAR == 2) { asm volatile("" : "+v"(c)); return c; } else return __builtin_amdgcn_mfma_scale_f32_32x32x64_f8f6f4(a, b, c, 0, 0, 0, 0, 0, 0);
}
template <int VAR = 0>
__device__ __forceinline__ void attn_unit_p(const bf16_t* __restrict__ Qb, const unsigned char* __restrict__ K8t, const unsigned char* __restrict__ VTt, bf16_t* __restrict__ Ob, int ldo, int ntile, bool rope, int pos0, int nvalid, LAS char* lds, const int tid) {
#define MF(a, b, c) mfv<VAR>(a, b, c)
#define MFZ(a, b, cold) (VAR == 2 ? mfv<VAR>(a, b, cold) : mfv<VAR>(a, b, z))

    const int wid = __builtin_amdgcn_readfirstlane(tid >> 6), lane = tid & 63, r32 = lane & 31, hi = lane >> 5;
    LAS float* wsf = (LAS float*)(lds + OFF_WS) + wid * 128;
    i32x8 qX[2], qY[2];
    { const int rx = wid * 64 + r32, ry = rx + 32; const int cx = rx < nvalid ? rx : rx % nvalid, cy = ry < nvalid ? ry : ry % nvalid;
      load_q(qX, (const char*)Qb, (unsigned)cx * 1536u, hi, rope, pos0 + rx); load_q(qY, (const char*)Qb, (unsigned)cy * 1536u, hi, rope, pos0 + ry); }
    if (wid >= 4) __builtin_amdgcn_s_setprio(1);
    float mX = 0.f, mY = 0.f, lX = 0.f, lY = 0.f; f32x16 oX[2] = {}, oY[2] = {};
    { const unsigned qb_ = __builtin_amdgcn_cvt_pk_fp8_f32(PSH, 0.f, 0u, false) & 0xffu; if (hi) { qX[1][0] = (int)qb_; qY[1][0] = (int)qb_; } }
    const int kst = (tid >> 3) * KROW + (tid & 7) * 16, vst = OFF_V + (tid >> 2) * VROW + (tid & 3) * 16; const bool vth = wid < 4;
    const int kfo = r32 * KROW + hi * 32, vfo = OFF_V + r32 * VROW + hi * 32;
    const unsigned toff = (unsigned)tid * 16u;
    unsigned zz_ = 0u; asm volatile("" : "+v"(zz_));
    u32x4 sk, sv = {zz_, zz_, zz_, zz_};
#define LDK(t) (sk = *(const u32x4*)(K8t + (size_t)(t) * 8192 + toff))
#define LDV(t) do { if (vth) sv = *(const u32x4*)(VTt + (size_t)(t) * 4096 + toff); } while (0)
#define WRK(s) (*(LAS u32x4*)(lds + (s) * SLOT_K + kst) = sk)
#define WRV(s) do { if (vth) *(LAS u32x4*)(lds + (s) * SLOT_V + vst) = sv; } while (0)
    LDK(0); LDV(0); WRK(0); WRV(0); if (1 < ntile) { LDK(1); WRK(1); } if (2 < ntile) LDK(2); if (1 < ntile) LDV(1);
    if (tid < 320) *(LAS u32x4*)(lds + OFF_V + 2 * SLOT_V + tid * 16) = (u32x4){zz_, zz_, zz_, zz_};
    __syncthreads();
    f32x16 pX0, pX1, pY0, pY1; i32x8 paX, paY = {};
    i32x8 kc0, kc1;
    { const LAS char* kb = lds + kfo; const f32x16 z = {};
      kc0 = ld32(kb); kc1 = ld32(kb + 32 * KROW); pX0 = MFZ(kc0, qX[0], pX0); pX1 = MFZ(kc1, qX[0], pX1);
      { const i32x8 k0 = ld32(kb + 64), k1 = ld32(kb + 32 * KROW + 64); pX0 = MF(k0, qX[1], pX0); pX1 = MF(k1, qX[1], pX1); } }
    int s0 = 0, s1 = 1, s2 = 2;
    for (int t = 0; t < ntile; ++t) {
        if constexpr (VAR != 4) __syncthreads();
        i32x8 w0, w1;
        {   const LAS char* vb = lds + s2 * SLOT_V + vfo; const LAS char* kb = lds + s0 * SLOT_K + kfo; const LAS char* vb2 = lds + s0 * SLOT_V + vfo; const f32x16 z = {};
            float ps = 0.f; SB0();
            pY0 = MFZ(kc0, qY[0], pY0); const i32x8 k2 = ld32(kb + 64);
            if (t + 2 < ntile) WRK(s2); if (t + 1 < ntile) WRV(s1);
            if (t + 3 < ntile) LDK(t + 3); if (t + 2 < ntile) LDV(t + 2);
            SM_CHUNK(pX0, pX1, paX, ps, 0); SB0();
            pY1 = MFZ(kc1, qY[0], pY1); const i32x8 k3 = ld32(kb + 32 * KROW + 64);
            SM_CHUNK(pX0, pX1, paX, ps, 1); SB0();
            pY0 = MF(k2, qY[1], pY0); const i32x8 v0 = ld32(vb);
            SM_CHUNK(pX0, pX1, paX, ps, 2); SB0();
            pY1 = MF(k3, qY[1], pY1); const i32x8 v1 = ld32(vb + 32 * VROW);
            SM_CHUNK(pX0, pX1, paX, ps, 3); SB0();
            oY[0] = MF(paY, v0, oY[0]); w0 = ld32(vb2); oY[1] = MF(paY, v1, oY[1]); w1 = ld32(vb2 + 32 * VROW);
            SM_FIN(ps, lX, pX0, pX1, paX, mX, oX, qX[1], wsf, t == 0); SB0();
        }
        {   const LAS char* kb = lds + s1 * SLOT_K + kfo; const f32x16 z = {};
            float ps = 0.f; SB0();
            oX[0] = MF(paX, w0, oX[0]); kc0 = ld32(kb);
            SM_CHUNK(pY0, pY1, paY, ps, 0); SB0();
            oX[1] = MF(paX, w1, oX[1]); kc1 = ld32(kb + 32 * KROW);
            SM_CHUNK(pY0, pY1, paY, ps, 1); SB0();
            pX0 = MFZ(kc0, qX[0], pX0); const i32x8 k2 = ld32(kb + 64);
            SM_CHUNK(pY0, pY1, paY, ps, 2); SB0();
            pX1 = MFZ(kc1, qX[0], pX1); const i32x8 k3 = ld32(kb + 32 * KROW + 64);
            SM_CHUNK(pY0, pY1, paY, ps, 3); SB0();
            pX0 = MF(k2, qX[1], pX0); pX1 = MF(k3, qX[1], pX1);
            SM_FIN(ps, lY, pY0, pY1, paY, mY, oY, qY[1], wsf + 32, t == 0); SB0();
        }
        { const int ts = s0; s0 = s1; s1 = s2; s2 = ts; }
    }
    { const LAS char* vb = lds + s2 * SLOT_V + vfo; const i32x8 v0 = ld32(vb), v1 = ld32(vb + 32 * VROW); oY[0] = MF(paY, v0, oY[0]); oY[1] = MF(paY, v1, oY[1]); }
#undef LDK
#undef LDV
#undef WRK
#undef WRV
    if (hi == 0) { wsf[64 + r32] = lX; wsf[96 + r32] = lY; } asm volatile("s_waitcnt lgkmcnt(0)" ::: "memory");
    LAS bf16_t* stg = (LAS bf16_t*)(lds + OFF_OST) + wid * 4096;
#pragma unroll
    for (int r = 0; r < 16; ++r) { const int orow = crow(r, hi); const float rx = __builtin_amdgcn_rcpf(wsf[64 + orow]), ry = __builtin_amdgcn_rcpf(wsf[96 + orow]);
#pragma unroll
        for (int d0 = 0; d0 < 2; ++d0) { stg[orow * 64 + d0 * 32 + r32] = (bf16_t)(cvt_pk_bf16(oX[d0][r] * rx, 0.f) & 0xffffu); stg[(32 + orow) * 64 + d0 * 32 + r32] = (bf16_t)(cvt_pk_bf16(oY[d0][r] * ry, 0.f) & 0xffffu); } }
    asm volatile("s_waitcnt lgkmcnt(0)" ::: "memory");
#pragma unroll
    for (int i = 0; i < 8; ++i) { const int row = i * 8 + (lane >> 3), ch = lane & 7; const u32x4 v = *(const LAS u32x4*)(stg + row * 64 + ch * 8);
        if (wid * 64 + row < nvalid) *(u32x4*)((char*)Ob + (unsigned)(((wid * 64 + row) * ldo + ch * 8) * 2)) = v; }
    asm volatile("s_waitcnt lgkmcnt(0)" ::: "memory"); __builtin_amdgcn_s_setprio(0); __syncthreads();
}
#undef SB0
#undef MF
#undef MFZ
#undef ATT_EXP
#undef SM_CHUNK
#undef SM_FIN
#undef MFMA8
}

namespace dft {
__device__ __forceinline__ int v_st8(int k, int c) { const int kk = (k & ~0xC) | ((k & 4) << 1) | ((k & 8) >> 1); return ((kk >> 3) * 8 + (c >> 5)) * 512 + ((kk & 7) * 32 + (c & 31)) * 2; }
template <int MODE, int K>
__device__ __forceinline__ void unit(LAS char* lds, const bf16_t* __restrict__ F, const char* __restrict__ in, size_t in_stride, char* __restrict__ dst, int p0, int p1, const int tid) {
    const int wid = __builtin_amdgcn_readfirstlane(tid >> 6), lane = tid & 63, r32 = lane & 31, hi = lane >> 5;
    { constexpr int NJ = K / 16; bf16x8 v[NJ];
#pragma unroll
      for (int j = 0; j < NJ; ++j) v[j] = *reinterpret_cast<const bf16x8*>(in + (size_t)((tid >> 5) + 16 * j) * in_stride + (tid & 31) * 16);
#pragma unroll
      for (int j = 0; j < NJ; ++j) *(LAS bf16x8*)(lds + v_st8((tid >> 5) + 16 * j, (tid & 31) * 8)) = v[j];
    }
    __syncthreads();
    f32x16 acc[8];
#pragma unroll
    for (int d = 0; d < 8; ++d) acc[d] = f32x16{};
    const int vb0 = (int)(uintptr_t)lds + att::v_rd_base(lane);
    const bf16_t* Fw = F + (size_t)(wid * 32 + r32) * K + hi * 8;
#pragma unroll 1
    for (int ks = 0; ks < K / 16; ++ks) {
        const bf16x8 a = *reinterpret_cast<const bf16x8*>(Fw + ks * 16);
        const int vb = vb0 + ks * 8192;
        {   s16x4 lo[4], hh[4];
            lo[0] = att::tr_read<0 * 512>(vb); hh[0] = att::tr_read<0 * 512 + 4096>(vb); lo[1] = att::tr_read<1 * 512>(vb); hh[1] = att::tr_read<1 * 512 + 4096>(vb);
            lo[2] = att::tr_read<2 * 512>(vb); hh[2] = att::tr_read<2 * 512 + 4096>(vb); lo[3] = att::tr_read<3 * 512>(vb); hh[3] = att::tr_read<3 * 512 + 4096>(vb);
            asm volatile("s_waitcnt lgkmcnt(0)" ::: "memory"); __builtin_amdgcn_sched_barrier(0);
#pragma unroll
            for (int d = 0; d < 4; ++d) { const bf16x8 b = (bf16x8){lo[d][0], lo[d][1], lo[d][2], lo[d][3], hh[d][0], hh[d][1], hh[d][2], hh[d][3]};
                acc[d] = __builtin_amdgcn_mfma_f32_32x32x16_bf16(a, b, acc[d], 0, 0, 0); } }
        {   s16x4 lo[4], hh[4];
            lo[0] = att::tr_read<4 * 512>(vb); hh[0] = att::tr_read<4 * 512 + 4096>(vb); lo[1] = att::tr_read<5 * 512>(vb); hh[1] = att::tr_read<5 * 512 + 4096>(vb);
            lo[2] = att::tr_read<6 * 512>(vb); hh[2] = att::tr_read<6 * 512 + 4096>(vb); lo[3] = att::tr_read<7 * 512>(vb); hh[3] = att::tr_read<7 * 512 + 4096>(vb);
            asm volatile("s_waitcnt lgkmcnt(0)" ::: "memory"); __builtin_amdgcn_sched_barrier(0);
#pragma unroll
            for (int d = 0; d < 4; ++d) { const bf16x8 b = (bf16x8){lo[d][0], lo[d][1], lo[d][2], lo[d][3], hh[d][0], hh[d][1], hh[d][2], hh[d][3]};
                acc[4 + d] = __builtin_amdgcn_mfma_f32_32x32x16_bf16(a, b, acc[4 + d], 0, 0, 0); } }
    }
    if (MODE == 0) {
#pragma unroll
        for (int g = 0; g < 2; ++g)
#pragma unroll
            for (int i = 0; i < 4; ++i) { const int k1 = 16 * wid + 8 * g + 4 * hi + i; float sn, cs; sincospif((float)(k1 * p1) * (1.0f / 8192.0f), &sn, &cs);
#pragma unroll
                for (int d = 0; d < 8; ++d) { const float yr = acc[d][8 * g + i], yi = acc[d][8 * g + 4 + i]; acc[d][8 * g + i] = yr * cs + yi * sn; acc[d][8 * g + 4 + i] = yi * cs - yr * sn; } }
    }
    __syncthreads();
    LAS bf16_t* stg = (LAS bf16_t*)lds + wid * 8192;
#pragma unroll
    for (int r = 0; r < 16; ++r) { const int orow = att::crow(r, hi);
#pragma unroll
        for (int d = 0; d < 8; ++d) stg[orow * 256 + d * 32 + r32] = (bf16_t)(cvt_pk_bf16(acc[d][r], 0.f) & 0xffffu); }
    asm volatile("s_waitcnt lgkmcnt(0)" ::: "memory");
#pragma unroll
    for (int it = 0; it < 16; ++it) { const int id = it * 64 + lane, rho = id >> 5, ch = id & 31; const u32x4 v = *(const LAS u32x4*)(stg + rho * 256 + ch * 8);
        size_t off;
        if (MODE == 0) { const int part = (rho >> 3) & 1, k1 = 16 * wid + (((rho >> 4) << 3) | (rho & 7)); off = ((((size_t)p0 * 128 + k1) * 128 + p1) * 2 + part) * 512; }
        else if (MODE == 1) { const int m = wid * 32 + rho, zp = m >> 7, k2 = m & 127; off = ((size_t)(p0 * SEQ + p1 + 128 * k2) * NINP + 256 + zp * 256) * 2; }
        else { const int m = wid * 32 + rho; off = ((size_t)(TL + p0 * CTXL + m) * NINP + 256 + p1 * 256) * 2; }
        *(u32x4*)(dst + off + ch * 16) = v; }
    asm volatile("s_waitcnt lgkmcnt(0)" ::: "memory"); __syncthreads();
}
}


#ifndef SELFCHECK
#define SELFCHECK 0
#endif
#ifndef SELFCHECK_REPORT
#define SELFCHECK_REPORT 1
#endif
#if SELFCHECK
constexpr int CW_CHK = 64;
__device__ __forceinline__ float fp8q(float x) { const unsigned w = __builtin_amdgcn_cvt_pk_fp8_f32(x, 0.f, 0u, false); return __builtin_amdgcn_cvt_f32_fp8((int)w, 0); }
__device__ __forceinline__ float bf2f(bf16_t v) { return __uint_as_float(((unsigned)v) << 16); }
__device__ __forceinline__ float chk_invfreq(int j) { return j == 0 ? 1.0f : j == 1 ? 0.316227766f : j == 2 ? 0.1f : j == 3 ? 0.0316227766f : j == 4 ? 0.01f : j == 5 ? 0.00316227766f : j == 6 ? 0.001f : 0.000316227766f; }
__device__ __forceinline__ void chk_sincos(float a, float& s, float& c) { const float k = rintf(a * 0.15915494309189535f); float r = fmaf(-k, 6.28125f, a); r = fmaf(-k, 1.9353071795864769e-3f, r); s = __sinf(r); c = __cosf(r); }
__device__ __forceinline__ void selfcheck_attn(int l, const bf16_t* Q, const unsigned char* K8, const bf16_t* Vb, const unsigned char* VT8, const bf16_t* YA, const bf16_t* Ub, const bf16_t* WuqT, const bf16_t* WukvT, unsigned* flag, LAS float* sm, int wave_g, int lane) {
    if (wave_g < 32) {
        const int i = wave_g, b = i & 1, h = (i >> 1) & 7, t = (i * 521 + 37 + 4099 * (i >> 4)) & (SEQ - 1); const int row = b * SEQ + t;
        LAS float* q = sm;
        for (int d = lane; d < 96; d += 64) q[d] = bf2f(Q[(size_t)row * 768 + h * 96 + d]);
        __builtin_amdgcn_s_waitcnt(0);
        float nv[2] = {0.f, 0.f};
        if (lane < 16) { const int ax = lane >> 3, j = lane & 7; const float pos = (float)(ax == 0 ? (t >> 6) : (t & 63)); const float ang = pos * chk_invfreq(j);
            float cs, sn; chk_sincos(ang, sn, cs); const float x1 = q[64 + 16 * ax + j], x2 = q[64 + 16 * ax + 8 + j]; nv[0] = x1 * cs - x2 * sn; nv[1] = x2 * cs + x1 * sn; }
        __builtin_amdgcn_s_waitcnt(0);
        if (lane < 16) { const int ax = lane >> 3, j = lane & 7; q[64 + 16 * ax + j] = nv[0]; q[64 + 16 * ax + 8 + j] = nv[1]; }
        __builtin_amdgcn_s_waitcnt(0);
        for (int d = lane; d < 96; d += 64) q[d] = fp8q(q[d] * (0.10206207261596575f * 1.4426950408889634f));
        __builtin_amdgcn_s_waitcnt(0);
        const unsigned char* Kh = K8 + (size_t)(b * NH + h) * LK * 128; const bf16_t* Vh = Vb + (size_t)(b * NH + h) * LK * DV;
        float mx = -1e30f, m0 = -1e30f;
        for (int k0 = 0; k0 < LK; k0 += 64) { const unsigned char* kr = Kh + (size_t)(k0 + lane) * 128; float s = 0.f;
            for (int d = 0; d < 96; d += 4) { const unsigned w = *(const unsigned*)(kr + d);
                s += q[d] * __builtin_amdgcn_cvt_f32_fp8((int)w, 0) + q[d + 1] * __builtin_amdgcn_cvt_f32_fp8((int)w, 1) + q[d + 2] * __builtin_amdgcn_cvt_f32_fp8((int)w, 2) + q[d + 3] * __builtin_amdgcn_cvt_f32_fp8((int)w, 3); }
            mx = fmaxf(mx, s); if (k0 == 0) m0 = s; }
        for (int o = 1; o < 64; o <<= 1) { mx = fmaxf(mx, shx(mx, o, lane)); m0 = fmaxf(m0, shx(m0, o, lane)); }
        const float mref = ceilf(m0); const bool skip = (mx - mref) > 5.9f;
        float acc[64]; float lsum = 0.f;
#pragma unroll
        for (int d = 0; d < 64; ++d) acc[d] = 0.f;
        for (int k0 = 0; k0 < LK; k0 += 64) { const unsigned char* kr = Kh + (size_t)(k0 + lane) * 128; float s = 0.f;
            for (int d = 0; d < 96; d += 4) { const unsigned w = *(const unsigned*)(kr + d);
                s += q[d] * __builtin_amdgcn_cvt_f32_fp8((int)w, 0) + q[d + 1] * __builtin_amdgcn_cvt_f32_fp8((int)w, 1) + q[d + 2] * __builtin_amdgcn_cvt_f32_fp8((int)w, 2) + q[d + 3] * __builtin_amdgcn_cvt_f32_fp8((int)w, 3); }
            const float p = __builtin_amdgcn_exp2f(s - (mref - 2.0f)); lsum += p; const float pq = fp8q(p); const bf16_t* vr = Vh + (size_t)(k0 + lane) * DV;
#pragma unroll
            for (int d = 0; d < 64; ++d) acc[d] += pq * fp8q(bf2f(vr[d])); }
        lsum = wave_sum(lsum, lane);
        float worst = 0.f;
#pragma unroll
        for (int d = 0; d < 64; ++d) { const float o = wave_sum(acc[d], lane) / lsum; const float got = bf2f(YA[(size_t)row * NINP + 768 + h * 64 + d]); worst = fmaxf(worst, fabsf(got - o) - 0.0042f * fabsf(o)); }
        if (skip) worst = 0.f;
        if (lane == 0) atomicMax(flag + 1 + l, (unsigned)(worst * 1.0e6f));
        if (lane == 0 && !(worst < 3e-3f)) atomicOr(flag, 1u << l);
    }
    else if (wave_g < 64) {
        const int i = wave_g - 32, b = i & 1, t = (i * 977 + 13) & (SEQ - 1); const int row = b * SEQ + t, key = CTXL + t;
        unsigned bad = 0;
        if (lane < 32) { const int d = lane, ax = d >> 4, j = d & 7, second = (d >> 3) & 1; const float pos = (float)(ax == 0 ? (t >> 6) : (t & 63)); const float ang = pos * chk_invfreq(j);
            float cs, sn; chk_sincos(ang, sn, cs); const float x1 = bf2f(Ub[(size_t)row * NINP + COL_KR + 16 * ax + j]), x2 = bf2f(Ub[(size_t)row * NINP + COL_KR + 16 * ax + 8 + j]);
            const float ref = second ? x2 * cs + x1 * sn : x1 * cs - x2 * sn; const float rq = fp8q(ref);
            for (int h = 0; h < NH; ++h) { const unsigned char* kr = K8 + ((size_t)(b * NH + h) * LK + key) * 128; const float got = __builtin_amdgcn_cvt_f32_fp8((int)kr[64 + d], 0);
                if (fabsf(got - rq) > 0.13f * fabsf(rq) + 1e-3f) bad |= 1u; if (kr[96 + d] != (d == 0 ? 0x38 : 0)) bad |= 2u; } }
        { const int h = lane & 7, jj = lane >> 3; float ak = 0.f, av = 0.f, aq = 0.f; const int jk = jj & 3; const int qd = (jj < 4) ? jj : 88 + jj;
          for (int k = 0; k < 256; ++k) { const float u = bf2f(Ub[(size_t)row * NINP + COL_KV + k]); ak += u * bf2f(WukvT[(size_t)(h * 128 + 17 * jk) * 256 + k]); av += u * bf2f(WukvT[(size_t)(h * 128 + 64 + 15 * jk) * 256 + k]); }
          for (int k = 0; k < 384; ++k) aq += bf2f(Ub[(size_t)row * NINP + COL_Q + k]) * bf2f(WuqT[(size_t)(h * 96 + qd) * 384 + k]);
          const float gk = __builtin_amdgcn_cvt_f32_fp8((int)K8[((size_t)(b * NH + h) * LK + key) * 128 + 17 * jk], 0), gv = bf2f(Vb[((size_t)(b * NH + h) * LK + key) * DV + 15 * jk]), gq = bf2f(Q[(size_t)row * 768 + h * 96 + qd]);
          if (fabsf(gk - ak) > 0.08f * fabsf(ak) + 0.02f) bad |= 4u; if (fabsf(gv - av) > 0.02f * fabsf(av) + 0.01f) bad |= 8u; if (fabsf(gq - aq) > 0.02f * fabsf(aq) + 0.01f) bad |= 16u;
          const int tl = key >> 6, kin = key & 63, kk = kin & 31, khi = (kk >> 2) & 1, kr_ = (kk & 3) + 4 * (kk >> 3), kpos = khi * 32 + (kin >> 5) * 16 + kr_;
          const float gt = __builtin_amdgcn_cvt_f32_fp8((int)VT8[((size_t)(b * NH + h) * 260 + tl) * 4096 + (15 * jk) * 64 + kpos], 0);
          if (gt != fp8q(gv)) bad |= 32u; }
        if (bad) atomicOr(flag, bad << (8 + 8 * l));
    }
}
#endif
__device__ __forceinline__ int perm256(int n) { const int c = n & 255; return (n & ~255) + 128 * ((c >> 3) & 1) + 32 * (c >> 6) + 16 * ((c >> 2) & 1) + 4 * ((c >> 4) & 3) + (c & 3); }
__device__ __forceinline__ void tr_item(const float* __restrict__ W, int ldS, const float* __restrict__ rs, bf16_t* __restrict__ WT, int ldD, int col0D, int nblk, int rowmode, LAS float* scr, int item, int lane, float f8scale = 0.f) {
    const int kb = item / nblk, nb = item % nblk, k0 = 64 * kb, n0 = 32 * nb;
#pragma unroll
    for (int i = 0; i < 32; ++i) { const int kk = 2 * i + (lane >> 5); float v = W[(size_t)(k0 + kk) * ldS + n0 + (lane & 31)]; if (rs) v *= rs[k0 + kk]; scr[kk * 33 + (lane & 31)] = v; }
    LDS_WAIT(); asm volatile("" ::: "memory");
    const int c = lane & 7;
#pragma unroll
    for (int j = 0; j < 4; ++j) { const int n = (lane >> 3) + 8 * j; const LAS float* s = scr + (8 * c) * 33 + n;
        u32x4 o; o.x = cvt_pk_bf16(s[0 * 33], s[1 * 33]); o.y = cvt_pk_bf16(s[2 * 33], s[3 * 33]); o.z = cvt_pk_bf16(s[4 * 33], s[5 * 33]); o.w = cvt_pk_bf16(s[6 * 33], s[7 * 33]);
        const int ns = n0 + n; const int nd = rowmode == 0 ? ns : (rowmode == 3 ? perm256(ns) : (8 * (ns >> 2) + (ns & 3) + (rowmode == 2 ? 4 : 0)));
        if (f8scale != 0.f) { u32x2 o8; o8.x = pk4_fp8(s[0 * 33] * f8scale, s[1 * 33] * f8scale, s[2 * 33] * f8scale, s[3 * 33] * f8scale); o8.y = pk4_fp8(s[4 * 33] * f8scale, s[5 * 33] * f8scale, s[6 * 33] * f8scale, s[7 * 33] * f8scale);
            *(u32x2*)((unsigned char*)WT + (size_t)nd * ldD + col0D + k0 + 8 * c) = o8; }
        else *(u32x4*)(WT + (size_t)nd * ldD + col0D + k0 + 8 * c) = o; }
    LDS_WAIT(); asm volatile("" ::: "memory");
}

struct TrDesc { const float* W; unsigned char* WT; int ldS, ldD, rowmode, k0, n0; float sc; };
__device__ __forceinline__ void tr8_load(const TrDesc& d, float (&v)[32], int lane) {
    unsigned off = (unsigned)((d.k0 + (lane >> 5)) * d.ldS + d.n0 + (lane & 31)) * 4u; const unsigned step = (unsigned)d.ldS * 8u;
#pragma unroll
    for (int i = 0; i < 32; ++i) { v[i] = __builtin_nontemporal_load((const float*)((const char*)d.W + off)); off += step; }
}
__device__ __forceinline__ void tr8_store(const TrDesc& d, const float (&v)[32], LAS float* scr, int lane) {
#pragma unroll
    for (int i = 0; i < 32; ++i) scr[(2 * i + (lane >> 5)) * 33 + (lane & 31)] = v[i];
    LDS_WAIT(); asm volatile("" ::: "memory");
    const int c = lane & 7;
#pragma unroll
    for (int j = 0; j < 4; ++j) { const int n = (lane >> 3) + 8 * j; const LAS float* s = scr + (8 * c) * 33 + n;
        const int ns = d.n0 + n; int nd;
        if (d.rowmode == 0) { const int c = ns & 255; nd = (ns & ~255) + 128 * ((c >> 3) & 1) + 32 * (c >> 6) + 16 * ((c >> 2) & 1) + 4 * ((c >> 4) & 3) + (c & 3); }
        else { const int a = ns & 127; nd = 256 * (ns >> 7) + 128 * ((a >> 2) & 1) + 32 * (a >> 5) + (d.rowmode == 2 ? 16 : 0) + 4 * ((a >> 3) & 3) + (a & 3); }
        u32x2 o8; o8.x = pk4_fp8(s[0 * 33] * d.sc, s[1 * 33] * d.sc, s[2 * 33] * d.sc, s[3 * 33] * d.sc); o8.y = pk4_fp8(s[4 * 33] * d.sc, s[5 * 33] * d.sc, s[6 * 33] * d.sc, s[7 * 33] * d.sc);
        *(u32x2*)(d.WT + (unsigned)(nd * d.ldD + d.k0 + 8 * c)) = o8; }
    LDS_WAIT(); asm volatile("" ::: "memory");
}

struct Params { const float* in[26]; float* out; unsigned char* ws; int ph_lo, ph_hi, use_bar, pad; };
constexpr int NPH_L = 15, NPHASE = 2 + 2 * NPH_L;

template <bool XB16 = false>
__device__ __forceinline__ void norm_rows(const void* __restrict__ xin_, bf16_t* __restrict__ hout, const float* __restrict__ g, const float* __restrict__ sh, const float* __restrict__ sc, int nrows, int lane, unsigned char* __restrict__ h8 = nullptr) {
    f32x4 gm[4], sv[4];
#pragma unroll
    for (int j = 0; j < 4; ++j) { const f32x4 gv = *(const f32x4*)(g + 4 * lane + 256 * j), s1 = *(const f32x4*)(sc + 4 * lane + 256 * j); gm[j] = gv * (s1 + 1.0f); sv[j] = *(const f32x4*)(sh + 4 * lane + 256 * j); }
    for (int r = 0; r < nrows; r += 2) {
        f32x4 v0[4], v1[4]; float s0 = 0.f, s1 = 0.f;
        if constexpr (XB16) { const u32x2* xr0 = (const u32x2*)((const bf16_t*)xin_ + (size_t)r * DM) + lane; const u32x2* xr1 = xr0 + DM / 4;
#pragma unroll
            for (int j = 0; j < 4; ++j) { const u32x2 a = xr0[64 * j], b = xr1[64 * j]; v0[j] = (f32x4){bf_lo(a.x), bf_hi(a.x), bf_lo(a.y), bf_hi(a.y)}; v1[j] = (f32x4){bf_lo(b.x), bf_hi(b.x), bf_lo(b.y), bf_hi(b.y)}; } }
        else { const f32x4* xr0 = (const f32x4*)((const float*)xin_ + (size_t)r * DM) + lane; const f32x4* xr1 = xr0 + DM / 4;
#pragma unroll
            for (int j = 0; j < 4; ++j) { v0[j] = xr0[64 * j]; v1[j] = xr1[64 * j]; } }
#pragma unroll
        for (int j = 0; j < 4; ++j) { s0 += (v0[j].x * v0[j].x + v0[j].y * v0[j].y) + (v0[j].z * v0[j].z + v0[j].w * v0[j].w); s1 += (v1[j].x * v1[j].x + v1[j].y * v1[j].y) + (v1[j].z * v1[j].z + v1[j].w * v1[j].w); }
        const float rstd0 = rsqrtf(wave_sum(s0, lane) * (1.0f / DM) + EPS), rstd1 = rsqrtf(wave_sum(s1, lane) * (1.0f / DM) + EPS);
        u32x2* o0 = (u32x2*)(hout + (size_t)r * DM) + lane; u32x2* o1 = o0 + DM / 4;
#pragma unroll
        for (int j = 0; j < 4; ++j) { const f32x4 y0 = v0[j] * rstd0 * gm[j] + sv[j], y1 = v1[j] * rstd1 * gm[j] + sv[j]; u32x2 w0, w1; w0.x = cvt_pk_bf16(y0.x, y0.y); w0.y = cvt_pk_bf16(y0.z, y0.w); w1.x = cvt_pk_bf16(y1.x, y1.y); w1.y = cvt_pk_bf16(y1.z, y1.w); o0[64 * j] = w0; o1[64 * j] = w1;
            if (h8) { ((unsigned*)(h8 + (size_t)r * DM))[lane + 64 * j] = pk4_fp8(y0.x, y0.y, y0.z, y0.w); ((unsigned*)(h8 + (size_t)(r + 1) * DM))[lane + 64 * j] = pk4_fp8(y1.x, y1.y, y1.z, y1.w); } }
    }
}

#define PHASE_BEGIN unsigned zo_ = 0; int z_ = 0; int tid; asm volatile("v_mbcnt_lo_u32_b32 %0, -1, 0\n\tv_mbcnt_hi_u32_b32 %0, -1, %0" : "=v"(tid)); tid += wave0_ * 64; int bx = blockIdx.x; int G = gridDim.x; LAS unsigned char* ldsp = lds; asm volatile("" : "+s"(zo_), "+s"(z_), "+v"(tid), "+s"(bx), "+s"(G), "+s"(ldsp)); \
    zo_ = (unsigned)__builtin_amdgcn_readfirstlane((int)zo_); z_ = __builtin_amdgcn_readfirstlane(z_); bx = __builtin_amdgcn_readfirstlane(bx); G = __builtin_amdgcn_readfirstlane(G); ldsp = (LAS unsigned char*)(unsigned)__builtin_amdgcn_readfirstlane((int)(unsigned)(uintptr_t)ldsp);     \
    (void)ldsp; unsigned char* wsp = P.ws + zo_; \
    const int lane = tid & 63, wave = __builtin_amdgcn_readfirstlane(tid >> 6); const int vcu = (G % 8 == 0) ? (bx % 8) * (G / 8) + bx / 8 : bx; const int gw = vcu * 8 + wave, NGW = G * 8; (void)lane; (void)wave; (void)vcu; (void)gw; (void)NGW
#define INP(k) (P.in[(k) + z_])
#define CV_NIT (NEX * 384)
#define CV_ON (G == 256)
#define CV_Q6 8
#define CV_Q8 7
#define CV_A (CV_ON ? 248 * 8 * CV_Q6 : 0)
#define CV_B (CV_ON ? CV_NIT - 126 * 8 * CV_Q8 : CV_NIT)
#define TR_DESC(D, it_) do { const int e_ = (it_) / 384, r_ = (it_) % 384, q_ = r_ & 127; \
                if (r_ < 128) { D.W = e_ < NE ? INP(19) + ((size_t)l * NE + e_) * DM * DE : INP(22) + (size_t)l * DM * DE; D.WT = P_EWGU8 + (size_t)e_ * 512 * 1024; D.ldS = DE; D.ldD = DM; D.rowmode = 1; D.k0 = 64 * (q_ >> 3); D.n0 = 32 * (q_ & 7); D.sc = 32.0f; } \
                else if (r_ < 256) { D.W = e_ < NE ? INP(20) + ((size_t)l * NE + e_) * DM * DE : INP(23) + (size_t)l * DM * DE; D.WT = P_EWGU8 + (size_t)e_ * 512 * 1024; D.ldS = DE; D.ldD = DM; D.rowmode = 2; D.k0 = 64 * (q_ >> 3); D.n0 = 32 * (q_ & 7); D.sc = 32.0f; } \
                else { D.W = e_ < NE ? INP(21) + ((size_t)l * NE + e_) * DE * DM : INP(24) + (size_t)l * DE * DM; D.WT = (unsigned char*)P_EWD + (size_t)e_ * 1024 * 256; D.ldS = DM; D.ldD = DE; D.rowmode = 0; D.k0 = 64 * (q_ >> 5); D.n0 = 32 * (q_ & 31); D.sc = 16.0f; } } while (0)
#define CONVERT_ITEMS(first_, step_, end_) do { int it = (first_); const int st_ = (step_), en_ = (end_);     \
                if (it < en_) { TrDesc d0, d1; float va[32], vb[32]; TR_DESC(d0, it); d1 = d0; \
                    { const float zf_ = (float)z_;                  \
                      _Pragma("unroll") for (int i = 0; i < 32; ++i) vb[i] = zf_; } \
                    tr8_load(d0, va, lane); \
                    for (;;) { \
                        const int it1 = it + st_; const bool h1 = it1 < en_; if (h1) { TR_DESC(d1, it1); tr8_load(d1, vb, lane); } \
                        tr8_store(d0, va, scr, lane); if (!h1) break; \
                        const int it2 = it1 + st_; const bool h2 = it2 < en_; if (h2) { TR_DESC(d0, it2); tr8_load(d0, va, lane); } \
                        tr8_store(d1, vb, scr, lane); if (!h2) break; \
                        it = it2; } } } while (0)
#define P_MODS ((float*)(wsp + WS_MODS))
#define P_XS ((bf16_t*)(wsp + WS_XS))
#define P_HQ ((bf16_t*)(wsp + WS_HQ))
#define P_U ((bf16_t*)(wsp + WS_U))
#define P_KB ((bf16_t*)(wsp + WS_KB))
#define P_VB ((bf16_t*)(wsp + WS_VB))
#define P_YA ((bf16_t*)(wsp + WS_YA))
#define P_YP ((bf16_t*)(wsp + WS_YP))
#define P_K8 ((unsigned char*)(wsp + WS_KB))
#define P_VT8 ((unsigned char*)(wsp + WS_VT8))
#define P_EWGU ((bf16_t*)(wsp + WS_EW))
#define P_EWD ((bf16_t*)(wsp + WS_EW + EW_GU_BYTES))
#define P_EWGU8 ((unsigned char*)(wsp + WS_EW))
#define P_H2F8 ((unsigned char*)(wsp + WS_EW + EW_GU_BYTES / 2))
#define P_ACT ((bf16_t*)(wsp + WS_ACT))
#define P_TOKL ((int*)(wsp + WS_TOKL))
#define P_TPOS ((int*)(wsp + WS_TPOS))
#define P_TW ((float*)(wsp + WS_TW))
#define P_LOG ((float*)(wsp + WS_LOG))
#define P_YB ((bf16_t*)(wsp + WS_YB))
#define P_F1 ((bf16_t*)(wsp + WS_F1))
#define P_F2 ((bf16_t*)(wsp + WS_F2))
#define P_FC ((bf16_t*)(wsp + WS_FC))
#define P_WCS ((float*)(wsp + WS_WCS))
#define P_DW(l) (wsp + WS_DW + (size_t)(l) * DW_LAYER)
#define P_GCNT(l) ((unsigned*)(wsp + WS_CTL) + CW_CNT + (l) * 64)

__global__ void __launch_bounds__(512, 2) mk_fwd(Params P) {
    extern __shared__ __attribute__((aligned(16))) unsigned char lds_raw[];
    LAS unsigned char* lds = (LAS unsigned char*)lds_raw;
    const int wave0_ = __builtin_amdgcn_readfirstlane((int)threadIdx.x >> 6);
    volatile LAS unsigned* MISC = (volatile LAS unsigned*)(lds + MISC_OFF);
    for (int u = threadIdx.x; u < 128; u += 512) MISC[u] = 0u;
    __syncthreads();
    XcdBarrier bar; bar.bar = (unsigned*)(P.ws + WS_CTL) + CW_BAR; bar.x = 0; bar.st = nullptr;
    if (P.use_bar) bar = xcd_barrier_post((unsigned*)(P.ws + WS_CTL) + CW_BAR, MISC + 8);
    const int lo = P.ph_lo, hi = P.ph_hi;
#define IN(k) ({ int lo_ = lo; asm volatile("" : "+s"(lo_)); lo_ = __builtin_amdgcn_readfirstlane(lo_); (lo_ <= (k) && (k) < hi); })
#define SEAM(k) do { if (IN(k) && IN((k) + 1)) { XcdBarrier bb_ = bar; unsigned zb_ = 0; int t0_; asm volatile("v_mbcnt_lo_u32_b32 %0, -1, 0\n\tv_mbcnt_hi_u32_b32 %0, -1, %0" : "=v"(t0_)); t0_ += wave0_ * 64; asm volatile("" : "+s"(zb_), "+s"(bb_.x)); zb_ = (unsigned)__builtin_amdgcn_readfirstlane((int)zb_); bb_.x = (unsigned)__builtin_amdgcn_readfirstlane((int)bb_.x); bb_.bar = (unsigned*)(P.ws + WS_CTL + zb_) + CW_BAR; for (int rb_ = 0; rb_ < REP_BAR; ++rb_) xcd_barrier(bb_, t0_); } } while (0)

    if (IN(0)) for (int rep_ = 0; rep_ < REP_PRO; ++rep_) {
        PHASE_BEGIN;
        {
            LAS float* sl = (LAS float*)lds;
            const float* c_in = INP(1); const float* cctx_in = INP(3);
            for (int i = tid; i < 3 * DM; i += 512) { const int v = i >> 10, d = i & 1023; const float cv = v < 2 ? c_in[v * DM + d] : cctx_in[d]; sl[i] = silu_f(cv); }
            __syncthreads();
            LAS float* red = sl + 3 * DM;
            for (int it = vcu; it < 192; it += G) {
                const int l = it / 96, n = (it % 96) * 64 + lane; const float* w = INP(4) + (size_t)l * DM * 6144 + n;
                float a0 = 0.f, a1 = 0.f, a2 = 0.f;
#pragma unroll 8
                for (int d = wave * 128; d < wave * 128 + 128; ++d) { const float wv = __builtin_nontemporal_load(w + (size_t)d * 6144); a0 += sl[d] * wv; a1 += sl[DM + d] * wv; a2 += sl[2 * DM + d] * wv; }
                red[(wave * 3 + 0) * 64 + lane] = a0; red[(wave * 3 + 1) * 64 + lane] = a1; red[(wave * 3 + 2) * 64 + lane] = a2;
                __syncthreads();
                if (wave < 3) { float s = 0.f;
#pragma unroll
                    for (int w8 = 0; w8 < 8; ++w8) s += red[(w8 * 3 + wave) * 64 + lane];
                    P_MODS[(l * 3 + wave) * 6144 + n] = s + INP(5)[l * 6144 + n]; }
                __syncthreads();
            }
            __syncthreads();
        }
        {
            LAS float* scr = (LAS float*)(lds + wave * 16384);
            constexpr int I_IN = 16 * 37, I_UQ = 6 * 24, I_UKV = 4 * 32, I_OUT = 8 * 32, I_R = 16 * 2, I_L = I_IN + I_UQ + I_UKV + I_OUT + I_R;
            for (int it = gw; it < 2 * I_L; it += NGW) {
                const int l = it / I_L; int r = it % I_L; unsigned char* dw = P_DW(l);
                if (r < I_IN) { tr_item(INP(8) + (size_t)l * DM * 1184, 1184, nullptr, (bf16_t*)(dw + DW_WIN), DM, 0, 37, 0, scr, r, lane); continue; } r -= I_IN;
                if (r < I_UQ) { tr_item(INP(13) + (size_t)l * 384 * 768, 768, INP(12) + l * 384, (bf16_t*)(dw + DW_WUQ), 384, 0, 24, 0, scr, r, lane); continue; } r -= I_UQ;
                if (r < I_UKV) { tr_item(INP(15) + (size_t)l * 256 * 1024, 1024, INP(14) + l * 256, (bf16_t*)(dw + DW_WUKV), 256, 0, 32, 0, scr, r, lane); continue; } r -= I_UKV;
                if (r < I_OUT) { tr_item(INP(16) + (size_t)l * DM * DM + (size_t)512 * DM, DM, nullptr, (bf16_t*)(dw + DW_WCOMB), NINP, 768, 32, 3, scr, r, lane); continue; } r -= I_OUT;
                tr_item(INP(17) + (size_t)l * DM * NE, NE, nullptr, (bf16_t*)(dw + DW_WR), DM, 0, 2, 0, scr, r, lane);
            }
            for (int l = 0; l < 2; ++l) {
                u32x4* z1 = (u32x4*)(P_DW(l) + DW_WIN + (size_t)1184 * DM * 2); const int n1 = 96 * DM * 2 / 16;
                for (int i = bx * 512 + tid; i < n1; i += G * 512) z1[i] = (u32x4){(unsigned)z_, (unsigned)z_, (unsigned)z_, (unsigned)z_};
                u32x4* z2 = (u32x4*)(P_DW(l) + DW_WR + (size_t)64 * DM * 2); const int n2 = 192 * DM * 2 / 16;
                for (int i = bx * 512 + tid; i < n2; i += G * 512) z2[i] = (u32x4){(unsigned)z_, (unsigned)z_, (unsigned)z_, (unsigned)z_};
            }
        }
        { bf16_t* F1 = P_F1; bf16_t* F2 = P_F2; bf16_t* FC = P_FC;
        for (int i = bx * 512 + tid; i < 256 * 128; i += G * 512) { const int m = i >> 7, l1 = i & 127, w = m >> 5, rho = m & 31, part = (rho >> 3) & 1, k1 = 16 * w + (((rho >> 4) << 3) | (rho & 7));
            float sn, cs; sincospif((float)((k1 * l1) & 127) * (1.0f / 64.0f), &sn, &cs); const float v = (part ? -sn : cs) * (1.0f / 128.0f); F1[i] = (bf16_t)(cvt_pk_bf16(v, 0.f) & 0xffffu); }
        for (int i = bx * 512 + tid; i < 256 * 256; i += G * 512) { const int m = i >> 8, j = i & 255, zp = m >> 7, k2 = m & 127, l2 = j >> 1, part = j & 1;
            float sn, cs; sincospif((float)((k2 * l2) & 127) * (1.0f / 64.0f), &sn, &cs); const float v = zp == 0 ? (part ? sn : cs) : (part ? cs : -sn); F2[i] = (bf16_t)(cvt_pk_bf16(v, 0.f) & 0xffffu); }
        for (int i = bx * 512 + tid; i < 512 * 256; i += G * 512) { const int m = i >> 8, l = i & 255, zp = m >> 8, k = m & 255;
            float sn, cs; sincospif((float)((k * l) & 255) * (1.0f / 128.0f), &sn, &cs); const float v = (zp ? -sn : cs) * (1.0f / 16.0f); FC[i] = (bf16_t)(cvt_pk_bf16(v, 0.f) & 0xffffu); } }
        for (int i = bx * 512 + tid; i < 2 * 2 * 4 * 64 * 64; i += G * 512) { const int d = i & 63, c = (i >> 6) & 63, g = (i >> 12) & 3, cs_ = (i >> 14) & 1, l = i >> 15;
            const float* wf = INP(11) + (size_t)(l * 4 + g) * 4096 + d; float a = 0.f;
            for (int m = 0; m < 64; ++m) { float sn, cs; sincospif((float)((m * c) & 63) * (1.0f / 32.0f), &sn, &cs); a += (cs_ ? sn : cs) * wf[m * 64]; }
            P_WCS[i] = a * 0.125f; }
    }
    SEAM(0);

#pragma unroll 1
    for (int l = 0; l < 2; ++l) {
        const int pb = 1 + l * NPH_L;
        const int RL = l == 0 ? RT : TL;

        for (int grp_ = 0; grp_ < GRP_MIX; ++grp_) {
        if (IN(pb + 0)) for (int rep_ = 0; rep_ < REP_NORM; ++rep_) {
            PHASE_BEGIN;
            const float* mods = P_MODS + (size_t)l * 3 * 6144;
            const float* xlat = INP(0); const float* xctx = INP(2);
            if (l == 0)
            for (int ch = gw; ch < RT / 16; ch += NGW) { const int r0 = ch * 16; const int vec = r0 < SEQ ? 0 : (r0 < TL ? 1 : 2);
                const float* xi = r0 < TL ? xlat + (size_t)r0 * DM : xctx + (size_t)(r0 - TL) * DM;
                norm_rows(xi, P_HQ + (size_t)r0 * DM, INP(6) + l * DM, mods + vec * 6144 + 0, mods + vec * 6144 + DM, 16, lane); }
            if (l == 0) {
                for (int it = gw; it < 2 * 96 * 16; it += NGW) {
                    const int itu = __builtin_amdgcn_readfirstlane(it); const int nch = itu & 15, kb = (itu >> 4) % 96, ll = itu / (96 * 16), k0 = kb * 8, n = nch * 64 + lane;
                    const bool pool = k0 < 256; const int kk = pool ? k0 : k0 - 256, cs_ = pool ? 0 : (kk >> 8), g = (kk >> 6) & 3, c0 = kk & 63;
                    const float* wo = INP(16) + (size_t)ll * DM * DM + (size_t)((pool ? 0 : 256) + g * 64) * DM + n;
                    const float* arow = pool ? INP(9) + (size_t)(ll * 4 + g) * 4096 + c0 * 64 : P_WCS + ((size_t)((ll * 2 + cs_) * 4 + g) * 64 + c0) * 64;
                    const float* ps = INP(10) + ll * 256 + g * 64;
                    float acc[8];
#pragma unroll
                    for (int j = 0; j < 8; ++j) acc[j] = 0.f;
#pragma unroll 4
                    for (int d = 0; d < 64; ++d) { const float wv = wo[(size_t)d * DM]; const float sc_ = pool ? ps[d] : 1.0f;
#pragma unroll
                        for (int j = 0; j < 8; ++j) acc[j] += arow[j * 64 + d] * sc_ * wv; }
                    u32x4 w; w.x = cvt_pk_bf16(acc[0], acc[1]); w.y = cvt_pk_bf16(acc[2], acc[3]); w.z = cvt_pk_bf16(acc[4], acc[5]); w.w = cvt_pk_bf16(acc[6], acc[7]);
                    *(u32x4*)((bf16_t*)(P_DW(ll) + DW_WCOMB) + (size_t)perm256(n) * NINP + k0) = w;
                }
            }
        }
        if (l == 0 || GRP_MOE > 1 || REP_COMB > 1 || GRP_MIX > 1) SEAM(pb + 0);

        if (IN(pb + 1)) for (int rep_ = 0; rep_ < REP_DENSE; ++rep_) {
            PHASE_BEGIN;
            pg8::DenseSched S; S.init(RT, NINP, G, bx, P_HQ, DM, P_DW(l) + DW_WIN, DM);
            pg8::EpiBf16 E{P_U, NINP, 0};
            pg8::gemm_phase<pg8::EpiBf16, pg8::DenseSched>(lds, DM, S, E, tid);
        }
        SEAM(pb + 1);

        if (IN(pb + 2)) for (int rep_ = 0; rep_ < REP_ROWS; ++rep_) {
            PHASE_BEGIN;
            bf16_t* Ub = P_U; bf16_t* YA = P_YA;
            for (int ch = gw; ch < RT / 16; ch += NGW) {
                const int r0 = ch * 16; const bool isc = r0 >= TL; const int b = isc ? (r0 - TL) >> 8 : r0 >> 14; const int t0 = isc ? (r0 - TL) & (CTXL - 1) : r0 & (SEQ - 1); const int Ls = isc ? CTXL : SEQ;
                const bf16_t* useq = Ub + (size_t)(r0 - t0) * NINP;
                if (l == 0 || !isc) {
                    u32x2 x[32];
#pragma unroll
                    for (int j = 0; j < 32; ++j) { const int tt = t0 - 8 + j; const int tc = tt < 0 ? 0 : (tt >= Ls ? Ls - 1 : tt); x[j] = *(const u32x2*)(useq + (size_t)tc * NINP + lane * 4); if (tt < 0 || tt >= Ls) x[j] = (u32x2){(unsigned)z_, (unsigned)z_}; }
                    const int g = lane >> 4, hw = 1 << g;
                    float res[16][4];
#pragma unroll
                    for (int half = 0; half < 2; ++half) {
                        float p0[33], p1[33]; p0[0] = 0.f; p1[0] = 0.f;
#pragma unroll
                        for (int j = 0; j < 32; ++j) { const unsigned w = half ? x[j].y : x[j].x; p0[j + 1] = p0[j] + bf_lo(w); p1[j + 1] = p1[j] + bf_hi(w); }
#pragma unroll
                        for (int i = 0; i < 16; ++i) { const int c = i + 8;
                            const float a1 = p0[c + 1] - p0[c - 1], a2 = p0[c + 2] - p0[c - 2], a4 = p0[c + 4] - p0[c - 4], a8 = p0[c + 8] - p0[c - 8];
                            const float b1 = p1[c + 1] - p1[c - 1], b2 = p1[c + 2] - p1[c - 2], b4 = p1[c + 4] - p1[c - 4], b8 = p1[c + 8] - p1[c - 8];
                            res[i][2 * half] = g == 0 ? a1 : (g == 1 ? a2 : (g == 2 ? a4 : a8)); res[i][2 * half + 1] = g == 0 ? b1 : (g == 1 ? b2 : (g == 2 ? b4 : b8)); }
                    }
#pragma unroll
                    for (int i = 0; i < 16; ++i) { const int t = t0 + i; const int lo_ = (t - hw) < 0 ? 0 : t - hw, hi_ = (t + hw) > Ls ? Ls : t + hw; const float ic = 1.0f / (float)(hi_ - lo_);
                        const u32x2 me = x[i + 8];
                        u32x2 w; w.x = cvt_pk_bf16(res[i][0] * ic - bf_lo(me.x), res[i][1] * ic - bf_hi(me.x)); w.y = cvt_pk_bf16(res[i][2] * ic - bf_lo(me.y), res[i][3] * ic - bf_hi(me.y));
                        *(u32x2*)(YA + (size_t)(r0 + i) * NINP + lane * 4) = w; }
                }
#pragma unroll 1
                for (int rb = 0; rb < 16; rb += 8) {
                    u32x4 qv[8], kv[8], kr[8]; const int cpc = lane & 3;
#pragma unroll
                    for (int k = 0; k < 8; ++k) { bf16_t* ur = Ub + (size_t)(r0 + rb + k) * NINP;
                        qv[k] = (u32x4){(unsigned)z_, (unsigned)z_, (unsigned)z_, (unsigned)z_}; kv[k] = qv[k];
                        if (lane < 48) qv[k] = *(const u32x4*)(ur + COL_Q + lane * 8);
                        if (lane < 32) kv[k] = *(const u32x4*)(ur + COL_KV + lane * 8);
                        kr[k] = *(const u32x4*)(ur + COL_KR + cpc * 8); }
#pragma unroll
                    for (int k = 0; k < 8; ++k) { const int row = r0 + rb + k, t = t0 + rb + k; bf16_t* ur = Ub + (size_t)row * NINP;
                        float sq = 0.f, sk = 0.f;
#pragma unroll
                        for (int j = 0; j < 4; ++j) { const float a = bf_lo(qv[k][j]), c2 = bf_hi(qv[k][j]); sq += a * a + c2 * c2; const float a2 = bf_lo(kv[k][j]), c3 = bf_hi(kv[k][j]); sk += a2 * a2 + c3 * c3; }
                        const float rq = rsqrtf(wave_sum(sq, lane) * (1.0f / 384.0f) + EPS), rk = rsqrtf(wave_sum(sk, lane) * (1.0f / 256.0f) + EPS);
                        if (lane < 48) { u32x4 w;
#pragma unroll
                            for (int j = 0; j < 4; ++j) w[j] = cvt_pk_bf16(bf_lo(qv[k][j]) * rq, bf_hi(qv[k][j]) * rq);
                            *(u32x4*)(ur + COL_Q + lane * 8) = w; }
                        if (lane < 32) { u32x4 w;
#pragma unroll
                            for (int j = 0; j < 4; ++j) w[j] = cvt_pk_bf16(bf_lo(kv[k][j]) * rk, bf_hi(kv[k][j]) * rk);
                            *(u32x4*)(ur + COL_KV + lane * 8) = w; }
                        const u32x4 mine = kr[k]; u32x4 oth;
#pragma unroll
                        for (int j = 0; j < 4; ++j) oth[j] = (unsigned)shxi((int)mine[j], 1, lane);
                        float f[8];
#pragma unroll
                        for (int j = 0; j < 4; ++j) { f[2 * j] = bf_lo(mine[j]); f[2 * j + 1] = bf_hi(mine[j]); }
                        if (!isc) { const float pos = (float)((cpc >> 1) == 0 ? (t >> 6) : (t & 63)); const bool second = cpc & 1;
#pragma unroll
                            for (int j = 0; j < 4; ++j) {
#pragma unroll
                                for (int q = 0; q < 2; ++q) { const float ang = pos * __powf(10000.0f, -(float)(2 * j + q) * 0.125f); const float sn = __sinf(ang), cs = __cosf(ang);
                                    const float m0 = q ? bf_hi(mine[j]) : bf_lo(mine[j]), o0 = q ? bf_hi(oth[j]) : bf_lo(oth[j]);
                                    f[2 * j + q] = second ? m0 * cs + o0 * sn : m0 * cs - o0 * sn; } } }
                        const int h = (lane >> 2) & 7; const int key = isc ? t : CTXL + t;
                        unsigned char* kd = P_K8 + ((size_t)(b * NH + h) * LK + key) * 128;
                        u32x2 w; w.x = pk4_fp8(f[0], f[1], f[2], f[3]); w.y = pk4_fp8(f[4], f[5], f[6], f[7]);
                        if (lane < 32) *(u32x2*)(kd + 64 + cpc * 8) = w; else *(u32x2*)(kd + 96 + cpc * 8) = (u32x2){(unsigned)z_ + (cpc == 0 ? 0x38u : 0u), (unsigned)z_}; }
                }
            }
        }
        SEAM(pb + 2);

        if (IN(pb + 3)) {
            for (int rep_ = 0; rep_ < REP_DENSE; ++rep_) { PHASE_BEGIN; pg8::DenseSched S; S.init(RL, 768, G, bx, P_U + COL_Q, NINP, P_DW(l) + DW_WUQ, 384);
              pg8::EpiBf16 E{P_HQ, 768, 0};
              pg8::gemm_phase<pg8::EpiBf16, pg8::DenseSched>(lds, 384, S, E, tid); }
            for (int rep_ = 0; rep_ < REP_DENSE; ++rep_) { PHASE_BEGIN; pg8::DenseSched S; S.init(RT, 1024, G, (G == 256) ? ((bx + 120) & 255) : bx, P_U + COL_KV, NINP, P_DW(l) + DW_WUKV, 256);
              pg8::EpiKV E{P_K8, P_VB};
              pg8::gemm_phase<pg8::EpiKV, pg8::DenseSched>(lds, 256, S, E, tid); }
            for (int rep_ = 0; rep_ < REP_FFT; ++rep_) { PHASE_BEGIN;
              for (int u = vcu; u < 256; u += G) { const int b = u >> 7, l2 = u & 127;
                dft::unit<0, 128>((LAS char*)lds, P_F1, (const char*)(P_U + (size_t)(b * SEQ + l2) * NINP + COL_FNO), (size_t)128 * NINP * 2, (char*)P_YP, b, l2, tid); } }
            if (l == 0) { PHASE_BEGIN;
              for (int u = vcu; u < 4; u += G) { const int b = u >> 1, zp = u & 1;
                dft::unit<2, 256>((LAS char*)lds, P_FC + (size_t)zp * 256 * 256, (const char*)(P_U + (size_t)(TL + b * CTXL) * NINP + COL_FNO), (size_t)NINP * 2, (char*)P_YA, b, zp, tid); } }
        }
        SEAM(pb + 3);

        if (IN(pb + 4)) for (int rep_ = 0; rep_ < REP_VT; ++rep_) {
            PHASE_BEGIN;
            LAS unsigned char* scr = (LAS unsigned char*)(ldsp + wave * 5120);
            const int k = lane, kk = k & 31, khi = (kk >> 2) & 1, kr = (kk & 3) + 4 * (kk >> 3), kpos = khi * 32 + (k >> 5) * 16 + kr;
            for (int u = gw; u < 16 * 260; u += NGW) { const int bh = u / 260, tl = u % 260;
                const u32x4* srcp = (const u32x4*)(P_VB + ((size_t)bh * LK + tl * 64 + k) * DV);
                u32x4 v[8];
#pragma unroll
                for (int c = 0; c < 8; ++c) v[c] = srcp[c];
#pragma unroll
                for (int c = 0; c < 8; ++c)
#pragma unroll
                    for (int j = 0; j < 4; ++j) { const unsigned w = __builtin_amdgcn_cvt_pk_fp8_f32(bf_lo(v[c][j]), bf_hi(v[c][j]), 0u, false); const int d = 8 * c + 2 * j;
                        scr[d * 80 + kpos] = (unsigned char)(w & 0xffu); scr[(d + 1) * 80 + kpos] = (unsigned char)((w >> 8) & 0xffu); }
                LDS_WAIT(); asm volatile("" ::: "memory");
                u32x4* dstp = (u32x4*)(P_VT8 + ((size_t)bh * 260 + tl) * 4096 + lane * 64);
#pragma unroll
                for (int c = 0; c < 4; ++c) dstp[c] = *(const LAS u32x4*)(scr + lane * 80 + c * 16);
                LDS_WAIT(); asm volatile("" ::: "memory");
            }
        }
        SEAM(pb + 4);

        if (IN(pb + 5)) {
            for (int rep_ = 0; rep_ < REP_FFT; ++rep_) { PHASE_BEGIN;
              for (int u = vcu; u < 256; u += G) { const int b = u >> 7, k1 = u & 127;
                dft::unit<1, 256>((LAS char*)lds, P_F2, (const char*)(P_YP + (size_t)(b * 128 + k1) * 256 * 256), (size_t)512, (char*)P_YA, b, k1, tid); } }
            if (l == 0) { PHASE_BEGIN;
              for (int u = vcu; u < 16; u += G) { const int b = u >> 3, h = u & 7;
                att8::attn_unit(P_HQ + (size_t)(TL + b * CTXL) * 768 + h * DQK, P_K8 + (size_t)(b * NH + h) * LK * 128, P_VT8 + (size_t)(b * NH + h) * 260 * 4096,
                                P_YA + (size_t)(TL + b * CTXL) * NINP + 768 + h * DV, NINP, CTXL / 64, false, 0, CTXL, (LAS char*)lds, tid); } }
            for (int rep_ = 0; rep_ < REP_ATT; ++rep_) { PHASE_BEGIN;
              for (int u = vcu; u < 512; u += G) { const int bh = u >> 5, qb = u & 31, b = bh >> 3, h = bh & 7; int tidu = tid; asm volatile("" : "+v"(tidu));
#if ATT_VAR
                if (rep_ + 1 < REP_ATT) att8::attn_unit_p<ATT_VAR>(P_HQ + (size_t)(b * SEQ + qb * 512) * 768 + h * DQK, P_K8 + (size_t)bh * LK * 128, P_VT8 + (size_t)bh * 260 * 4096,
                                P_YA + (size_t)(b * SEQ + qb * 512) * NINP + 768 + h * DV, NINP, LK / 64, true, qb * 512, 512, (LAS char*)lds, tidu); else
#endif
                att8::attn_unit_p<0>(P_HQ + (size_t)(b * SEQ + qb * 512) * 768 + h * DQK, P_K8 + (size_t)bh * LK * 128, P_VT8 + (size_t)bh * 260 * 4096,
                                P_YA + (size_t)(b * SEQ + qb * 512) * NINP + 768 + h * DV, NINP, LK / 64, true, qb * 512, 512, (LAS char*)lds, tidu); } }
        }
        SEAM(pb + 5);
        }

        if (IN(pb + 6)) for (int rep_ = 0; rep_ < REP_OUT; ++rep_) {
            PHASE_BEGIN;
#if SELFCHECK
            if (gw < 64) selfcheck_attn(l, P_HQ, P_K8, P_VB, P_VT8, P_YA, P_U, (const bf16_t*)(P_DW(l) + DW_WUQ), (const bf16_t*)(P_DW(l) + DW_WUKV), (unsigned*)(wsp + WS_CTL) + CW_CHK, (LAS float*)(ldsp + wave * 1024), gw, lane);
            __syncthreads();
#endif
            const float* xlat = INP(0); const float* xctx = INP(2); const bf16_t* xsin = (l == 0 && rep_ == 0) ? nullptr : P_XS;
            pg8::DenseSched S; S.init(RL, DM, G, bx, P_YA, NINP, P_DW(l) + DW_WCOMB, NINP);
            pg8::EpiResid E{xlat, xctx, xsin, P_XS, P_MODS + (size_t)l * 3 * 6144, (REP_OUT > 1 && rep_ > 0) ? 0.f : 1.f};
            pg8::gemm_phase<pg8::EpiResid, pg8::DenseSched>(lds, NINP, S, E, tid);
            if (CV_ON && bx >= 8 && rep_ == 0) { LAS float* scr = (LAS float*)(lds + wave * 16384);
                CONVERT_ITEMS((bx - 8) * 8 + wave, 248 * 8, CV_A); }
        }
        SEAM(pb + 6);

        for (int grp2_ = 0; grp2_ < GRP_MOE; ++grp2_) {
        if (IN(pb + 7)) for (int rep_ = 0; rep_ < REP_NORM * REP_P7; ++rep_) {
            PHASE_BEGIN;
            const float* mods = P_MODS + (size_t)l * 3 * 6144;
            for (int ch = gw; ch < RL / 16; ch += NGW) { const int r0 = ch * 16; const int vec = r0 < SEQ ? 0 : (r0 < TL ? 1 : 2);
                norm_rows<true>(P_XS + (size_t)r0 * DM, P_YB + (size_t)r0 * DM, INP(7) + l * DM, mods + vec * 6144 + 3 * DM, mods + vec * 6144 + 4 * DM, 16, lane, P_H2F8 + (size_t)r0 * DM); }
            LAS float* scr = (LAS float*)(lds + wave * 16384);
            CONVERT_ITEMS(CV_A + gw, NGW, CV_B);
        }
        SEAM(pb + 7);

        if (IN(pb + 8)) for (int rep_ = 0; rep_ < REP_DENSE; ++rep_) {
            PHASE_BEGIN;
            pg8::DenseSched S; S.init(RL, 256, G, bx, P_YB, DM, P_DW(l) + DW_WR, DM);
            pg8::EpiLogits E{P_LOG};
            pg8::gemm_phase<pg8::EpiLogits, pg8::DenseSched>(lds, DM, S, E, tid);
            if (CV_ON && bx >= 130 && rep_ == 0) { LAS float* scr = (LAS float*)(lds + wave * 16384);
                CONVERT_ITEMS(CV_B + (bx - 130) * 8 + wave, 126 * 8, CV_NIT); }
        }
        SEAM(pb + 8);

        if (IN(pb + 9)) for (int rep_ = 0; rep_ < REP_ROUTE; ++rep_) {
            PHASE_BEGIN;
            LAS int* lcnt = (LAS int*)lds; LAS int* lbase = lcnt + 64; LAS int* rec = lbase + 64;
            if (tid < 64) lcnt[tid] = 0;
            __syncthreads();
            const int per = (RL + G - 1) / G; const int t0 = vcu * per; const int t1 = (t0 + per) < RL ? (t0 + per) : RL;
            const float bias = INP(18)[l * NE + lane]; const float* LOGITS = P_LOG;
            for (int t = t0 + wave; t < t1; t += 8) {
                const float lg = LOGITS[(size_t)t * NE + lane]; const float s = 1.0f / (1.0f + __expf(-lg)); const float sel = s + bias;
                float v1 = sel; int i1 = lane;
#pragma unroll
                for (int off = 1; off < 8; off <<= 1) { const float ov = shx(v1, off, lane); const int oi = shxi(i1, off, lane); if (ov > v1 || (ov == v1 && oi < i1)) { v1 = ov; i1 = oi; } }
                float v2 = (lane == i1) ? -INFINITY : sel;
#pragma unroll
                for (int off = 1; off < 8; off <<= 1) v2 = fmaxf(v2, shx(v2, off, lane));
                const float gs = v1 + v2; const int g = lane >> 3; int grank = 0;
#pragma unroll
                for (int gg = 0; gg < 8; ++gg) { const float og = __uint_as_float(__builtin_amdgcn_readlane(__float_as_uint(gs), gg * 8)); grank += (og > gs || (og == gs && gg < g)) ? 1 : 0; }
                const bool gsel = grank < 4; const float msel = gsel ? sel : -INFINITY; int rank = 0;
                unsigned long long gm = __ballot(gsel && (lane & 7) == 0);
#pragma unroll 1
                for (int gi = 0; gi < 4; ++gi) { const int gb = __builtin_amdgcn_readfirstlane((int)__builtin_ctzll(gm | (1ull << 63))); gm &= gm - 1ull;
#pragma unroll
                    for (int j = 0; j < 8; ++j) { const int e2 = gb + j; const float ov = __uint_as_float(__builtin_amdgcn_readlane(__float_as_uint(msel), e2)); rank += (ov > msel || (ov == msel && e2 < lane)) ? 1 : 0; } }
                const bool chosen = gsel && rank < 8;
                const float ssum = wave_sum(chosen ? s : 0.f, lane);
                if (chosen) { const int lp = __hip_atomic_fetch_add(lcnt + lane, 1, __ATOMIC_RELAXED, __HIP_MEMORY_SCOPE_WORKGROUP); LAS int* rr = rec + ((t - t0) * 8 + rank) * 3; rr[0] = lane; rr[1] = lp; rr[2] = (int)__float_as_uint(s / ssum * 2.5f); }
            }
            __syncthreads();
            if (tid < 64) lbase[tid] = (int)__hip_atomic_fetch_add(P_GCNT(l) + 256 * rep_ + 512 * grp2_ + tid, (unsigned)lcnt[tid], __ATOMIC_RELAXED, __HIP_MEMORY_SCOPE_AGENT);
            __syncthreads();
            int* TOKL = P_TOKL; int* TPOS = P_TPOS; float* TW = P_TW;
            if (REP_ROUTE > 1 && rep_ > 0) { TOKL = (int*)(wsp + WS_YB + 70 * MiB); TPOS = (int*)(wsp + WS_YB + 80 * MiB); TW = (float*)(wsp + WS_YB + 82 * MiB); }
            for (int i = tid; i < (t1 - t0) * 8; i += 512) { const LAS int* rr = rec + i * 3; const int e = rr[0], pos = lbase[e] + rr[1], t = t0 + (i >> 3);
                TOKL[(size_t)e * RT + pos] = t; TPOS[(size_t)t * 8 + (i & 7)] = (e << 20) | pos; TW[(size_t)t * 8 + (i & 7)] = __uint_as_float((unsigned)rr[2]); }
            __syncthreads();
        }
        SEAM(pb + 9);

#define tstart ((LAS int*)(ldsp + TAB_OFF))
#define ecnt ((LAS int*)(ldsp + TAB_OFF + 288))
#define ulist ((LAS int*)(ldsp + ULIST_OFF))
#define uidx ((LAS int*)(ldsp + IDX_OFF))
        const bool need_tab = (hi > pb + 10) && (lo <= pb + 14);
        if (need_tab) {
            PHASE_BEGIN;
            if (tid < 64) {
                const int c = (int)__hip_atomic_load(P_GCNT(l) + 512 * grp2_ + tid, __ATOMIC_RELAXED, __HIP_MEMORY_SCOPE_AGENT); const int nt_ = (c + 255) >> 8; int inc = nt_;
#pragma unroll
                for (int o = 1; o < 64; o <<= 1) { const int v = __builtin_amdgcn_ds_bpermute(((lane - o) & 63) << 2, inc); if (lane >= o) inc += v; }
                ecnt[tid] = c; tstart[tid] = inc - nt_;
                if (tid == 63) { ecnt[NE] = RL; tstart[NE] = inc; tstart[NEX] = inc + RL / 256; } }
            __syncthreads();
        }
        int ntile = 0; if (need_tab) { PHASE_BEGIN; ntile = tstart[NEX]; }

        if (IN(pb + 10)) for (int rep_ = 0; rep_ < REP_MOE; ++rep_) {
            PHASE_BEGIN;
            const int nunits = ntile * 2; int nu = 0;
            for (int i = 0; ; ++i) { const int u = i * G + vcu; if (u >= nunits || i >= MAXU) break; nu = i + 1; }
            if (tid < nu) { const int u = tid * G + vcu, tile = u >> 1; int e = 0;
_Pragma("unroll 1")
                for (int q = 0; q < NEX; ++q) if (tstart[q] <= tile) e = q;
                ulist[tid * 4 + 0] = e; ulist[tid * 4 + 1] = tile; ulist[tid * 4 + 2] = u & 1; ulist[tid * 4 + 3] = tile - tstart[e]; }
            __syncthreads();
            const int* TOKL = P_TOKL;
            for (int i = 0; i < nu; ++i) { const int e = ulist[i * 4 + 0], rt = ulist[i * 4 + 3], cnt = ecnt[e];
                if (tid < 256) { const int pos = rt * 256 + tid; const int pc = pos < cnt ? pos : cnt - 1; uidx[i * 256 + tid] = e < NE ? TOKL[(size_t)e * RT + pc] : pc; } }
            __syncthreads();
            pg8::MoeSched S{ulist, uidx, nu, (const char*)P_H2F8, (const char*)P_EWGU8, 0, 0};
            pg8::EpiSwiGLU E{P_ACT, 1.0f / 32.0f};
            pg8::gemm_phase<pg8::EpiSwiGLU, pg8::MoeSched, true>(lds, DM, S, E, tid);
        }
        SEAM(pb + 10);

#pragma unroll 1
        for (int qd = 0; qd < 2; ++qd) {
            if (IN(pb + 11 + 2 * qd)) for (int rep_ = 0; rep_ < REP_MOE * REP_DOWN; ++rep_) {
                PHASE_BEGIN;
                const int nunits = ntile * 2; int nu = 0;
                for (int i = 0; ; ++i) { const int u = i * G + vcu; if (u >= nunits || i >= MAXU) break; nu = i + 1; }
                __syncthreads();
                if (tid < nu) { const int u = tid * G + vcu, tile = u >> 1; int e = 0;
_Pragma("unroll 1")
                    for (int q = 0; q < NEX; ++q) if (tstart[q] <= tile) e = q;
                    ulist[tid * 4 + 0] = e; ulist[tid * 4 + 1] = tile; ulist[tid * 4 + 2] = u & 1; ulist[tid * 4 + 3] = tile - tstart[e]; }
                __syncthreads();
                pg8::MoeSched S{ulist, uidx, nu, (const char*)P_ACT, (const char*)P_EWD, 1, qd};
                pg8::EpiFp8 E{(unsigned char*)P_YB, 512, 1.0f / 16.0f};
                pg8::gemm_phase<pg8::EpiFp8, pg8::MoeSched, true>(lds, DE, S, E, tid);
            }
            SEAM(pb + 11 + 2 * qd);
            if (IN(pb + 12 + 2 * qd)) for (int rep_ = 0; rep_ < REP_COMB; ++rep_) {
                PHASE_BEGIN;
                const float* mods = P_MODS + (size_t)l * 3 * 6144; const int* TPOS = P_TPOS; const float* TW = P_TW; const unsigned char* YB8 = (const unsigned char*)P_YB; bf16_t* XS = P_XS;
                const bool fuse = (qd == 1) && (GRP_MOE == 1 || grp2_ + 1 == GRP_MOE) && (REP_COMB == 1);
                for (int ch = gw; ch < RL / 8; ch += NGW) {
                    const int tb = ch * 8; const int vec = tb < SEQ ? 0 : (tb < TL ? 1 : 2);
                    const float* gp = mods + vec * 6144 + 5 * DM + qd * 512 + lane * 8; f32x4 g0 = *(const f32x4*)gp, g1 = *(const f32x4*)(gp + 4);
                    if ((REP_COMB > 1 && rep_ > 0) || (GRP_MOE > 1 && grp2_ + 1 < GRP_MOE)) { g0 = g0 * 0.f; g1 = g1 * 0.f; }
                    f32x4 nm[4], ns[4];
                    { const float zf_ = (float)z_;
#pragma unroll
                      for (int q = 0; q < 4; ++q) { nm[q] = (f32x4){zf_, zf_, zf_, zf_}; ns[q] = nm[q]; } }
                    if (fuse) {
                        if (l == 0) { const float* m1 = P_MODS + (size_t)3 * 6144 + vec * 6144; const float* gmx = INP(6) + DM;
#pragma unroll
                            for (int q = 0; q < 4; ++q) { const int col = (q >> 1) * 512 + lane * 8 + (q & 1) * 4; const f32x4 gv = *(const f32x4*)(gmx + col), s1 = *(const f32x4*)(m1 + DM + col); nm[q] = gv * (s1 + 1.0f); ns[q] = *(const f32x4*)(m1 + col); } }
                        else { const float* gf = INP(25);
#pragma unroll
                            for (int q = 0; q < 4; ++q) { const int col = (q >> 1) * 512 + lane * 8 + (q & 1) * 4; nm[q] = *(const f32x4*)(gf + col); ns[q] = nm[q] * 0.f; } }
                    }
#pragma unroll 2
                    for (int t = tb; t < tb + 8; ++t) {
                        int tp = 0; float tw = 0.f; if (lane < 8) { tp = TPOS[(size_t)t * 8 + lane]; tw = TW[(size_t)t * 8 + lane]; }
                        u32x2 v[9];
#pragma unroll
                        for (int k = 0; k < 8; ++k) { const int tpk = __builtin_amdgcn_readlane(tp, k); const int slot = tstart[tpk >> 20] * 256 + (tpk & 0xfffff); v[k] = __builtin_nontemporal_load((const u32x2*)(YB8 + (size_t)slot * 512 + lane * 8)); }
                        v[8] = __builtin_nontemporal_load((const u32x2*)(YB8 + (size_t)(tstart[NE] * 256 + t) * 512 + lane * 8));
                        u32x4* xp = (u32x4*)(XS + (size_t)t * DM + qd * 512 + lane * 8); const u32x4 xw = *xp;
                        f32x4 x0 = {bf_lo(xw.x), bf_hi(xw.x), bf_lo(xw.y), bf_hi(xw.y)}, x1 = {bf_lo(xw.z), bf_hi(xw.z), bf_lo(xw.w), bf_hi(xw.w)};
                        f32x4 y0 = x0, y1 = x1; if (fuse) { const u32x4 yw = *(const u32x4*)(XS + (size_t)t * DM + lane * 8); y0 = (f32x4){bf_lo(yw.x), bf_hi(yw.x), bf_lo(yw.y), bf_hi(yw.y)}; y1 = (f32x4){bf_lo(yw.z), bf_hi(yw.z), bf_lo(yw.w), bf_hi(yw.w)}; }
                        float a[8];
#pragma unroll
                        for (int j = 0; j < 8; ++j) a[j] = 0.f;
#pragma unroll
                        for (int k = 0; k < 9; ++k) { const float w = k < 8 ? __uint_as_float(__builtin_amdgcn_readlane(__float_as_uint(tw), k < 8 ? k : 0)) : 1.0f;
                            a[0] += w * __builtin_amdgcn_cvt_f32_fp8((int)v[k].x, 0); a[1] += w * __builtin_amdgcn_cvt_f32_fp8((int)v[k].x, 1); a[2] += w * __builtin_amdgcn_cvt_f32_fp8((int)v[k].x, 2); a[3] += w * __builtin_amdgcn_cvt_f32_fp8((int)v[k].x, 3);
                            a[4] += w * __builtin_amdgcn_cvt_f32_fp8((int)v[k].y, 0); a[5] += w * __builtin_amdgcn_cvt_f32_fp8((int)v[k].y, 1); a[6] += w * __builtin_amdgcn_cvt_f32_fp8((int)v[k].y, 2); a[7] += w * __builtin_amdgcn_cvt_f32_fp8((int)v[k].y, 3); }
                        x0.x += g0.x * a[0]; x0.y += g0.y * a[1]; x0.z += g0.z * a[2]; x0.w += g0.w * a[3]; x1.x += g1.x * a[4]; x1.y += g1.y * a[5]; x1.z += g1.z * a[6]; x1.w += g1.w * a[7];
                        if (!(fuse && l == 1)) { u32x4 ow; ow.x = cvt_pk_bf16(x0.x, x0.y); ow.y = cvt_pk_bf16(x0.z, x0.w); ow.z = cvt_pk_bf16(x1.x, x1.y); ow.w = cvt_pk_bf16(x1.z, x1.w); *xp = ow; }
                        if (fuse) {
                            float s = (x0.x * x0.x + x0.y * x0.y) + (x0.z * x0.z + x0.w * x0.w) + (x1.x * x1.x + x1.y * x1.y) + (x1.z * x1.z + x1.w * x1.w)
                                    + (y0.x * y0.x + y0.y * y0.y) + (y0.z * y0.z + y0.w * y0.w) + (y1.x * y1.x + y1.y * y1.y) + (y1.z * y1.z + y1.w * y1.w);
                            const float rstd = rsqrtf(wave_sum(s, lane) * (1.0f / DM) + EPS);
                            const f32x4 o0 = y0 * rstd * nm[0] + ns[0], o1 = y1 * rstd * nm[1] + ns[1], o2 = x0 * rstd * nm[2] + ns[2], o3 = x1 * rstd * nm[3] + ns[3];
                            if (l == 1) { f32x4* op = (f32x4*)(P.out + (size_t)t * DM + lane * 8); __builtin_nontemporal_store(o0, op); __builtin_nontemporal_store(o1, op + 1); __builtin_nontemporal_store(o2, op + 128); __builtin_nontemporal_store(o3, op + 129); }
                            else { u32x4 w0, w1; w0.x = cvt_pk_bf16(o0.x, o0.y); w0.y = cvt_pk_bf16(o0.z, o0.w); w0.z = cvt_pk_bf16(o1.x, o1.y); w0.w = cvt_pk_bf16(o1.z, o1.w);
                                w1.x = cvt_pk_bf16(o2.x, o2.y); w1.y = cvt_pk_bf16(o2.z, o2.w); w1.z = cvt_pk_bf16(o3.x, o3.y); w1.w = cvt_pk_bf16(o3.z, o3.w);
                                bf16_t* hp = P_HQ + (size_t)t * DM + lane * 8; *(u32x4*)hp = w0; *(u32x4*)(hp + 512) = w1; }
                        }
                    }
                }
            }
            if (!(l == 1 && qd == 1) || SELFCHECK || REP_COMB > 1 || GRP_MOE > 1) SEAM(pb + 12 + 2 * qd);
        }
        }
    }

    if (IN(NPHASE - 1)) for (int rep_ = 0; rep_ < REP_PRO; ++rep_) {
        PHASE_BEGIN;
#if SELFCHECK
        const unsigned chk_code = __hip_atomic_load((unsigned*)(wsp + WS_CTL) + CW_CHK, __ATOMIC_RELAXED, __HIP_MEMORY_SCOPE_AGENT);
#endif
        const float* gf = INP(25); f32x4 gm[4]; const bf16_t* XS = P_XS;
#pragma unroll
        for (int j = 0; j < 4; ++j) gm[j] = *(const f32x4*)(gf + 4 * lane + 256 * j);
        for (int r = gw; r < ((REP_COMB > 1) ? TL : (SELFCHECK ? 1 : 0)); r += NGW) {
            const u32x2* xr = (const u32x2*)(XS + (size_t)r * DM) + lane; f32x4 v[4]; float s = 0.f;
#pragma unroll
            for (int j = 0; j < 4; ++j) { const u32x2 a = xr[64 * j]; v[j] = (f32x4){bf_lo(a.x), bf_hi(a.x), bf_lo(a.y), bf_hi(a.y)}; s += (v[j].x * v[j].x + v[j].y * v[j].y) + (v[j].z * v[j].z + v[j].w * v[j].w); }
            const float rstd = rsqrtf(wave_sum(s, lane) * (1.0f / DM) + EPS);
            f32x4* o = (f32x4*)(P.out + (size_t)r * DM) + lane;
#pragma unroll
            for (int j = 0; j < 4; ++j) if (!SELFCHECK) o[64 * j] = v[j] * rstd * gm[j];
#if SELFCHECK
            if (r == 0 && lane == 0) { const unsigned w1 = __hip_atomic_load((unsigned*)(wsp + WS_CTL) + CW_CHK + 1 + SELFCHECK_REPORT, __ATOMIC_RELAXED, __HIP_MEMORY_SCOPE_AGENT); P.out[0] = (float)w1; (void)chk_code; }
#endif
        }
    }
#undef IN
#undef SEAM
#undef tstart
#undef ecnt
#undef ulist
#undef uidx
}

extern "C" void kernel_launch(void* const* d_in, const int* in_sizes, int n_in, void* d_out, int out_size, void* d_ws, size_t ws_size, hipStream_t stream) {
    static int grid = 0;
    if (grid == 0) {
        if (n_in != 26 || out_size != TL * DM || ws_size < WS_END) { fprintf(stderr, "kernel_launch: unexpected problem: n_in %d out %d ws %zu (need %zu)\n", n_in, out_size, ws_size, (size_t)WS_END); grid = -1; return; }
        int dev = 0, cus = 0, per_cu = 0;
        if (hipGetDevice(&dev) != hipSuccess || hipDeviceGetAttribute(&cus, hipDeviceAttributeMultiprocessorCount, dev) != hipSuccess) { grid = -1; return; }
        if (hipFuncSetAttribute((const void*)mk_fwd, hipFuncAttributeMaxDynamicSharedMemorySize, LDS_BYTES) != hipSuccess) { fprintf(stderr, "kernel_launch: hipFuncSetAttribute failed\n"); grid = -1; return; }
        if (hipOccupancyMaxActiveBlocksPerMultiprocessor(&per_cu, (const void*)mk_fwd, 512, LDS_BYTES) != hipSuccess || per_cu < 1) { fprintf(stderr, "kernel_launch: occupancy query says %d\n", per_cu); (void)hipGetLastError(); }
        grid = cus;
    }
    if (grid < 0) return;
    (void)hipMemsetAsync((char*)d_ws + WS_CTL, 0, CTL_ZERO_BYTES, stream);
    Params p{};
    for (int i = 0; i < 26; ++i) p.in[i] = (const float*)d_in[i];
    p.out = (float*)d_out; p.ws = (unsigned char*)d_ws; p.pad = 0;
#if MK_N_LAUNCHES == 1
    p.ph_lo = 0; p.ph_hi = NPHASE; p.use_bar = 1;
    hipLaunchKernelGGL(mk_fwd, dim3(grid), dim3(512), LDS_BYTES, stream, p);
#else
    for (int ph = 0; ph < NPHASE; ++ph) { p.ph_lo = ph; p.ph_hi = ph + 1; p.use_bar = 0; hipLaunchKernelGGL(mk_fwd, dim3(grid), dim3(512), LDS_BYTES, stream, p); }
#endif
}
```

```cpp
#include <hip/hip_runtime.h>
#include <cstdio>
#include <cstdint>
#include <cmath>

#ifndef MK_N_LAUNCHES
#define MK_N_LAUNCHES 1
#endif

#ifndef REP_NORM
#define REP_NORM 1
#endif
#ifndef REP_DENSE
#define REP_DENSE 1
#endif
#ifndef REP_ROWS
#define REP_ROWS 1
#endif
#ifndef REP_MOE
#define REP_MOE 1
#endif
#ifndef REP_FFT
#define REP_FFT 1
#endif
#ifndef REP_PRO
#define REP_PRO 1
#endif
#ifndef REP_COMB
#define REP_COMB 1
#endif
#ifndef REP_OUT
#define REP_OUT 1
#endif
#ifndef REP_BAR
#define REP_BAR 1
#endif
#ifndef REP_ATT
#define REP_ATT 1
#endif
#ifndef ATT_VAR
#define ATT_VAR 0
#endif
#ifndef REP_P7
#define REP_P7 1
#endif
#ifndef REP_DOWN
#define REP_DOWN 1
#endif
#ifndef REP_VT
#define REP_VT 1
#endif
#ifndef GRP_MIX
#define GRP_MIX 1
#endif
#ifndef GRP_MOE
#define GRP_MOE 1
#endif
#ifndef REP_ROUTE
#define REP_ROUTE 1
#endif
#define LAS __attribute__((address_space(3)))
#define GAS __attribute__((address_space(1)))
typedef unsigned short bf16_t;
typedef short bf16x8 __attribute__((ext_vector_type(8)));
typedef short s16x4 __attribute__((ext_vector_type(4)));
typedef float f32x4 __attribute__((ext_vector_type(4)));
typedef float f32x2 __attribute__((ext_vector_type(2)));
typedef float f32x16 __attribute__((ext_vector_type(16)));
typedef unsigned u32x4 __attribute__((ext_vector_type(4)));
typedef unsigned u32x2 __attribute__((ext_vector_type(2)));

constexpr int DM = 1024, NB = 2, SEQ = 16384, CTXL = 256, TL = NB * SEQ, TC = NB * CTXL, RT = TL + TC;
constexpr int NINP = 1280;
constexpr int NH = 8, DQK = 96, DV = 64, LK = SEQ + CTXL;
constexpr int NE = 64, DE = 256, NEX = NE + 1;
constexpr int COL_FNO = 256, COL_Q = 512, COL_KV = 896, COL_KR = 1152;
constexpr float EPS = 1e-6f;
constexpr int NSLOT_MAX = 282624 + RT;
constexpr int MAXU = 12;

constexpr size_t MiB = 1u << 20;
constexpr size_t WS_CTL = 0, CTL_ZERO_BYTES = 65536;
constexpr size_t WS_MODS = 65536;
constexpr size_t WS_DW = 1 * MiB, DW_LAYER = 7 * MiB;
constexpr size_t DW_WIN = 0, DW_WUQ = 2560 * 1024, DW_WUKV = 3200 * 1024, DW_WCOMB = 3712 * 1024, DW_WR = 6272 * 1024;
constexpr size_t WS_F1 = 15 * MiB, WS_F2 = WS_F1 + 65536, WS_FC = WS_F2 + 131072, WS_WCS = WS_FC + 262144;
constexpr size_t WS_PB = WS_WCS + 262144;
constexpr size_t WS_XS = 17 * MiB;
constexpr size_t WS_X0 = 147 * MiB;
constexpr size_t WS_HQ = WS_X0;
constexpr size_t WS_U = WS_X0 + 65 * MiB;
constexpr size_t WS_KB = WS_U + 83200 * 1024;
constexpr size_t WS_VB = WS_KB + 49920 * 1024;
constexpr size_t WS_YA = WS_VB + 33280 * 1024;
constexpr size_t WS_YP = WS_YA + 83200 * 1024;
constexpr size_t WS_VT8 = WS_YP + 32 * MiB;
constexpr size_t WS_MIX_END = WS_VT8 + (size_t)16 * 260 * 4096;
constexpr size_t WS_EW = WS_X0;
constexpr size_t EW_GU_BYTES = (size_t)NEX * 512 * 1024 * 2, EW_D_BYTES = (size_t)NEX * 1024 * 256 * 2;
constexpr size_t WS_ACT = WS_EW + EW_GU_BYTES + EW_D_BYTES;
constexpr size_t WS_TOKL = WS_ACT + (size_t)NSLOT_MAX * 512;
constexpr size_t WS_TPOS = WS_TOKL + (size_t)NE * RT * 4;
constexpr size_t WS_TW = WS_TPOS + (size_t)RT * 32;
constexpr size_t WS_LOG = WS_TW + (size_t)RT * 32;
constexpr size_t WS_YB = WS_LOG + (size_t)RT * 256;
constexpr size_t WS_END = WS_YB + (size_t)NSLOT_MAX * 512;
static_assert(WS_MIX_END <= 590 * MiB && WS_END <= 590 * MiB, "workspace map must fit the guaranteed 590 MiB");
static_assert(WS_PB + 24576 <= WS_XS && WS_DW + 2 * DW_LAYER <= WS_F1 && DW_WR + 768 * 1024 <= DW_LAYER, "dense weight map");
static_assert((size_t)RT * 2048 <= (size_t)NSLOT_MAX * 512, "H2 fits in the head of YB");
constexpr int CW_TMO = 0, CW_BAR = 1024, CW_CNT = 8192;

constexpr int LDS_WORK = 131072, IDX_OFF = LDS_WORK, ULIST_OFF = IDX_OFF + MAXU * 1024, TAB_OFF = ULIST_OFF + 512, MISC_OFF = TAB_OFF + 1024, VOC_OFF = MISC_OFF + 512, LDS_BYTES = VOC_OFF + 16384;
static_assert(LDS_BYTES <= 163840, "LDS");

__device__ __forceinline__ unsigned cvt_pk_bf16(float lo, float hi) { unsigned r; asm volatile("v_cvt_pk_bf16_f32 %0, %1, %2" : "=v"(r) : "v"(lo), "v"(hi)); return r; }
__device__ __forceinline__ float bf_lo(unsigned w) { return __uint_as_float(w << 16); }
__device__ __forceinline__ float bf_hi(unsigned w) { return __uint_as_float(w & 0xffff0000u); }
__device__ __forceinline__ float shx(float v, int o, int lane) { return __int_as_float(__builtin_amdgcn_ds_bpermute((lane ^ o) << 2, __float_as_int(v))); }
__device__ __forceinline__ int shxi(int v, int o, int lane) { return __builtin_amdgcn_ds_bpermute((lane ^ o) << 2, v); }
__device__ __forceinline__ float wave_sum(float v, int lane) {
#pragma unroll
    for (int o = 1; o < 32; o <<= 1) v += shx(v, o, lane);
    { auto rr = __builtin_amdgcn_permlane32_swap(__float_as_uint(v), __float_as_uint(v), false, false); v = __uint_as_float(rr[0]) + __uint_as_float(rr[1]); }
    return v;
}
__device__ __forceinline__ float silu_f(float v) { return v * __builtin_amdgcn_rcpf(1.0f + __builtin_amdgcn_exp2f(v * -1.4426950408889634f)); }
typedef int i32x8 __attribute__((ext_vector_type(8)));
__device__ __forceinline__ unsigned pk4_fp8(float a, float b, float c, float d) { unsigned w = __float_as_uint(a); w = __builtin_amdgcn_cvt_pk_fp8_f32(a, b, w, false); w = __builtin_amdgcn_cvt_pk_fp8_f32(c, d, w, true); return w; }
__device__ __forceinline__ u32x2 bf8_to_fp8(const u32x4 v) { u32x2 w; w.x = pk4_fp8(bf_lo(v.x), bf_hi(v.x), bf_lo(v.y), bf_hi(v.y)); w.y = pk4_fp8(bf_lo(v.z), bf_hi(v.z), bf_lo(v.w), bf_hi(v.w)); return w; }
#define LDS_WAIT() asm volatile("s_waitcnt lgkmcnt(0)" ::: "memory")
#define VM_WAIT() asm volatile("s_waitcnt vmcnt(0)" ::: "memory")

#define XB_TMO      128
#define XB_XCNT(j)  (256  + 64 * (j))
#define XB_XSUB(j)  (1280 + 64 * (j))
#define XB_XGEN(j)  (2304 + 64 * (j))
#define XB_TOP      3328
#define XB_TOPGEN   3392
#define XCD_BAR_WORDS 3456
#define XB_SPIN_CAP (1u << 22)
__device__ __forceinline__ unsigned xb_ld(unsigned* p)              { return __hip_atomic_load(p, __ATOMIC_RELAXED, __HIP_MEMORY_SCOPE_AGENT); }
__device__ __forceinline__ unsigned xb_add(unsigned* p, unsigned v) { return __hip_atomic_fetch_add(p, v, __ATOMIC_RELAXED, __HIP_MEMORY_SCOPE_AGENT); }
__device__ __forceinline__ unsigned xb_xcc_id() { return (unsigned)__builtin_amdgcn_s_getreg((3 << 11) | 20) & 0xFu; }
#define XB_SPIN(cond, bar) do { unsigned _sp = 0; while (cond) { __builtin_amdgcn_s_sleep(1); \
    if ((++_sp & 255u) == 0u) { if (xb_ld(&(bar)[XB_TMO])) break; if (_sp > XB_SPIN_CAP) { atomicAdd(&(bar)[XB_TMO], 1u); break; } } } } while (0)
struct XcdBarrier { unsigned* bar; unsigned x; volatile LAS unsigned* st; };
__device__ __forceinline__ XcdBarrier xcd_barrier_post(unsigned* bar, volatile LAS unsigned* st) {
    XcdBarrier b; b.bar = bar; b.x = xb_xcc_id(); b.st = st;
    if (threadIdx.x == 0) (void)xb_add(&bar[XB_XCNT(b.x)], 1u);
    return b;
}
__device__ __forceinline__ void xcd_barrier_complete(unsigned* bar, unsigned x, unsigned& nloc, unsigned& nx) {
    const unsigned G = gridDim.x * gridDim.y * gridDim.z;
    unsigned sum, cnt, mine, sp = 0u;
    for (;;) {
        sum = 0u; cnt = 0u; mine = 0u;
#pragma unroll
        for (unsigned j = 0; j < 16; ++j) { const unsigned c = xb_ld(&bar[XB_XCNT(j)]); sum += c; cnt += (c > 0u) ? 1u : 0u; mine = (j == x) ? c : mine; }
        if (sum == G) break;
        __builtin_amdgcn_s_sleep(1);
        if ((++sp & 255u) == 0u) { if (xb_ld(&bar[XB_TMO])) break; if (sp > XB_SPIN_CAP) { atomicAdd(&bar[XB_TMO], 1u); break; } }
    }
    nloc = mine > 0u ? mine : 1u; nx = cnt > 0u ? cnt : 1u;
}
__device__ __forceinline__ void xcd_barrier(const XcdBarrier& b, const int tid0) {
    asm volatile("s_waitcnt vmcnt(0)" ::: "memory");
    __syncthreads();
    if (tid0 == 0) {
        unsigned* bar = b.bar;
        __builtin_amdgcn_s_waitcnt(0);
        unsigned nloc = b.st[0], nx = b.st[1];
        if (nloc == 0u) { xcd_barrier_complete(bar, b.x, nloc, nx); b.st[0] = nloc; b.st[1] = nx; }
        const unsigned old = xb_add(&bar[XB_XSUB(b.x)], 1u);
        const unsigned gen = old / nloc;
        if (old + 1u == (gen + 1u) * nloc) {
            __builtin_amdgcn_fence(__ATOMIC_RELEASE, "agent");
            asm volatile("s_waitcnt vmcnt(0)" ::: "memory");
            const unsigned og = xb_add(&bar[XB_TOP], 1u);
            const unsigned tg = og / nx;
            if (og + 1u == (tg + 1u) * nx) xb_add(&bar[XB_TOPGEN], 1u);
            else XB_SPIN(xb_ld(&bar[XB_TOPGEN]) == tg, bar);
            __builtin_amdgcn_fence(__ATOMIC_ACQUIRE, "agent");
            xb_add(&bar[XB_XGEN(b.x)], 1u);
            asm volatile("s_waitcnt vmcnt(0)" ::: "memory");
        } else {
            XB_SPIN(xb_ld(&bar[XB_XGEN(b.x)]) == gen, bar);
            __builtin_amdgcn_fence(__ATOMIC_ACQUIRE, "agent");
            asm volatile("s_waitcnt vmcnt(0)" ::: "memory");
        }
    }
    __syncthreads();
}

namespace pg8 {
constexpr int BM = 256, BK = 64, HALF = 128, HTB = HALF * BK * 2, STAGE_BYTES = 8 * HTB, NXCD = 8, WGM = 8;
__device__ __forceinline__ int lds_byte(int r, int c) { const int st = (r >> 4) * 2 + (c >> 5), rr = r & 15, cc = c & 31, ob = rr * 64 + cc * 2; return st * 1024 + (ob ^ (((ob >> 9) & 1) << 5)); }
__device__ __forceinline__ void stage_rc(int b, int& R, int& C) { const int st = b / 1024, sb = b % 1024, swz = sb ^ (((sb >> 9) & 1) << 5); R = (st >> 1) * 16 + swz / 64; C = (st & 1) * 32 + (swz % 64) / 2; }
__device__ __forceinline__ int perm32(int rho) { const int n = rho >> 4, i = rho & 15; return 8 * (i >> 2) + 4 * n + (i & 3); }
struct Unit { int pm, pn, e, aux; };

template <class Epi, class Sched, bool F8 = false>
__device__ __forceinline__ void gemm_phase(LAS unsigned char* lds, const int K, const Sched& S, const Epi& E, const int tid) {
    const int wid = __builtin_amdgcn_readfirstlane(tid >> 6), lane = tid & 63, wr = wid >> 2, wc = wid & 3, fr = lane & 15, fq = lane >> 4;
    const int nt = F8 ? K / 128 : K / BK;
    int Rr[2], Cc[2]; unsigned voffB[2]; const unsigned vstepB = F8 ? (unsigned)(64 * K) : (unsigned)(64 * K) * 2u;
#pragma unroll
    for (int i = 0; i < 2; ++i) { int R, C; stage_rc(tid * 16 + i * 8192, R, C); const int Rb = Epi::PERM ? ((R & ~31) + perm32(R & 31)) : R; Rr[i] = R; Cc[i] = C; voffB[i] = F8 ? (unsigned)(Rb * K + 2 * C) : (unsigned)(Rb * K + C) * 2u; }
    const size_t kstep = (size_t)(BK * 2);
    const size_t hstep = F8 ? (size_t)HALF * K : (size_t)HALF * K * 2;
    const unsigned ldsw = (unsigned)wid * 1024u;
    const int aoff = lds_byte(wr * 64 + fr, fq * 8), boff = lds_byte(wc * 32 + fr, fq * 8);
    const int f8in = (fq >> 1) * 1024 + ((fr * 64 + 32 * (fq & 1)) ^ ((fr >> 3) << 5)); const int aoff8 = 8 * wr * 1024 + f8in; const int bdiff8 = (4 * wc - 8 * wr) * 1024;
#define PG8_SA(b, h) (((b) * 2 + (h)) * HTB)
#define PG8_SB(b, h) ((4 + (b) * 2 + (h)) * HTB)
#define PG8_STAGE(bufoff, gbase, voff) do { _Pragma("unroll") for (int _i = 0; _i < 2; ++_i) { unsigned vo_ = (voff)[0] + (unsigned)_i * vstepB; asm volatile("" : "+v"(vo_));         \
        __builtin_amdgcn_global_load_lds((const unsigned*)((const char*)(gbase) + vo_), (LAS unsigned*)(lds + (bufoff) + ldsw + _i * 8192), 16, 0, 0); } } while (0)
#define PG8_STAGEA(bufoff, o0, o1) do { \
        __builtin_amdgcn_global_load_lds((const unsigned*)(aB + (size_t)(o0)), (LAS unsigned*)(lds + (bufoff) + ldsw), 16, 0, 0); \
        __builtin_amdgcn_global_load_lds((const unsigned*)(aB + (size_t)(o1)), (LAS unsigned*)(lds + (bufoff) + ldsw + 8192), 16, 0, 0); } while (0)
#define PG8_LDA(dst, b, h) do { if constexpr (F8) { _Pragma("unroll") for (int m = 0; m < 4; ++m) { typedef int i32x4_ __attribute__((ext_vector_type(4))); const i32x4_ x_ = *(const LAS i32x4_*)(lds + PG8_SA(b, h) + aoff8 + m * 2048), y_ = *(const LAS i32x4_*)(lds + PG8_SA(b, h) + aoff8 + m * 2048 + 16); \
            dst##8[m] = __builtin_shufflevector(x_, y_, 0, 1, 2, 3, 4, 5, 6, 7); } } \
        else { _Pragma("unroll") for (int m = 0; m < 4; ++m) _Pragma("unroll") for (int k = 0; k < 2; ++k) dst[m][k] = *(const LAS bf16x8*)(lds + PG8_SA(b, h) + aoff + m * 2048 + k * 1024); } } while (0)
#define PG8_LDB(dst, b, h) do { if constexpr (F8) { int boff8 = aoff8 + bdiff8; asm volatile("" : "+v"(boff8)); _Pragma("unroll") for (int n = 0; n < 2; ++n) { typedef int i32x4_ __attribute__((ext_vector_type(4))); const i32x4_ x_ = *(const LAS i32x4_*)(lds + PG8_SB(b, h) + boff8 + n * 2048), y_ = *(const LAS i32x4_*)(lds + PG8_SB(b, h) + boff8 + n * 2048 + 16); \
            dst##8[n] = __builtin_shufflevector(x_, y_, 0, 1, 2, 3, 4, 5, 6, 7); } } \
        else { _Pragma("unroll") for (int n = 0; n < 2; ++n) _Pragma("unroll") for (int k = 0; k < 2; ++k) dst[n][k] = *(const LAS bf16x8*)(lds + PG8_SB(b, h) + boff + n * 2048 + k * 1024); } } while (0)
#define PG8_MMA(ai, bj, At, Bt) do { __builtin_amdgcn_s_setprio(1); if constexpr (F8) { _Pragma("unroll") for (int m = 0; m < 4; ++m) _Pragma("unroll") for (int n = 0; n < 2; ++n) \
            acc[ai][bj][m][n] = __builtin_amdgcn_mfma_scale_f32_16x16x128_f8f6f4(Bt##8[n], At##8[m], acc[ai][bj][m][n], 0, 0, 0, 0, 0, 0); } \
        else if constexpr (Epi::SWAPV) { _Pragma("unroll") for (int m = 0; m < 4; ++m) _Pragma("unroll") for (int n = 0; n < 2; ++n) _Pragma("unroll") for (int k = 0; k < 2; ++k) \
            acc[ai][bj][m][n] = __builtin_amdgcn_mfma_f32_16x16x32_bf16(At[m][k], Bt[n][k], acc[ai][bj][m][n], 0, 0, 0); }     \
        else { _Pragma("unroll") for (int m = 0; m < 4; ++m) _Pragma("unroll") for (int n = 0; n < 2; ++n) _Pragma("unroll") for (int k = 0; k < 2; ++k) \
            acc[ai][bj][m][n] = __builtin_amdgcn_mfma_f32_16x16x32_bf16(Bt[n][k], At[m][k], acc[ai][bj][m][n], 0, 0, 0); } __builtin_amdgcn_s_setprio(0); } while (0)
#define PG8_WAIT_V(n) asm volatile("s_waitcnt vmcnt(" #n ")" ::: "memory")
#define PG8_WAIT_L(n) asm volatile("s_waitcnt lgkmcnt(" #n ")" ::: "memory")
#define PG8_BAR __builtin_amdgcn_s_barrier()
#define PG8_SCHED __builtin_amdgcn_sched_barrier(0)
    Unit cur, nxt; int ui = 0;
    if (!S.next(0, cur)) return;
    f32x4 acc[2][2][4][2];
#pragma unroll
    for (int a = 0; a < 2; ++a)
#pragma unroll
        for (int b = 0; b < 2; ++b)
#pragma unroll
            for (int m = 0; m < 4; ++m)
#pragma unroll
                for (int n = 0; n < 2; ++n) acc[a][b][m][n] = (f32x4){0.f, 0.f, 0.f, 0.f};
    bf16x8 At[4][2], B0[2][2], B1[2][2]; i32x8 At8[4], B08[2], B18[2];
    unsigned voc[2][2];
    S.a_off(cur, Rr, Cc, voc);
    const int vso = VOC_OFF + wid * 2048 - 8 * wr * 1024; int csel = 0;
    if constexpr (F8) *(LAS u32x4*)(lds + vso + aoff8) = (u32x4){voc[0][0], voc[0][1], voc[1][0], voc[1][1]};
#define PG8_RDV(sel, h) (*(const LAS u32x2*)(lds + vso + aoff8 + (sel) + (h) * 8))
    const char* const aB = S.a_base();
    const char* cB = S.b_base(cur);
    PG8_STAGE(PG8_SB(0, 0), cB, voffB); PG8_STAGE(PG8_SB(0, 1), cB + hstep, voffB); PG8_STAGEA(PG8_SA(0, 0), voc[0][0], voc[0][1]); PG8_STAGEA(PG8_SA(0, 1), voc[1][0], voc[1][1]);
    if (wr == 1) PG8_BAR;
    PG8_WAIT_V(2); PG8_BAR;
    PG8_STAGE(PG8_SB(1, 0), cB + kstep, voffB); PG8_STAGEA(PG8_SA(1, 0), voc[0][0] + 128u, voc[0][1] + 128u); PG8_STAGE(PG8_SB(1, 1), cB + hstep + kstep, voffB);
    PG8_WAIT_V(6); PG8_BAR;
    for (;;) {
        const bool has_next = S.next(ui + 1, nxt);
        const char* nB = has_next ? S.b_base(nxt) : cB;
#pragma unroll 1
        for (int t = 0; t < nt; t += 2) {
            const bool last = (t == nt - 2);
            const unsigned k1b = (unsigned)(t + 1) * 128u, k2b = last ? 0u : (unsigned)(t + 2) * 128u;
            const char* b2 = last ? nB : cB + (size_t)(t + 2) * kstep; const char* b3 = b2 + kstep;
            if constexpr (F8) {
                int tl0_; asm volatile("v_mbcnt_lo_u32_b32 %0, -1, 0\n\tv_mbcnt_hi_u32_b32 %0, -1, %0" : "=v"(tl0_));
                const int fr0_ = tl0_ & 15, fq0_ = tl0_ >> 4; const int aoff8 = 8 * wr * 1024 + (fq0_ >> 1) * 1024 + ((fr0_ * 64 + 32 * (fq0_ & 1)) ^ ((fr0_ >> 3) << 5));
                const bool sw = last && has_next; const int nsel = sw ? (csel ^ 16) : csel;
                if (sw) {
                    unsigned vn[2][2]; int tl_; asm volatile("v_mbcnt_lo_u32_b32 %0, -1, 0\n\tv_mbcnt_hi_u32_b32 %0, -1, %0" : "=v"(tl_)); tl_ += wid * 64; int R2[2], C2[2];
#pragma unroll
                    for (int i = 0; i < 2; ++i) stage_rc(tl_ * 16 + i * 8192, R2[i], C2[i]);
                    S.a_off(nxt, R2, C2, vn); *(LAS u32x4*)(lds + vso + aoff8 + nsel) = (u32x4){vn[0][0], vn[0][1], vn[1][0], vn[1][1]};
                }
                { const u32x2 o_ = PG8_RDV(csel, 1);
                  PG8_LDB(B0, 0, 0); PG8_LDB(B1, 0, 1); PG8_SCHED; PG8_LDA(At, 0, 0); PG8_STAGEA(PG8_SA(1, 1), o_.x + k1b, o_.y + k1b); }
                PG8_WAIT_V(8); PG8_WAIT_L(0); PG8_BAR; PG8_MMA(0, 0, At, B0); PG8_MMA(0, 1, At, B1); PG8_BAR; PG8_SCHED;
                { const u32x2 o_ = PG8_RDV(nsel, 0);
                  PG8_LDA(At, 0, 1); PG8_STAGE(PG8_SB(0, 0), b2, voffB); PG8_STAGE(PG8_SB(0, 1), b2 + hstep, voffB); PG8_STAGEA(PG8_SA(0, 0), o_.x + k2b, o_.y + k2b); }
                PG8_WAIT_V(8); PG8_WAIT_L(0); PG8_BAR; PG8_MMA(1, 0, At, B0); PG8_MMA(1, 1, At, B1); PG8_BAR; PG8_SCHED;
                { const u32x2 o_ = PG8_RDV(nsel, 1);
                  PG8_LDB(B0, 1, 0); PG8_LDB(B1, 1, 1); PG8_SCHED; PG8_LDA(At, 1, 0); PG8_STAGEA(PG8_SA(0, 1), o_.x + k2b, o_.y + k2b); }
                PG8_WAIT_V(8); PG8_WAIT_L(0); PG8_BAR; PG8_MMA(0, 0, At, B0); PG8_MMA(0, 1, At, B1); PG8_BAR; PG8_SCHED;
                { const u32x2 o_ = PG8_RDV(nsel, 0);
                  PG8_LDA(At, 1, 1); PG8_STAGE(PG8_SB(1, 0), b3, voffB); PG8_STAGE(PG8_SB(1, 1), b3 + hstep, voffB); PG8_STAGEA(PG8_SA(1, 0), o_.x + (k2b + 128u), o_.y + (k2b + 128u)); }
                PG8_WAIT_V(8); PG8_WAIT_L(0); PG8_BAR; PG8_MMA(1, 0, At, B0); PG8_MMA(1, 1, At, B1); PG8_BAR; PG8_SCHED;
            } else {
            unsigned s00 = voc[0][0] + k2b, s01 = voc[0][1] + k2b, s10 = voc[1][0] + k2b, s11 = voc[1][1] + k2b;
            if (last && has_next) {
                unsigned vn[2][2]; int tl_; asm volatile("v_mbcnt_lo_u32_b32 %0, -1, 0\n\tv_mbcnt_hi_u32_b32 %0, -1, %0" : "=v"(tl_)); tl_ += wid * 64; int R2[2], C2[2];
#pragma unroll
                for (int i = 0; i < 2; ++i) stage_rc(tl_ * 16 + i * 8192, R2[i], C2[i]);
                S.a_off(nxt, R2, C2, vn); s00 = vn[0][0]; s01 = vn[0][1]; s10 = vn[1][0]; s11 = vn[1][1];
            }
            PG8_LDB(B0, 0, 0); PG8_LDB(B1, 0, 1); PG8_SCHED; PG8_LDA(At, 0, 0); PG8_STAGEA(PG8_SA(1, 1), voc[1][0] + k1b, voc[1][1] + k1b);
            PG8_WAIT_V(8); PG8_WAIT_L(0); PG8_BAR; PG8_MMA(0, 0, At, B0); PG8_MMA(0, 1, At, B1); PG8_BAR; PG8_SCHED;
            PG8_LDA(At, 0, 1); PG8_STAGE(PG8_SB(0, 0), b2, voffB); PG8_STAGE(PG8_SB(0, 1), b2 + hstep, voffB); PG8_STAGEA(PG8_SA(0, 0), s00, s01);
            PG8_WAIT_V(8); PG8_WAIT_L(0); PG8_BAR; PG8_MMA(1, 0, At, B0); PG8_MMA(1, 1, At, B1); PG8_BAR; PG8_SCHED;
            PG8_LDB(B0, 1, 0); PG8_LDB(B1, 1, 1); PG8_SCHED; PG8_LDA(At, 1, 0); PG8_STAGEA(PG8_SA(0, 1), s10, s11);
            PG8_WAIT_V(8); PG8_WAIT_L(0); PG8_BAR; PG8_MMA(0, 0, At, B0); PG8_MMA(0, 1, At, B1); PG8_BAR; PG8_SCHED;
            PG8_LDA(At, 1, 1); PG8_STAGE(PG8_SB(1, 0), b3, voffB); PG8_STAGE(PG8_SB(1, 1), b3 + hstep, voffB); PG8_STAGEA(PG8_SA(1, 0), s00 + 128u, s01 + 128u);
            PG8_WAIT_V(8); PG8_WAIT_L(0); PG8_BAR; PG8_MMA(1, 0, At, B0); PG8_MMA(1, 1, At, B1); PG8_BAR; PG8_SCHED;
            }
        }
        if (wr == 0) PG8_BAR;
        if constexpr (F8) { int tl_; asm volatile("v_mbcnt_lo_u32_b32 %0, -1, 0\n\tv_mbcnt_hi_u32_b32 %0, -1, %0" : "=v"(tl_)); E(acc, cur, wr, wc, tl_ & 15, tl_ >> 4); }
        else E(acc, cur, wr, wc, fr, fq);
        if (!has_next) break;
#pragma unroll
        for (int a = 0; a < 2; ++a)
#pragma unroll
            for (int b = 0; b < 2; ++b)
#pragma unroll
                for (int m = 0; m < 4; ++m)
#pragma unroll
                    for (int n = 0; n < 2; ++n) acc[a][b][m][n] = (f32x4){0.f, 0.f, 0.f, 0.f};
        cur = nxt; cB = nB; ++ui;
        if constexpr (F8) csel ^= 16;
        else { int tl_; asm volatile("v_mbcnt_lo_u32_b32 %0, -1, 0\n\tv_mbcnt_hi_u32_b32 %0, -1, %0" : "=v"(tl_)); tl_ += wid * 64; int R2[2], C2[2];
#pragma unroll
          for (int i = 0; i < 2; ++i) stage_rc(tl_ * 16 + i * 8192, R2[i], C2[i]);
          S.a_off(cur, R2, C2, voc); }
        if (wr == 1) PG8_BAR;
    }
    PG8_WAIT_V(0);
    PG8_BAR;
#undef PG8_SA
#undef PG8_SB
#undef PG8_STAGE
#undef PG8_STAGEA
#undef PG8_RDV
#undef PG8_LDA
#undef PG8_LDB
#undef PG8_MMA
#undef PG8_WAIT_V
#undef PG8_WAIT_L
#undef PG8_BAR
#undef PG8_SCHED
}

struct DenseSched {
    int nM, nN, nwg, G, c; const char* A; unsigned lda_b; const char* Bt; int K;
    __device__ __forceinline__ void init(int M, int N, int G_, int c_, const void* A_, int lda_elems, const void* Bt_, int K_) { nM = M / BM; nN = N / BM; nwg = nM * nN; G = G_; c = c_; A = (const char*)A_; lda_b = (unsigned)lda_elems * 2u; Bt = (const char*)Bt_; K = K_; }
    __device__ __forceinline__ bool next(int i, Unit& u) const {
        const long L = (long)i * G + c; if (L >= nwg) return false;
        int wgid = (int)L; { const int q = nwg / NXCD, r = nwg % NXCD, xcd = wgid % NXCD, off = wgid / NXCD; wgid = (xcd < r ? xcd * (q + 1) : r * (q + 1) + (xcd - r) * q) + off; }
        const int nig = WGM * nN, gid = wgid / nig, fm = gid * WGM, gsz = (nM - fm) < WGM ? (nM - fm) : WGM;
        u.pm = fm + ((wgid % nig) % gsz); u.pn = (wgid % nig) / gsz; u.e = 0; u.aux = 0; return true;
    }
    __device__ __forceinline__ void a_off(const Unit& u, const int (&R)[2], const int (&C)[2], unsigned (&vo)[2][2]) const {
#pragma unroll
        for (int h = 0; h < 2; ++h)
#pragma unroll
            for (int i = 0; i < 2; ++i) vo[h][i] = (unsigned)(u.pm * BM + h * HALF + R[i]) * lda_b + (unsigned)C[i] * 2u;
    }
    __device__ __forceinline__ const char* a_base() const { return A; }
    __device__ __forceinline__ const char* b_base(const Unit& u) const { return Bt + (size_t)u.pn * BM * K * 2; }
};
struct DenseSched8 : DenseSched {
    __device__ __forceinline__ const char* b_base(const Unit& u) const { return Bt + (size_t)u.pn * BM * K; }
};
struct RouterSched : DenseSched {
    __device__ __forceinline__ const char* b_base(const Unit& u) const { const int r0 = u.pm * BM; return Bt + (size_t)(r0 < SEQ ? 0 : (r0 < TL ? 1 : 2)) * 64 * DM * 2; }
};
struct MoeSched {
    const LAS int* ulist; const LAS int* uidx; int nu; const char* A; const char* Bt; int mode  ; int quarter;
    __device__ __forceinline__ bool next(int i, Unit& u) const {
        if (i >= nu) return false;
        u.e = __builtin_amdgcn_readfirstlane(ulist[i * 4 + 0]); u.pm = __builtin_amdgcn_readfirstlane(ulist[i * 4 + 1]); u.pn = __builtin_amdgcn_readfirstlane(ulist[i * 4 + 2]); u.aux = i; return true;
    }
    __device__ __forceinline__ void a_off(const Unit& u, const int (&R)[2], const int (&C)[2], unsigned (&vo)[2][2]) const {
        if (mode == 0) {
#pragma unroll
            for (int i = 0; i < 2; ++i) { const LAS int* p = uidx + u.aux * 256 + R[i]; vo[0][i] = (unsigned)p[0] * 1024u + (unsigned)C[i] * 2u; vo[1][i] = (unsigned)p[HALF] * 1024u + (unsigned)C[i] * 2u; }
        } else {
#pragma unroll
            for (int h = 0; h < 2; ++h)
#pragma unroll
                for (int i = 0; i < 2; ++i) vo[h][i] = (unsigned)(u.pm * BM + h * HALF + R[i]) * 256u + (unsigned)C[i] * 2u;
        }
    }
    __device__ __forceinline__ const char* a_base() const { return A; }
    __device__ __forceinline__ const char* b_base(const Unit& u) const {
        return mode == 0 ? Bt + ((size_t)u.e * 512 + (size_t)u.pn * 256) * 1024 : Bt + ((size_t)u.e * 1024 + (size_t)quarter * 512 + (size_t)u.pn * 256) * 256;
    }
};

struct EpiBf16 {
    static constexpr bool SWAPV = false; static constexpr bool PERM = true;
    bf16_t* O; int ldc; int col_tile0; float osc;
    __device__ __forceinline__ void operator()(const f32x4 (&acc)[2][2][4][2], const Unit& u, int wr, int wc, int fr, int fq) const {
        const int row0 = u.pm * BM + wr * 64 + fr; const int col0 = (col_tile0 ? 0 : u.pn * BM) + wc * 32 + 8 * fq;
#pragma unroll
        for (int ai = 0; ai < 2; ++ai)
#pragma unroll
            for (int m = 0; m < 4; ++m) { bf16_t* rowp = O + (size_t)(row0 + ai * HALF + m * 16) * ldc + col0;
#pragma unroll
                for (int bj = 0; bj < 2; ++bj) { const f32x4 v0 = acc[ai][bj][m][0] * osc, v1 = acc[ai][bj][m][1] * osc;
                    u32x4 w; w.x = cvt_pk_bf16(v0[0], v0[1]); w.y = cvt_pk_bf16(v0[2], v0[3]); w.z = cvt_pk_bf16(v1[0], v1[1]); w.w = cvt_pk_bf16(v1[2], v1[3]);
                    *(u32x4*)(rowp + bj * HALF) = w; } }
    }
};
struct EpiFp8 {
    static constexpr bool SWAPV = false; static constexpr bool PERM = false;
    unsigned char* O; int ldc; float oscale;
    __device__ __forceinline__ void operator()(const f32x4 (&acc)[2][2][4][2], const Unit& u, int wr, int wc, int fr, int fq) const {
        const int row0 = u.pm * BM + wr * 64 + fr; const int col0 = u.pn * BM + wc * 64 + 16 * fq;
#pragma unroll
        for (int ai = 0; ai < 2; ++ai)
#pragma unroll
            for (int m = 0; m < 4; ++m) { u32x4 w;
                { const f32x4 a0 = acc[ai][0][m][0] * oscale, a1 = acc[ai][0][m][1] * oscale, b0 = acc[ai][1][m][0] * oscale, b1 = acc[ai][1][m][1] * oscale;
                  w.x = pk4_fp8(a0[0], a0[1], a0[2], a0[3]); w.y = pk4_fp8(a1[0], a1[1], a1[2], a1[3]); w.z = pk4_fp8(b0[0], b0[1], b0[2], b0[3]); w.w = pk4_fp8(b1[0], b1[1], b1[2], b1[3]); }
                *(u32x4*)(O + (unsigned)((row0 + ai * HALF + m * 16) * ldc + col0)) = w; }
    }
};
template <bool VW> struct EpiKV {
    static constexpr bool SWAPV = VW;
    static constexpr bool PERM = true;
    unsigned char* K8; unsigned char* VT8;
    __device__ __forceinline__ void operator()(const f32x4 (&acc)[2][2][4][2], const Unit& u, int wr, int wc, int fr, int fq) const {
        if constexpr (VW) {
            const int dl = (wc - 2) * 32 + 8 * (fr >> 2) + (fr & 3); const unsigned loff = (unsigned)(dl * 64 + (fq & 1) * 32 + (fq >> 1) * 16);
#pragma unroll
            for (int ai = 0; ai < 2; ++ai) { const int R64 = u.pm * BM + ai * HALF + wr * 64; int b, key0;
                if (R64 < TL) { b = R64 >> 14; key0 = CTXL + (R64 & (SEQ - 1)); } else { const int rr = R64 - TL; b = rr >> 8; key0 = rr & (CTXL - 1); }
#pragma unroll
                for (int bj = 0; bj < 2; ++bj) { unsigned char* base = VT8 + ((size_t)((b * NH + u.pn * 2 + bj) * 260 + (key0 >> 6))) * 4096;
#pragma unroll
                    for (int n = 0; n < 2; ++n) { unsigned W[4];
#pragma unroll
                        for (int m = 0; m < 4; ++m) { const f32x4 v = acc[ai][bj][m][n]; W[m] = pk4_fp8(v[0], v[1], v[2], v[3]); }
                        const auto s0 = __builtin_amdgcn_permlane32_swap(W[0], W[2], false, false), s1 = __builtin_amdgcn_permlane32_swap(W[1], W[3], false, false);
                        *(u32x4*)(base + loff + n * 256) = (u32x4){s0[0], s0[1], s1[0], s1[1]}; } } }
            return;
        }
        const int row0 = u.pm * BM + wr * 64 + fr;
#pragma unroll
        for (int ai = 0; ai < 2; ++ai)
#pragma unroll
            for (int m = 0; m < 4; ++m) { const int row = row0 + ai * HALF + m * 16; int b, key;
                if (row < TL) { b = row >> 14; key = CTXL + (row & (SEQ - 1)); } else { const int rr = row - TL; b = rr >> 8; key = rr & (CTXL - 1); }
#pragma unroll
                for (int bj = 0; bj < 2; ++bj) { const int col0 = u.pn * BM + bj * HALF + wc * 32 + 8 * fq, h = col0 >> 7, j = col0 & 127;
                    const f32x4 v0 = acc[ai][bj][m][0], v1 = acc[ai][bj][m][1];
                    u32x2 w; w.x = pk4_fp8(v0[0], v0[1], v0[2], v0[3]); w.y = pk4_fp8(v1[0], v1[1], v1[2], v1[3]);
                    *(u32x2*)(K8 + ((size_t)(b * NH + h) * LK + key) * 128 + j) = w; } }
    }
};
struct EpiResid {
    static constexpr bool SWAPV = false; static constexpr bool PERM = false;
    const float* xlat; const float* xctx; const bf16_t* xsin; bf16_t* XS; const float* mods; float gscale;
    __device__ __forceinline__ void operator()(const f32x4 (&acc)[2][2][4][2], const Unit& u, int wr, int wc, int fr, int fq) const {
        const int rowt = u.pm * BM; const int vec = rowt < SEQ ? 0 : (rowt < TL ? 1 : 2);
        const float* gate = mods + vec * 6144 + 2 * DM;
        const float* xin = rowt < TL ? xlat + (size_t)rowt * DM : xctx + (size_t)(rowt - TL) * DM;
        const bf16_t* xib = xsin + (size_t)rowt * DM;
        bf16_t* xo = XS + (size_t)rowt * DM;
        const int r0 = wr * 64 + fr, col0 = u.pn * BM + wc * 64 + 16 * fq;
        f32x4 gv[2][2];
#pragma unroll
        for (int bj = 0; bj < 2; ++bj)
#pragma unroll
            for (int n = 0; n < 2; ++n) { gv[bj][n] = *(const f32x4*)(gate + col0 + 8 * bj + 4 * n) * gscale; }
#pragma unroll
        for (int ai = 0; ai < 2; ++ai)
#pragma unroll
            for (int m = 0; m < 4; ++m) { const unsigned off = (unsigned)((r0 + ai * HALF + m * 16) * DM + col0); f32x4 xv[2][2];
                if (xsin) { const u32x4 a = *(const u32x4*)(xib + off), b = *(const u32x4*)(xib + off + 8);
                    xv[0][0] = (f32x4){bf_lo(a.x), bf_hi(a.x), bf_lo(a.y), bf_hi(a.y)}; xv[0][1] = (f32x4){bf_lo(a.z), bf_hi(a.z), bf_lo(a.w), bf_hi(a.w)};
                    xv[1][0] = (f32x4){bf_lo(b.x), bf_hi(b.x), bf_lo(b.y), bf_hi(b.y)}; xv[1][1] = (f32x4){bf_lo(b.z), bf_hi(b.z), bf_lo(b.w), bf_hi(b.w)}; }
                else {
#pragma unroll
                    for (int bj = 0; bj < 2; ++bj)
#pragma unroll
                        for (int n = 0; n < 2; ++n) xv[bj][n] = __builtin_nontemporal_load((const f32x4*)(xin + off + 8 * bj + 4 * n)); }
                u32x4 o[2];
#pragma unroll
                for (int bj = 0; bj < 2; ++bj) { const f32x4 y0 = xv[bj][0] + gv[bj][0] * acc[ai][bj][m][0], y1 = xv[bj][1] + gv[bj][1] * acc[ai][bj][m][1];
                    o[bj].x = cvt_pk_bf16(y0.x, y0.y); o[bj].y = cvt_pk_bf16(y0.z, y0.w); o[bj].z = cvt_pk_bf16(y1.x, y1.y); o[bj].w = cvt_pk_bf16(y1.z, y1.w); }
                *(u32x4*)(xo + off) = o[0]; *(u32x4*)(xo + off + 8) = o[1];
                asm volatile("" ::: "memory"); }
    }
};
struct EpiLogits {
    static constexpr bool SWAPV = false; static constexpr bool PERM = false;
    float* Lg;
    __device__ __forceinline__ void operator()(const f32x4 (&acc)[2][2][4][2], const Unit& u, int wr, int wc, int fr, int fq) const {
        if (wc >= 2) return;
        const int row0 = u.pm * BM + wr * 64 + fr, col0 = wc * 32 + 4 * fq;
#pragma unroll
        for (int ai = 0; ai < 2; ++ai)
#pragma unroll
            for (int m = 0; m < 4; ++m)
#pragma unroll
                for (int n = 0; n < 2; ++n) *(f32x4*)(Lg + (size_t)(row0 + ai * HALF + m * 16) * NE + col0 + n * 16) = acc[ai][0][m][n];
    }
};
struct EpiSwiGLU {
    static constexpr bool SWAPV = false; static constexpr bool PERM = false;
    bf16_t* ACT; float wscale;
    __device__ __forceinline__ void operator()(const f32x4 (&acc)[2][2][4][2], const Unit& u, int wr, int wc, int fr, int fq) const {
        const unsigned off0 = (unsigned)(u.pm * BM + wr * 64 + fr) * DE + (unsigned)(u.pn * 128 + wc * 32 + 8 * fq);
#pragma unroll
        for (int ai = 0; ai < 2; ++ai)
#pragma unroll
            for (int m = 0; m < 4; ++m) { u32x2 w;
#pragma unroll
                for (int bj = 0; bj < 2; ++bj) { const f32x4 g = acc[ai][bj][m][0] * wscale, v = acc[ai][bj][m][1] * wscale;
                    w[bj] = pk4_fp8(silu_f(g[0]) * v[0], silu_f(g[1]) * v[1], silu_f(g[2]) * v[2], silu_f(g[3]) * v[3]); }
                *(u32x2*)((char*)ACT + (off0 + (unsigned)((ai * HALF + m * 16) * DE))) = w; }
    }
};
}

namespace att {
constexpr int NW = 8, QBLK = 32, KVBLK = 64, KROW = 208;
constexpr int SHM_V = KVBLK * DV * 2, SHM_K = KVBLK * KROW, OFF_K = 2 * SHM_V, OFF_WS = OFF_K + 2 * SHM_K, OFF_OST = OFF_WS + NW * 64 * 4, LDS_ATT = OFF_OST + NW * 4096;
static_assert(LDS_ATT <= LDS_WORK, "attention LDS");
constexpr float SCALE = 0.10206207261596575f;
constexpr float THR = 8.f;
#define SBAR() __builtin_amdgcn_sched_barrier(0)
__device__ __forceinline__ int crow(int r, int hi) { return (r & 3) + 8 * (r >> 2) + 4 * hi; }
__device__ __forceinline__ void partialSM(f32x16& p0, f32x16& p1, float& m_reg, float& mn, float& alpha) {
    constexpr float C = SCALE * 1.4426950408889634f;
    float pmax = p0[0];
#pragma unroll
    for (int r = 1; r < 16; ++r) pmax = fmaxf(pmax, p0[r]);
#pragma unroll
    for (int r = 0; r < 16; ++r) pmax = fmaxf(pmax, p1[r]);
    { auto rr = __builtin_amdgcn_permlane32_swap(__float_as_uint(pmax), __float_as_uint(pmax), false, false);
      pmax = fmaxf(__uint_as_float(rr[0]), __uint_as_float(rr[1])); }
    if (__builtin_expect(__all(pmax - m_reg <= THR / SCALE), 1)) { mn = m_reg; alpha = 1.f; }
    else { mn = fmaxf(m_reg, pmax); alpha = __builtin_amdgcn_exp2f((m_reg - mn) * C); m_reg = mn; }
    const float mnC = -mn * C;
#pragma unroll
    for (int r = 0; r < 16; ++r) p0[r] = fmaf(p0[r], C, mnC);
#pragma unroll
    for (int r = 0; r < 16; ++r) p1[r] = fmaf(p1[r], C, mnC);
#pragma unroll
    for (int r = 0; r < 16; ++r) p0[r] = __builtin_amdgcn_exp2f(p0[r]);
}
__device__ __forceinline__ void finishSM(f32x16& p0, f32x16& p1, float alpha, float& l_reg, bf16x8& pa0, bf16x8& pa1, bf16x8& pa2, bf16x8& pa3) {
#pragma unroll
    for (int r = 0; r < 16; ++r) p1[r] = __builtin_amdgcn_exp2f(p1[r]);
    float ps = 0;
#pragma unroll
    for (int r = 0; r < 16; ++r) ps += p0[r];
#pragma unroll
    for (int r = 0; r < 16; ++r) ps += p1[r];
    { auto rr = __builtin_amdgcn_permlane32_swap(__float_as_uint(ps), __float_as_uint(ps), false, false);
      ps = __uint_as_float(rr[0]) + __uint_as_float(rr[1]); }
    l_reg = l_reg * alpha + ps;
#define PK4(P, BASE, OUT) do { unsigned a0 = cvt_pk_bf16(P[BASE + 0], P[BASE + 1]), a1 = cvt_pk_bf16(P[BASE + 2], P[BASE + 3]);   \
    unsigned b0 = cvt_pk_bf16(P[BASE + 4], P[BASE + 5]), b1 = cvt_pk_bf16(P[BASE + 6], P[BASE + 7]);                              \
    auto r0 = __builtin_amdgcn_permlane32_swap(a0, b0, false, false); auto r1 = __builtin_amdgcn_permlane32_swap(a1, b1, false, false); \
    u32x4 w = {r0[0], r1[0], r0[1], r1[1]}; OUT = *reinterpret_cast<bf16x8*>(&w); } while (0)
    PK4(p0, 0, pa0); PK4(p0, 8, pa1); PK4(p1, 0, pa2); PK4(p1, 8, pa3);
#undef PK4
}
__device__ __forceinline__ void qkt(f32x16& p0, f32x16& p1, const LAS char* Ks, const bf16x8* qr, int r32, int hi) {
    p0 = f32x16{}; p1 = f32x16{};
#pragma unroll
    for (int d0 = 0; d0 < 6; ++d0) { const int cb = (d0 * 16 + hi * 8) * 2;
        const bf16x8 b0 = *reinterpret_cast<const LAS bf16x8*>(Ks + r32 * KROW + cb);
        const bf16x8 b1 = *reinterpret_cast<const LAS bf16x8*>(Ks + (32 + r32) * KROW + cb);
        p0 = __builtin_amdgcn_mfma_f32_32x32x16_bf16(b0, qr[d0], p0, 0, 0, 0);
        p1 = __builtin_amdgcn_mfma_f32_32x32x16_bf16(b1, qr[d0], p1, 0, 0, 0); }
}
__device__ __forceinline__ int v_st(int k, int c) { const int kk = (k & ~0xC) | ((k & 4) << 1) | ((k & 8) >> 1); return ((kk >> 3) * 2 + (c >> 5)) * 512 + ((kk & 7) * 32 + (c & 31)) * 2; }
__device__ __forceinline__ int v_rd_base(int lane) { return ((lane & 3) << 3) | (((lane >> 2) & 3) << 6) | (((lane >> 4) & 1) << 5) | (((lane >> 5) & 1) << 8); }
template <int OFF> __device__ __forceinline__ s16x4 tr_read(int vb) {
    s16x4 r; asm volatile("ds_read_b64_tr_b16 %0, %1 offset:%2" : "=&v"(r) : "v"(vb), "i"(OFF) : "memory"); return r;
}
template <int D0> __device__ __forceinline__ void pv_one(f32x16& od, int vb, bf16x8 pa0, bf16x8 pa1, bf16x8 pa2, bf16x8 pa3) {
    const s16x4 l0 = tr_read<D0 * 512 + 0 * 2048>(vb), h0 = tr_read<D0 * 512 + 0 * 2048 + 1024>(vb), l1 = tr_read<D0 * 512 + 1 * 2048>(vb), h1 = tr_read<D0 * 512 + 1 * 2048 + 1024>(vb);
    const s16x4 l2 = tr_read<D0 * 512 + 2 * 2048>(vb), h2 = tr_read<D0 * 512 + 2 * 2048 + 1024>(vb), l3 = tr_read<D0 * 512 + 3 * 2048>(vb), h3 = tr_read<D0 * 512 + 3 * 2048 + 1024>(vb);
    asm volatile("s_waitcnt lgkmcnt(0)" ::: "memory"); SBAR();
#define PK(L, H) (bf16x8){L[0], L[1], L[2], L[3], H[0], H[1], H[2], H[3]}
    od = __builtin_amdgcn_mfma_f32_32x32x16_bf16(pa0, PK(l0, h0), od, 0, 0, 0);
    od = __builtin_amdgcn_mfma_f32_32x32x16_bf16(pa1, PK(l1, h1), od, 0, 0, 0);
    od = __builtin_amdgcn_mfma_f32_32x32x16_bf16(pa2, PK(l2, h2), od, 0, 0, 0);
    od = __builtin_amdgcn_mfma_f32_32x32x16_bf16(pa3, PK(l3, h3), od, 0, 0, 0);
#undef PK
}
__device__ __forceinline__ void pv_d0(f32x16* o, int vb, bf16x8 pa0, bf16x8 pa1, bf16x8 pa2, bf16x8 pa3) {
    pv_one<0>(o[0], vb, pa0, pa1, pa2, pa3); pv_one<1>(o[1], vb, pa0, pa1, pa2, pa3);
}
__device__ __forceinline__ void attn_unit(const bf16_t* __restrict__ Qb, const bf16_t* __restrict__ Kh, const bf16_t* __restrict__ Vh, bf16_t* __restrict__ Ob, int ldo, int seq, bool rope, int pos0, LAS char* lds, const int tid) {
    const int wid = __builtin_amdgcn_readfirstlane(tid >> 6), lane = tid & 63, r32 = lane & 31, hi = lane >> 5;
    LAS char* V_lds = lds; LAS char* K_lds = lds + OFF_K;
    LAS float* ws = (LAS float*)(lds + OFF_WS) + wid * 64; LAS float* li_l = ws; LAS float* al_l = ws + 32;
    float m_reg = -1e30f, l_reg = 0; f32x16 o[2] = {}; bf16x8 qr[6];
    const bf16_t* Qw = Qb + (size_t)(wid * QBLK + r32) * 768 + hi * 8;
#pragma unroll
    for (int d0 = 0; d0 < 6; ++d0) qr[d0] = *reinterpret_cast<const bf16x8*>(Qw + d0 * 16);
    if (rope) {
        const int t = pos0 + wid * QBLK + r32;
#pragma unroll
        for (int ax = 0; ax < 2; ++ax) {
            const float pos = (float)(ax == 0 ? (t >> 6) : (t & 63));
            u32x4 mine = *reinterpret_cast<u32x4*>(&qr[4 + ax]); u32x4 oth;
#pragma unroll
            for (int j = 0; j < 4; ++j) { auto rr = __builtin_amdgcn_permlane32_swap(mine[j], mine[j], false, false); oth[j] = hi ? rr[1] : rr[0]; }
            u32x4 res;
#pragma unroll
            for (int j = 0; j < 4; ++j) {
                float cs[2], sn[2];
#pragma unroll
                for (int q = 0; q < 2; ++q) { const float ang = pos * __powf(10000.0f, -(float)(2 * j + q) * 0.125f); sn[q] = __sinf(ang); cs[q] = __cosf(ang); }
                const float m0 = bf_lo(mine[j]), m1 = bf_hi(mine[j]), o0 = bf_lo(oth[j]), o1 = bf_hi(oth[j]);
                const float r0 = hi == 0 ? m0 * cs[0] - o0 * sn[0] : m0 * cs[0] + o0 * sn[0];
                const float r1 = hi == 0 ? m1 * cs[1] - o1 * sn[1] : m1 * cs[1] + o1 * sn[1];
                res[j] = cvt_pk_bf16(r0, r1);
            }
            qr[4 + ax] = *reinterpret_cast<bf16x8*>(&res);
        }
    }
    const int vk = tid >> 3, vc = (tid & 7) * 8, vst = v_st(vk, vc);
    const int kc0 = tid, kc1 = 512 + (tid & 255); const int kst0 = (kc0 / 12) * KROW + (kc0 % 12) * 16, kst1 = (kc1 / 12) * KROW + (kc1 % 12) * 16;
    const bool k2 = wid < 4;
    const int vb0 = (int)(uintptr_t)V_lds + v_rd_base(lane);
    struct { bf16x8 vs0, ks0, ks1; } sr_[2];
#define SLOAD(i, k0) do { sr_[i].vs0 = *reinterpret_cast<const bf16x8*>(Vh + (size_t)(k0) * DV + tid * 8); sr_[i].ks0 = *reinterpret_cast<const bf16x8*>(Kh + (size_t)(k0) * DQK + kc0 * 8); \
    if (k2) sr_[i].ks1 = *reinterpret_cast<const bf16x8*>(Kh + (size_t)(k0) * DQK + kc1 * 8); } while (0)
#define SWRITE(b, i) do { *(LAS bf16x8*)(V_lds + (b) * SHM_V + vst) = sr_[i].vs0; *(LAS bf16x8*)(K_lds + (b) * SHM_K + kst0) = sr_[i].ks0; \
    if (k2) *(LAS bf16x8*)(K_lds + (b) * SHM_K + kst1) = sr_[i].ks1; } while (0)
#define RESC(a) do { if (__any((a) < 1.f)) { if (hi == 0) al_l[r32] = (a); asm volatile("s_waitcnt lgkmcnt(0)" ::: "memory"); \
    _Pragma("unroll") for (int d = 0; d < 2; ++d) _Pragma("unroll") for (int r = 0; r < 16; ++r) o[d][r] *= al_l[crow(r, hi)]; } } while (0)
    f32x16 pA0, pA1, pB0, pB1; float mnA, mnB, alA, alB; bf16x8 pa0, pa1, pa2, pa3; const int NT = seq / KVBLK;
    constexpr int SE = 0, SO = 1;
    SLOAD(SE, 0); asm volatile("s_waitcnt vmcnt(0)" ::: "memory"); SWRITE(0, SE); __syncthreads();
    qkt(pA0, pA1, K_lds, qr, r32, hi); partialSM(pA0, pA1, m_reg, mnA, alA);
    SLOAD(SO, KVBLK); if (2 < NT) SLOAD(SE, 2 * KVBLK);
    SWRITE(1, SO); __syncthreads();
    for (int j = 1; j + 1 < NT; j += 2) {
        SBAR(); qkt(pB0, pB1, K_lds + SHM_K, qr, r32, hi);
        finishSM(pA0, pA1, alA, l_reg, pa0, pa1, pa2, pa3); SBAR();
        SLOAD(SO, (j + 2) * KVBLK); SBAR();
        pv_d0(o, vb0, pa0, pa1, pa2, pa3); partialSM(pB0, pB1, m_reg, mnB, alB);
        __syncthreads(); SWRITE(0, SE);
        RESC(alB); __syncthreads();
        SBAR(); qkt(pA0, pA1, K_lds, qr, r32, hi);
        finishSM(pB0, pB1, alB, l_reg, pa0, pa1, pa2, pa3); SBAR();
        if (j + 3 < NT) SLOAD(SE, (j + 3) * KVBLK); SBAR();
        pv_d0(o, vb0 + SHM_V, pa0, pa1, pa2, pa3); partialSM(pA0, pA1, m_reg, mnA, alA);
        __syncthreads(); SWRITE(1, SO);
        RESC(alA); __syncthreads();
    }
    SBAR(); qkt(pB0, pB1, K_lds + SHM_K, qr, r32, hi);
    finishSM(pA0, pA1, alA, l_reg, pa0, pa1, pa2, pa3); SBAR();
    pv_d0(o, vb0, pa0, pa1, pa2, pa3); partialSM(pB0, pB1, m_reg, mnB, alB);
    __syncthreads(); RESC(alB);
    finishSM(pB0, pB1, alB, l_reg, pa0, pa1, pa2, pa3); SBAR();
    pv_d0(o, vb0 + SHM_V, pa0, pa1, pa2, pa3);
    if (hi == 0) li_l[r32] = l_reg; asm volatile("s_waitcnt lgkmcnt(0)" ::: "memory");
    float rli[16];
#pragma unroll
    for (int r = 0; r < 16; ++r) rli[r] = __builtin_amdgcn_rcpf(li_l[crow(r, hi)]);
    { LAS bf16_t* stg = (LAS bf16_t*)(lds + OFF_OST) + wid * 2048;
#pragma unroll
      for (int r = 0; r < 16; ++r) { const int orow = crow(r, hi);
#pragma unroll
          for (int d0 = 0; d0 < 2; ++d0) stg[orow * 64 + d0 * 32 + r32] = (bf16_t)(cvt_pk_bf16(o[d0][r] * rli[r], 0.f) & 0xffffu); }
      asm volatile("s_waitcnt lgkmcnt(0)" ::: "memory");
      bf16_t* Ow = Ob + (size_t)(wid * QBLK) * ldo;
#pragma unroll
      for (int i = 0; i < 4; ++i) { const int row = i * 8 + (lane >> 3), ch = lane & 7; const u32x4 v = *(const LAS u32x4*)(stg + row * 64 + ch * 8); *(u32x4*)(Ow + (size_t)row * ldo + ch * 8) = v; } }
    asm volatile("s_waitcnt lgkmcnt(0)" ::: "memory"); __syncthreads();
#undef SLOAD
#undef SWRITE
#undef RESC
}
}


namespace att8 {
constexpr int KROW = 144, VROW = 80, SLOT_K = 64 * KROW, SLOT_V = 64 * VROW, NSLOT = 3;
constexpr int OFF_V = NSLOT * SLOT_K, OFF_WS = OFF_V + NSLOT * SLOT_V, OFF_OST = OFF_WS + 8 * 512, LDS_ATT = OFF_OST + 8 * 8192;
static_assert(LDS_ATT <= LDS_WORK, "attention LDS");
constexpr float C2 = 0.10206207261596575f * 1.4426950408889634f;
constexpr float THR = 6.f, PSH = 2.f;
__device__ __forceinline__ int crow(int r, int hi) { return (r & 3) + 8 * (r >> 2) + 4 * hi; }
#define MFMA8(a, b, c) __builtin_amdgcn_mfma_scale_f32_32x32x64_f8f6f4(a, b, c, 0, 0, 0, 0, 0, 0)
__device__ __forceinline__ float max3f(float a, float b, float c) { float r; asm("v_max3_f32 %0, %1, %2, %3" : "=v"(r) : "v"(a), "v"(b), "v"(c)); return r; }
__device__ __forceinline__ i32x8 ld32(const LAS char* p) { const u32x4 a = *(const LAS u32x4*)p, b = *(const LAS u32x4*)(p + 16); return (i32x8){(int)a.x, (int)a.y, (int)a.z, (int)a.w, (int)b.x, (int)b.y, (int)b.z, (int)b.w}; }
__device__ __forceinline__ i32x8 softmax_blk(f32x16& p0, f32x16& p1, float& m_reg, float& l_reg, f32x16 (&o)[2], LAS float* al_l, int r32, int hi) {
    float a = fmaxf(fmaxf(p0[0], p0[1]), p1[0]), b = fmaxf(fmaxf(p0[2], p0[3]), p1[1]); a = fmaxf(fmaxf(a, p1[2]), p1[3]);
#pragma unroll
    for (int r = 4; r < 16; r += 4) { a = fmaxf(fmaxf(a, p0[r]), p0[r + 1]); b = fmaxf(fmaxf(b, p0[r + 2]), p0[r + 3]); a = fmaxf(fmaxf(a, p1[r]), p1[r + 1]); b = fmaxf(fmaxf(b, p1[r + 2]), p1[r + 3]); }
    float pmax = fmaxf(a, b);
    { auto rr = __builtin_amdgcn_permlane32_swap(__float_as_uint(pmax), __float_as_uint(pmax), false, false); pmax = fmaxf(__uint_as_float(rr[0]), __uint_as_float(rr[1])); }
    if (__builtin_expect(!__all(pmax - m_reg <= THR), 0)) {
        const float mn = fmaxf(m_reg, pmax), alpha = __builtin_amdgcn_exp2f(m_reg - mn); m_reg = mn; l_reg *= alpha;
        if (hi == 0) al_l[r32] = alpha; asm volatile("s_waitcnt lgkmcnt(0)" ::: "memory");
        int hi_ = hi; asm volatile("" : "+v"(hi_));
#pragma unroll
        for (int d = 0; d < 2; ++d)
#pragma unroll
            for (int r = 0; r < 16; ++r) o[d][r] *= al_l[crow(r, hi_)];
    }
    const float ms = m_reg - PSH;
#pragma unroll
    for (int r = 0; r < 16; ++r) { p0[r] = __builtin_amdgcn_exp2f(p0[r] - ms); p1[r] = __builtin_amdgcn_exp2f(p1[r] - ms); }
    float ps = 0.f;
#pragma unroll
    for (int r = 0; r < 16; ++r) ps += p0[r];
#pragma unroll
    for (int r = 0; r < 16; ++r) ps += p1[r];
    { auto rr = __builtin_amdgcn_permlane32_swap(__float_as_uint(ps), __float_as_uint(ps), false, false); ps = __uint_as_float(rr[0]) + __uint_as_float(rr[1]); }
    l_reg += ps;
    i32x8 pa;
#pragma unroll
    for (int w = 0; w < 4; ++w) { pa[w] = (int)pk4_fp8(p0[4 * w], p0[4 * w + 1], p0[4 * w + 2], p0[4 * w + 3]); pa[4 + w] = (int)pk4_fp8(p1[4 * w], p1[4 * w + 1], p1[4 * w + 2], p1[4 * w + 3]); }
    return pa;
}
__device__ __forceinline__ void load_q(i32x8 (&q)[2], const char* __restrict__ qbase, unsigned qoff, int hi, bool rope, int t) {
    { const u32x4* p = (const u32x4*)(qbase + (qoff + (unsigned)hi * 64u)); float f[32];
#pragma unroll
      for (int c = 0; c < 4; ++c) { const u32x4 v = p[c];
#pragma unroll
          for (int j = 0; j < 4; ++j) { f[8 * c + 2 * j] = bf_lo(v[j]) * C2; f[8 * c + 2 * j + 1] = bf_hi(v[j]) * C2; } }
#pragma unroll
      for (int w = 0; w < 8; ++w) q[0][w] = (int)pk4_fp8(f[4 * w], f[4 * w + 1], f[4 * w + 2], f[4 * w + 3]); }
    { const u32x4* p = (const u32x4*)(qbase + (qoff + 128u)); float f[32];
#pragma unroll
      for (int c = 0; c < 4; ++c) { const u32x4 v = p[c];
#pragma unroll
          for (int j = 0; j < 4; ++j) { f[8 * c + 2 * j] = bf_lo(v[j]) * C2; f[8 * c + 2 * j + 1] = bf_hi(v[j]) * C2; } }
      if (rope) {
#pragma unroll
          for (int ax = 0; ax < 2; ++ax) { const float pos = (float)(ax == 0 ? (t >> 6) : (t & 63));
#pragma unroll
              for (int j = 0; j < 8; ++j) { const float ang = pos * __powf(10000.0f, -(float)j * 0.125f); const float sn = __sinf(ang), cs = __cosf(ang);
                  const float x1 = f[16 * ax + j], x2 = f[16 * ax + 8 + j]; f[16 * ax + j] = x1 * cs - x2 * sn; f[16 * ax + 8 + j] = x2 * cs + x1 * sn; } } }
#pragma unroll
      for (int w = 0; w < 8; ++w) q[1][w] = hi ? 0 : (int)pk4_fp8(f[4 * w], f[4 * w + 1], f[4 * w + 2], f[4 * w + 3]); }
}
__device__ __forceinline__ void attn_unit(const bf16_t* __restrict__ Qb, const unsigned char* __restrict__ K8t, const unsigned char* __restrict__ VTt, bf16_t* __restrict__ Ob, int ldo, int ntile, bool rope, int pos0, int nvalid, LAS char* lds, const int tid) {
    const int wid = __builtin_amdgcn_readfirstlane(tid >> 6), lane = tid & 63, r32 = lane & 31, hi = lane >> 5;
    LAS float* wsf = (LAS float*)(lds + OFF_WS) + wid * 128;
    i32x8 qX[2], qY[2];
    { const int rx = wid * 64 + r32, ry = rx + 32; const int cx = rx < nvalid ? rx : rx % nvalid, cy = ry < nvalid ? ry : ry % nvalid;
      load_q(qX, (const char*)Qb, (unsigned)cx * 1536u, hi, rope, pos0 + rx); load_q(qY, (const char*)Qb, (unsigned)cy * 1536u, hi, rope, pos0 + ry); }
    float mX = -1e30f, mY = -1e30f, lX = 0.f, lY = 0.f; f32x16 oX[2] = {}, oY[2] = {};
    const int kst = (tid >> 3) * KROW + (tid & 7) * 16, vst = OFF_V + (tid >> 2) * VROW + (tid & 3) * 16; const bool vth = wid < 4;
    const int kfo = r32 * KROW + hi * 32, vfo = OFF_V + r32 * VROW + hi * 32;
    unsigned zz_ = 0u; asm volatile("" : "+v"(zz_));
    u32x4 sk, sv = {zz_, zz_, zz_, zz_};
    const unsigned toff = (unsigned)tid * 16u;
#define SLOAD8(t) do { sk = *(const u32x4*)(K8t + (size_t)(t) * 8192 + toff); if (vth) sv = *(const u32x4*)(VTt + (size_t)(t) * 4096 + toff); } while (0)
#define SWRITE8(s) do { *(LAS u32x4*)(lds + (s) * SLOT_K + kst) = sk; if (vth) *(LAS u32x4*)(lds + (s) * SLOT_V + vst) = sv; } while (0)
    SLOAD8(0); SWRITE8(0); if (1 < ntile) SLOAD8(1);
    int sc = 0, sn = 1;
    for (int t = 0; t < ntile; ++t) {
        __syncthreads();
        if (t + 1 < ntile) SWRITE8(sn);
        if (t + 2 < ntile) SLOAD8(t + 2);
        const LAS char* kb = lds + sc * SLOT_K + kfo; const LAS char* vb = lds + sc * SLOT_V + vfo;
        f32x16 pX0, pX1, pY0, pY1;
        { const i32x8 k0 = ld32(kb), k1 = ld32(kb + 32 * KROW); const f32x16 z = {};
          pX0 = MFMA8(k0, qX[0], z); pX1 = MFMA8(k1, qX[0], z); pY0 = MFMA8(k0, qY[0], z); pY1 = MFMA8(k1, qY[0], z); }
        { const i32x8 k0 = ld32(kb + 64), k1 = ld32(kb + 32 * KROW + 64);
          pX0 = MFMA8(k0, qX[1], pX0); pX1 = MFMA8(k1, qX[1], pX1); pY0 = MFMA8(k0, qY[1], pY0); pY1 = MFMA8(k1, qY[1], pY1); }
        const i32x8 paX = softmax_blk(pX0, pX1, mX, lX, oX, wsf, r32, hi);
        { const i32x8 v0 = ld32(vb), v1 = ld32(vb + 32 * VROW);
          oX[0] = MFMA8(paX, v0, oX[0]); oX[1] = MFMA8(paX, v1, oX[1]); }
        const i32x8 paY = softmax_blk(pY0, pY1, mY, lY, oY, wsf + 32, r32, hi);
        { const i32x8 v0 = ld32(vb), v1 = ld32(vb + 32 * VROW);
          oY[0] = MFMA8(paY, v0, oY[0]); oY[1] = MFMA8(paY, v1, oY[1]); }
        sc = sn; sn = (sn == NSLOT - 1) ? 0 : sn + 1;
    }
#undef SLOAD8
#undef SWRITE8
    if (hi == 0) { wsf[64 + r32] = lX; wsf[96 + r32] = lY; } asm volatile("s_waitcnt lgkmcnt(0)" ::: "memory");
    LAS bf16_t* stg = (LAS bf16_t*)(lds + OFF_OST) + wid * 4096;
#pragma unroll
    for (int r = 0; r < 16; ++r) { const int orow = crow(r, hi); const float rx = __builtin_amdgcn_rcpf(wsf[64 + orow]), ry = __builtin_amdgcn_rcpf(wsf[96 + orow]);
#pragma unroll
        for (int d0 = 0; d0 < 2; ++d0) { stg[orow * 64 + d0 * 32 + r32] = (bf16_t)(cvt_pk_bf16(oX[d0][r] * rx, 0.f) & 0xffffu); stg[(32 + orow) * 64 + d0 * 32 + r32] = (bf16_t)(cvt_pk_bf16(oY[d0][r] * ry, 0.f) & 0xffffu); } }
    asm volatile("s_waitcnt lgkmcnt(0)" ::: "memory");
#pragma unroll
    for (int i = 0; i < 8; ++i) { const int row = i * 8 + (lane >> 3), ch = lane & 7; const u32x4 v = *(const LAS u32x4*)(stg + row * 64 + ch * 8);
        if (wid * 64 + row < nvalid) *(u32x2*)((char*)Ob + (size_t)(wid * 64 + row) * ldo + ch * 8) = bf8_to_fp8(v); }
    asm volatile("s_waitcnt lgkmcnt(0)" ::: "memory"); __syncthreads();
}
#undef MFMA8

__device__ __forceinline__ void sm_max(f32x16& p0, f32x16& p1, float& m_reg, float& l_reg, f32x16 (&o)[2], i32x8& qpad, LAS float* al_l, int r32, int hi, bool first) {
    float a = fmaxf(fmaxf(p0[0], p0[1]), p1[0]), b = fmaxf(fmaxf(p0[2], p0[3]), p1[1]); a = fmaxf(fmaxf(a, p1[2]), p1[3]);
#pragma unroll
    for (int r = 4; r < 16; r += 4) { a = fmaxf(fmaxf(a, p0[r]), p0[r + 1]); b = fmaxf(fmaxf(b, p0[r + 2]), p0[r + 3]); a = fmaxf(fmaxf(a, p1[r]), p1[r + 1]); b = fmaxf(fmaxf(b, p1[r + 2]), p1[r + 3]); }
    float pmax = fmaxf(a, b);
    { auto rr = __builtin_amdgcn_permlane32_swap(__float_as_uint(pmax), __float_as_uint(pmax), false, false); pmax = fmaxf(__uint_as_float(rr[0]), __uint_as_float(rr[1])); }
    if (__builtin_expect(first || !__all(pmax <= THR + PSH), 0)) {
        const float tm = ceilf(pmax + (m_reg - PSH)); float x = (first ? tm : fmaxf(m_reg, tm)) - PSH;
        const unsigned qb_ = __builtin_amdgcn_cvt_pk_fp8_f32(-x, 0.f, 0u, false) & 0xffu; x = -__builtin_amdgcn_cvt_f32_fp8((int)qb_, 0);
        const float mn = x + PSH, d = mn - m_reg, alpha = __builtin_amdgcn_exp2f(-d); m_reg = mn; l_reg *= alpha;
        if (hi == 0) al_l[r32] = alpha; asm volatile("s_waitcnt lgkmcnt(0)" ::: "memory");
        int hi_ = hi; asm volatile("" : "+v"(hi_));
#pragma unroll
        for (int dd = 0; dd < 2; ++dd)
#pragma unroll
            for (int r = 0; r < 16; ++r) o[dd][r] *= al_l[crow(r, hi_)];
#pragma unroll
        for (int r = 0; r < 16; ++r) { p0[r] -= d; p1[r] -= d; }
        if (hi_) qpad[0] = (int)qb_;
    }
}
__device__ __forceinline__ i32x8 sm_exp(f32x16& p0, f32x16& p1, const float m_reg, float& l_reg) {
    const float ms = m_reg - PSH;
#pragma unroll
    for (int r = 0; r < 16; ++r) { p0[r] = __builtin_amdgcn_exp2f(p0[r] - ms); p1[r] = __builtin_amdgcn_exp2f(p1[r] - ms); }
    float ps = 0.f;
#pragma unroll
    for (int r = 0; r < 16; ++r) ps += p0[r];
#pragma unroll
    for (int r = 0; r < 16; ++r) ps += p1[r];
    { auto rr = __builtin_amdgcn_permlane32_swap(__float_as_uint(ps), __float_as_uint(ps), false, false); ps = __uint_as_float(rr[0]) + __uint_as_float(rr[1]); }
    l_reg += ps;
    i32x8 pa;
#pragma unroll
    for (int w = 0; w < 4; ++w) { pa[w] = (int)pk4_fp8(p0[4 * w], p0[4 * w + 1], p0[4 * w + 2], p0[4 * w + 3]); pa[4 + w] = (int)pk4_fp8(p1[4 * w], p1[4 * w + 1], p1[4 * w + 2], p1[4 * w + 3]); }
    return pa;
}
#define MFMA8(a, b, c) __builtin_amdgcn_mfma_scale_f32_32x32x64_f8f6f4(a, b, c, 0, 0, 0, 0, 0, 0)
#ifndef ATT_FENCE
#define ATT_FENCE 1
#endif
#if ATT_FENCE
#define SB0() __builtin_amdgcn_sched_barrier(0)
#else
#define SB0() do {} while (0)
#endif
#define ATT_EXP(x) (VAR == 1 ? (x) * 1.0009765625f : __builtin_amdgcn_exp2f(x))
#define SM_CHUNK(P0, P1, PA, PS, c) do { if constexpr (VAR == 3) { PA[c] = __float_as_int(P0[4 * (c)]); PA[4 + (c)] = __float_as_int(P1[4 * (c)]); } else { \
    _Pragma("unroll") for (int r_ = 4 * (c); r_ < 4 * (c) + 4; ++r_) { P0[r_] = ATT_EXP(P0[r_]); P1[r_] = ATT_EXP(P1[r_]); } \
    _Pragma("unroll") for (int r_ = 4 * (c); r_ < 4 * (c) + 4; ++r_) { PS += P0[r_]; PS += P1[r_]; } \
    PA[c] = (int)pk4_fp8(P0[4 * (c)], P0[4 * (c) + 1], P0[4 * (c) + 2], P0[4 * (c) + 3]); PA[4 + (c)] = (int)pk4_fp8(P1[4 * (c)], P1[4 * (c) + 1], P1[4 * (c) + 2], P1[4 * (c) + 3]); } } while (0)
__device__ __forceinline__ void sm_rescale(f32x16& p0, f32x16& p1, i32x8& pa, float& s_row, float& m_reg, float& l_reg, f32x16 (&o)[2], i32x8& qpad, LAS float* al_l, int r32, int hi, bool first) {
    float d = ceilf(__log2f(fmaxf(s_row, 1e-30f))) - 4.f; d = fminf(fmaxf(d, first ? -100.f : 0.f), 100.f);
    const float xo = m_reg - PSH; const float xn = xo + d;
    unsigned qb_ = __builtin_amdgcn_cvt_pk_fp8_f32(-xn, 0.f, 0u, false) & 0xffu; float xq = -__builtin_amdgcn_cvt_f32_fp8((int)qb_, 0);
    if (xq < xn) { const float st = __builtin_amdgcn_exp2f(floorf(__log2f(fabsf(xq) + 1e-9f)) - 3.f); qb_ = __builtin_amdgcn_cvt_pk_fp8_f32(-(xq + st), 0.f, 0u, false) & 0xffu; xq = -__builtin_amdgcn_cvt_f32_fp8((int)qb_, 0); }
    const float dd = xq - xo, f = __builtin_amdgcn_exp2f(-dd);
    m_reg = xq + PSH; l_reg *= f; s_row *= f;
    if (hi == 0) al_l[r32] = f; asm volatile("s_waitcnt lgkmcnt(0)" ::: "memory");
    int hi_ = hi; asm volatile("" : "+v"(hi_));
#pragma unroll
    for (int dq = 0; dq < 2; ++dq)
#pragma unroll
        for (int r = 0; r < 16; ++r) o[dq][r] *= al_l[crow(r, hi_)];
#pragma unroll
    for (int r = 0; r < 16; ++r) { p0[r] *= f; p1[r] *= f; }
#pragma unroll
    for (int w = 0; w < 4; ++w) { pa[w] = (int)pk4_fp8(p0[4 * w], p0[4 * w + 1], p0[4 * w + 2], p0[4 * w + 3]); pa[4 + w] = (int)pk4_fp8(p1[4 * w], p1[4 * w + 1], p1[4 * w + 2], p1[4 * w + 3]); }
    if (hi_) qpad[0] = (int)qb_;
}
#define SM_FIN(PS, L, P0, P1, PA, M, O, QP, AL, FIRST) do { float s_ = PS; { auto rr_ = __builtin_amdgcn_permlane32_swap(__float_as_uint(s_), __float_as_uint(s_), false, false); s_ = __uint_as_float(rr_[0]) + __uint_as_float(rr_[1]); } \
    if (__builtin_expect((FIRST) || !__all(s_ <= 256.f), 0)) sm_rescale(P0, P1, PA, s_, M, L, O, QP, AL, r32, hi, FIRST); \
    L += s_; } while (0)
template <int VAR> __device__ __forceinline__ f32x16 mfv(const i32x8& a, const i32x8& b, f32x16 c) {
    if constexpr (VAR == 2) { asm volatile("" : "+v"(c)); return c; } else return __builtin_amdgcn_mfma_scale_f32_32x32x64_f8f6f4(a, b, c, 0, 0, 0, 0, 0, 0);
}
template <int VAR = 0>
__device__ __forceinline__ void attn_unit_p(const bf16_t* __restrict__ Qb, const unsigned char* __restrict__ K8t, const unsigned char* __restrict__ VTt, bf16_t* __restrict__ Ob, int ldo, int ntile, bool rope, int pos0, int nvalid, LAS char* lds, const int tid) {
#define MF(a, b, c) mfv<VAR>(a, b, c)
#define MFZ(a, b, cold) (VAR == 2 ? mfv<VAR>(a, b, cold) : mfv<VAR>(a, b, z))

    const int wid = __builtin_amdgcn_readfirstlane(tid >> 6), lane = tid & 63, r32 = lane & 31, hi = lane >> 5;
    LAS float* wsf = (LAS float*)(lds + OFF_WS) + wid * 128;
    i32x8 qX[2], qY[2];
    { const int rx = wid * 64 + r32, ry = rx + 32; const int cx = rx < nvalid ? rx : rx % nvalid, cy = ry < nvalid ? ry : ry % nvalid;
      load_q(qX, (const char*)Qb, (unsigned)cx * 1536u, hi, rope, pos0 + rx); load_q(qY, (const char*)Qb, (unsigned)cy * 1536u, hi, rope, pos0 + ry); }
    if (wid >= 4) __builtin_amdgcn_s_setprio(1);
    float mX = 0.f, mY = 0.f, lX = 0.f, lY = 0.f; f32x16 oX[2] = {}, oY[2] = {};
    { const unsigned qb_ = __builtin_amdgcn_cvt_pk_fp8_f32(PSH, 0.f, 0u, false) & 0xffu; if (hi) { qX[1][0] = (int)qb_; qY[1][0] = (int)qb_; } }
    const int kst = (tid >> 3) * KROW + (tid & 7) * 16, vst = OFF_V + (tid >> 2) * VROW + (tid & 3) * 16; const bool vth = wid < 4;
    const int kfo = r32 * KROW + hi * 32, vfo = OFF_V + r32 * VROW + hi * 32;
    const unsigned toff = (unsigned)tid * 16u;
    unsigned zz_ = 0u; asm volatile("" : "+v"(zz_));
    u32x4 sk, sv = {zz_, zz_, zz_, zz_};
#define LDK(t) (sk = *(const u32x4*)(K8t + (size_t)(t) * 8192 + toff))
#define LDV(t) do { if (vth) sv = *(const u32x4*)(VTt + (size_t)(t) * 4096 + toff); } while (0)
#define WRK(s) (*(LAS u32x4*)(lds + (s) * SLOT_K + kst) = sk)
#define WRV(s) do { if (vth) *(LAS u32x4*)(lds + (s) * SLOT_V + vst) = sv; } while (0)
    LDK(0); LDV(0); WRK(0); WRV(0); if (1 < ntile) { LDK(1); WRK(1); } if (2 < ntile) LDK(2); if (1 < ntile) LDV(1);
    if (tid < 320) *(LAS u32x4*)(lds + OFF_V + 2 * SLOT_V + tid * 16) = (u32x4){zz_, zz_, zz_, zz_};
    __syncthreads();
    f32x16 pX0, pX1, pY0, pY1; i32x8 paX, paY = {};
    i32x8 kc0, kc1;
    { const LAS char* kb = lds + kfo; const f32x16 z = {};
      kc0 = ld32(kb); kc1 = ld32(kb + 32 * KROW); pX0 = MFZ(kc0, qX[0], pX0); pX1 = MFZ(kc1, qX[0], pX1);
      { const i32x8 k0 = ld32(kb + 64), k1 = ld32(kb + 32 * KROW + 64); pX0 = MF(k0, qX[1], pX0); pX1 = MF(k1, qX[1], pX1); } }
    asm volatile("s_nop 0\n\ts_nop 0\n\ts_nop 0\n\ts_nop 0\n\t" ::);
    int s0 = 0, s1 = 1, s2 = 2;
    for (int t = 0; t < ntile; ++t) {
        if constexpr (VAR != 4) __syncthreads();
        i32x8 w0, w1;
        {   const LAS char* vb = lds + s2 * SLOT_V + vfo; const LAS char* kb = lds + s0 * SLOT_K + kfo; const LAS char* vb2 = lds + s0 * SLOT_V + vfo; const f32x16 z = {};
            float ps = 0.f; SB0();
            pY0 = MFZ(kc0, qY[0], pY0); const i32x8 k2 = ld32(kb + 64);
            if (t + 2 < ntile) WRK(s2); if (t + 1 < ntile) WRV(s1);
            if (t + 3 < ntile) LDK(t + 3); if (t + 2 < ntile) LDV(t + 2);
            SM_CHUNK(pX0, pX1, paX, ps, 0); SB0();
            pY1 = MFZ(kc1, qY[0], pY1); const i32x8 k3 = ld32(kb + 32 * KROW + 64);
            SM_CHUNK(pX0, pX1, paX, ps, 1); SB0();
            pY0 = MF(k2, qY[1], pY0); const i32x8 v0 = ld32(vb);
            SM_CHUNK(pX0, pX1, paX, ps, 2); SB0();
            pY1 = MF(k3, qY[1], pY1); const i32x8 v1 = ld32(vb + 32 * VROW);
            SM_CHUNK(pX0, pX1, paX, ps, 3); SB0();
            oY[0] = MF(paY, v0, oY[0]); w0 = ld32(vb2); oY[1] = MF(paY, v1, oY[1]); w1 = ld32(vb2 + 32 * VROW);
            SM_FIN(ps, lX, pX0, pX1, paX, mX, oX, qX[1], wsf, t == 0); SB0();
        }
        {   const LAS char* kb = lds + s1 * SLOT_K + kfo; const f32x16 z = {};
            float ps = 0.f; SB0();
            oX[0] = MF(paX, w0, oX[0]); kc0 = ld32(kb);
            SM_CHUNK(pY0, pY1, paY, ps, 0); SB0();
            oX[1] = MF(paX, w1, oX[1]); kc1 = ld32(kb + 32 * KROW);
            SM_CHUNK(pY0, pY1, paY, ps, 1); SB0();
            pX0 = MFZ(kc0, qX[0], pX0); const i32x8 k2 = ld32(kb + 64);
            SM_CHUNK(pY0, pY1, paY, ps, 2); SB0();
            pX1 = MFZ(kc1, qX[0], pX1); const i32x8 k3 = ld32(kb + 32 * KROW + 64);
            SM_CHUNK(pY0, pY1, paY, ps, 3); SB0();
            pX0 = MF(k2, qX[1], pX0); pX1 = MF(k3, qX[1], pX1);
            SM_FIN(ps, lY, pY0, pY1, paY, mY, oY, qY[1], wsf + 32, t == 0); SB0();
        }
        { const int ts = s0; s0 = s1; s1 = s2; s2 = ts; }
    }
    { const LAS char* vb = lds + s2 * SLOT_V + vfo; const i32x8 v0 = ld32(vb), v1 = ld32(vb + 32 * VROW); oY[0] = MF(paY, v0, oY[0]); oY[1] = MF(paY, v1, oY[1]); }
#undef LDK
#undef LDV
#undef WRK
#undef WRV
    if (hi == 0) { wsf[64 + r32] = lX; wsf[96 + r32] = lY; } asm volatile("s_waitcnt lgkmcnt(0)" ::: "memory");
    LAS bf16_t* stg = (LAS bf16_t*)(lds + OFF_OST) + wid * 4096;
#pragma unroll
    for (int r = 0; r < 16; ++r) { const int orow = crow(r, hi); const float rx = __builtin_amdgcn_rcpf(wsf[64 + orow]), ry = __builtin_amdgcn_rcpf(wsf[96 + orow]);
#pragma unroll
        for (int d0 = 0; d0 < 2; ++d0) { stg[orow * 64 + d0 * 32 + r32] = (bf16_t)(cvt_pk_bf16(oX[d0][r] * rx, 0.f) & 0xffffu); stg[(32 + orow) * 64 + d0 * 32 + r32] = (bf16_t)(cvt_pk_bf16(oY[d0][r] * ry, 0.f) & 0xffffu); } }
    asm volatile("s_waitcnt lgkmcnt(0)" ::: "memory");
#pragma unroll
    for (int i = 0; i < 8; ++i) { const int row = i * 8 + (lane >> 3), ch = lane & 7; const u32x4 v = *(const LAS u32x4*)(stg + row * 64 + ch * 8);
        if (wid * 64 + row < nvalid) *(u32x2*)((char*)Ob + (unsigned)((wid * 64 + row) * ldo + ch * 8)) = bf8_to_fp8(v); }
    asm volatile("s_waitcnt lgkmcnt(0)" ::: "memory"); __builtin_amdgcn_s_setprio(0); __syncthreads();
}
#undef SB0
#undef MF
#undef MFZ
#undef ATT_EXP
#undef SM_CHUNK
#undef SM_FIN
#undef MFMA8
}

namespace dft {
__device__ __forceinline__ int v_st8(int k, int c) { const int kk = (k & ~0xC) | ((k & 4) << 1) | ((k & 8) >> 1); return ((kk >> 3) * 8 + (c >> 5)) * 512 + ((kk & 7) * 32 + (c & 31)) * 2; }
template <int MODE, int K>
__device__ __forceinline__ void unit(LAS char* lds, const bf16_t* __restrict__ F, const char* __restrict__ in, size_t in_stride, char* __restrict__ dst, int p0, int p1, const int tid) {
    const int wid = __builtin_amdgcn_readfirstlane(tid >> 6), lane = tid & 63, r32 = lane & 31, hi = lane >> 5;
    { constexpr int NJ = K / 16; bf16x8 v[NJ];
#pragma unroll
      for (int j = 0; j < NJ; ++j) v[j] = *reinterpret_cast<const bf16x8*>(in + (size_t)((tid >> 5) + 16 * j) * in_stride + (tid & 31) * 16);
#pragma unroll
      for (int j = 0; j < NJ; ++j) *(LAS bf16x8*)(lds + v_st8((tid >> 5) + 16 * j, (tid & 31) * 8)) = v[j];
    }
    __syncthreads();
    f32x16 acc[8];
#pragma unroll
    for (int d = 0; d < 8; ++d) acc[d] = f32x16{};
    const int vb0 = (int)(uintptr_t)lds + att::v_rd_base(lane);
    const bf16_t* Fw = F + (size_t)(wid * 32 + r32) * K + hi * 8;
#pragma unroll 1
    for (int kb = 0; kb < K / 16; kb += 4) {
    bf16x8 af[4];
#pragma unroll
    for (int j = 0; j < 4; ++j) af[j] = *reinterpret_cast<const bf16x8*>(Fw + (kb + j) * 16);
#pragma unroll
    for (int j = 0; j < 4; ++j) { const int ks = kb + j;
        const bf16x8 a = af[j];
        const int vb = vb0 + ks * 8192;
        {   s16x4 lo[4], hh[4];
            lo[0] = att::tr_read<0 * 512>(vb); hh[0] = att::tr_read<0 * 512 + 4096>(vb); lo[1] = att::tr_read<1 * 512>(vb); hh[1] = att::tr_read<1 * 512 + 4096>(vb);
            lo[2] = att::tr_read<2 * 512>(vb); hh[2] = att::tr_read<2 * 512 + 4096>(vb); lo[3] = att::tr_read<3 * 512>(vb); hh[3] = att::tr_read<3 * 512 + 4096>(vb);
            asm volatile("s_waitcnt lgkmcnt(0)" ::: "memory"); __builtin_amdgcn_sched_barrier(0);
#pragma unroll
            for (int d = 0; d < 4; ++d) { const bf16x8 b = (bf16x8){lo[d][0], lo[d][1], lo[d][2], lo[d][3], hh[d][0], hh[d][1], hh[d][2], hh[d][3]};
                acc[d] = __builtin_amdgcn_mfma_f32_32x32x16_bf16(a, b, acc[d], 0, 0, 0); } }
        {   s16x4 lo[4], hh[4];
            lo[0] = att::tr_read<4 * 512>(vb); hh[0] = att::tr_read<4 * 512 + 4096>(vb); lo[1] = att::tr_read<5 * 512>(vb); hh[1] = att::tr_read<5 * 512 + 4096>(vb);
            lo[2] = att::tr_read<6 * 512>(vb); hh[2] = att::tr_read<6 * 512 + 4096>(vb); lo[3] = att::tr_read<7 * 512>(vb); hh[3] = att::tr_read<7 * 512 + 4096>(vb);
            asm volatile("s_waitcnt lgkmcnt(0)" ::: "memory"); __builtin_amdgcn_sched_barrier(0);
#pragma unroll
            for (int d = 0; d < 4; ++d) { const bf16x8 b = (bf16x8){lo[d][0], lo[d][1], lo[d][2], lo[d][3], hh[d][0], hh[d][1], hh[d][2], hh[d][3]};
                acc[4 + d] = __builtin_amdgcn_mfma_f32_32x32x16_bf16(a, b, acc[4 + d], 0, 0, 0); } }
    } }
    if (MODE == 0) {
#pragma unroll
        for (int g = 0; g < 2; ++g)
#pragma unroll
            for (int i = 0; i < 4; ++i) { const int k1 = 16 * wid + 8 * g + 4 * hi + i; float sn, cs; sincospif((float)(k1 * p1) * (1.0f / 8192.0f), &sn, &cs);
#pragma unroll
                for (int d = 0; d < 8; ++d) { const float yr = acc[d][8 * g + i], yi = acc[d][8 * g + 4 + i]; acc[d][8 * g + i] = yr * cs + yi * sn; acc[d][8 * g + 4 + i] = yi * cs - yr * sn; } }
    }
    __syncthreads();
    LAS bf16_t* stg = (LAS bf16_t*)lds + wid * 8192;
#pragma unroll
    for (int r = 0; r < 16; ++r) { const int orow = att::crow(r, hi);
#pragma unroll
        for (int d = 0; d < 8; ++d) stg[orow * 256 + d * 32 + r32] = (bf16_t)(cvt_pk_bf16(acc[d][r], 0.f) & 0xffffu); }
    asm volatile("s_waitcnt lgkmcnt(0)" ::: "memory");
#pragma unroll
    for (int it = 0; it < 16; ++it) { const int id = it * 64 + lane, rho = id >> 5, ch = id & 31; const u32x4 v = *(const LAS u32x4*)(stg + rho * 256 + ch * 8);
        size_t off;
        if (MODE == 0) { const int part = (rho >> 3) & 1, k1 = 16 * wid + (((rho >> 4) << 3) | (rho & 7)); off = ((((size_t)p0 * 128 + k1) * 128 + p1) * 2 + part) * 512; }
        else if (MODE == 1) { const int m = wid * 32 + rho, zp = m >> 7, k2 = m & 127; off = ((size_t)(p0 * SEQ + p1 + 128 * k2) * NINP + 256 + zp * 256); }
        else { const int m = wid * 32 + rho; off = ((size_t)(TL + p0 * CTXL + m) * NINP + 256 + p1 * 256); }
        if (MODE == 0) *(u32x4*)(dst + off + ch * 16) = v; else *(u32x2*)(dst + off + ch * 8) = bf8_to_fp8(v); }
    asm volatile("s_waitcnt lgkmcnt(0)" ::: "memory"); __syncthreads();
}
}


#ifndef SELFCHECK
#define SELFCHECK 0
#endif
#ifndef SELFCHECK_REPORT
#define SELFCHECK_REPORT 1
#endif
#if SELFCHECK
constexpr int CW_CHK = 64;
__device__ __forceinline__ float fp8q(float x) { const unsigned w = __builtin_amdgcn_cvt_pk_fp8_f32(x, 0.f, 0u, false); return __builtin_amdgcn_cvt_f32_fp8((int)w, 0); }
__device__ __forceinline__ float bf2f(bf16_t v) { return __uint_as_float(((unsigned)v) << 16); }
__device__ __forceinline__ float chk_invfreq(int j) { return j == 0 ? 1.0f : j == 1 ? 0.316227766f : j == 2 ? 0.1f : j == 3 ? 0.0316227766f : j == 4 ? 0.01f : j == 5 ? 0.00316227766f : j == 6 ? 0.001f : 0.000316227766f; }
__device__ __forceinline__ void chk_sincos(float a, float& s, float& c) { const float k = rintf(a * 0.15915494309189535f); float r = fmaf(-k, 6.28125f, a); r = fmaf(-k, 1.9353071795864769e-3f, r); s = __sinf(r); c = __cosf(r); }
__device__ __forceinline__ void selfcheck_attn(int l, const bf16_t* Q, const unsigned char* K8, const bf16_t* Vb, const unsigned char* VT8, const bf16_t* YA, const bf16_t* Ub, const bf16_t* WuqT, const bf16_t* WukvT, unsigned* flag, LAS float* sm, int wave_g, int lane) {
    if (wave_g < 32) {
        const int i = wave_g, b = i & 1, h = (i >> 1) & 7, t = (i * 521 + 37 + 4099 * (i >> 4)) & (SEQ - 1); const int row = b * SEQ + t;
        LAS float* q = sm;
        for (int d = lane; d < 96; d += 64) q[d] = bf2f(Q[(size_t)row * 768 + h * 96 + d]);
        __builtin_amdgcn_s_waitcnt(0);
        float nv[2] = {0.f, 0.f};
        if (lane < 16) { const int ax = lane >> 3, j = lane & 7; const float pos = (float)(ax == 0 ? (t >> 6) : (t & 63)); const float ang = pos * chk_invfreq(j);
            float cs, sn; chk_sincos(ang, sn, cs); const float x1 = q[64 + 16 * ax + j], x2 = q[64 + 16 * ax + 8 + j]; nv[0] = x1 * cs - x2 * sn; nv[1] = x2 * cs + x1 * sn; }
        __builtin_amdgcn_s_waitcnt(0);
        if (lane < 16) { const int ax = lane >> 3, j = lane & 7; q[64 + 16 * ax + j] = nv[0]; q[64 + 16 * ax + 8 + j] = nv[1]; }
        __builtin_amdgcn_s_waitcnt(0);
        for (int d = lane; d < 96; d += 64) q[d] = fp8q(q[d] * (0.10206207261596575f * 1.4426950408889634f));
        __builtin_amdgcn_s_waitcnt(0);
        const unsigned char* Kh = K8 + (size_t)(b * NH + h) * LK * 128; const bf16_t* Vh = Vb + (size_t)(b * NH + h) * LK * DV;
        float mx = -1e30f, m0 = -1e30f;
        for (int k0 = 0; k0 < LK; k0 += 64) { const unsigned char* kr = Kh + (size_t)(k0 + lane) * 128; float s = 0.f;
            for (int d = 0; d < 96; d += 4) { const unsigned w = *(const unsigned*)(kr + d);
                s += q[d] * __builtin_amdgcn_cvt_f32_fp8((int)w, 0) + q[d + 1] * __builtin_amdgcn_cvt_f32_fp8((int)w, 1) + q[d + 2] * __builtin_amdgcn_cvt_f32_fp8((int)w, 2) + q[d + 3] * __builtin_amdgcn_cvt_f32_fp8((int)w, 3); }
            mx = fmaxf(mx, s); if (k0 == 0) m0 = s; }
        for (int o = 1; o < 64; o <<= 1) { mx = fmaxf(mx, shx(mx, o, lane)); m0 = fmaxf(m0, shx(m0, o, lane)); }
        const float mref = ceilf(m0); const bool skip = (mx - mref) > 5.9f;
        float acc[64]; float lsum = 0.f;
#pragma unroll
        for (int d = 0; d < 64; ++d) acc[d] = 0.f;
        for (int k0 = 0; k0 < LK; k0 += 64) { const unsigned char* kr = Kh + (size_t)(k0 + lane) * 128; float s = 0.f;
            for (int d = 0; d < 96; d += 4) { const unsigned w = *(const unsigned*)(kr + d);
                s += q[d] * __builtin_amdgcn_cvt_f32_fp8((int)w, 0) + q[d + 1] * __builtin_amdgcn_cvt_f32_fp8((int)w, 1) + q[d + 2] * __builtin_amdgcn_cvt_f32_fp8((int)w, 2) + q[d + 3] * __builtin_amdgcn_cvt_f32_fp8((int)w, 3); }
            const float p = __builtin_amdgcn_exp2f(s - (mref - 2.0f)); lsum += p; const float pq = fp8q(p); const bf16_t* vr = Vh + (size_t)(k0 + lane) * DV;
#pragma unroll
            for (int d = 0; d < 64; ++d) acc[d] += pq * fp8q(bf2f(vr[d])); }
        lsum = wave_sum(lsum, lane);
        float worst = 0.f;
#pragma unroll
        for (int d = 0; d < 64; ++d) { const float o = wave_sum(acc[d], lane) / lsum; const float got = bf2f(YA[(size_t)row * NINP + 768 + h * 64 + d]); worst = fmaxf(worst, fabsf(got - o) - 0.0042f * fabsf(o)); }
        if (skip) worst = 0.f;
        if (lane == 0) atomicMax(flag + 1 + l, (unsigned)(worst * 1.0e6f));
        if (lane == 0 && !(worst < 3e-3f)) atomicOr(flag, 1u << l);
    }
    else if (wave_g < 64) {
        const int i = wave_g - 32, b = i & 1, t = (i * 977 + 13) & (SEQ - 1); const int row = b * SEQ + t, key = CTXL + t;
        unsigned bad = 0;
        if (lane < 32) { const int d = lane, ax = d >> 4, j = d & 7, second = (d >> 3) & 1; const float pos = (float)(ax == 0 ? (t >> 6) : (t & 63)); const float ang = pos * chk_invfreq(j);
            float cs, sn; chk_sincos(ang, sn, cs); const float x1 = bf2f(Ub[(size_t)row * NINP + COL_KR + 16 * ax + j]), x2 = bf2f(Ub[(size_t)row * NINP + COL_KR + 16 * ax + 8 + j]);
            const float ref = second ? x2 * cs + x1 * sn : x1 * cs - x2 * sn; const float rq = fp8q(ref);
            for (int h = 0; h < NH; ++h) { const unsigned char* kr = K8 + ((size_t)(b * NH + h) * LK + key) * 128; const float got = __builtin_amdgcn_cvt_f32_fp8((int)kr[64 + d], 0);
                if (fabsf(got - rq) > 0.13f * fabsf(rq) + 1e-3f) bad |= 1u; if (kr[96 + d] != (d == 0 ? 0x38 : 0)) bad |= 2u; } }
        { const int h = lane & 7, jj = lane >> 3; float ak = 0.f, av = 0.f, aq = 0.f; const int jk = jj & 3; const int qd = (jj < 4) ? jj : 88 + jj;
          for (int k = 0; k < 256; ++k) { const float u = bf2f(Ub[(size_t)row * NINP + COL_KV + k]); ak += u * bf2f(WukvT[(size_t)(h * 128 + 17 * jk) * 256 + k]); av += u * bf2f(WukvT[(size_t)(h * 128 + 64 + 15 * jk) * 256 + k]); }
          for (int k = 0; k < 384; ++k) aq += bf2f(Ub[(size_t)row * NINP + COL_Q + k]) * bf2f(WuqT[(size_t)(h * 96 + qd) * 384 + k]);
          const float gk = __builtin_amdgcn_cvt_f32_fp8((int)K8[((size_t)(b * NH + h) * LK + key) * 128 + 17 * jk], 0), gv = bf2f(Vb[((size_t)(b * NH + h) * LK + key) * DV + 15 * jk]), gq = bf2f(Q[(size_t)row * 768 + h * 96 + qd]);
          if (fabsf(gk - ak) > 0.08f * fabsf(ak) + 0.02f) bad |= 4u; if (fabsf(gv - av) > 0.02f * fabsf(av) + 0.01f) bad |= 8u; if (fabsf(gq - aq) > 0.02f * fabsf(aq) + 0.01f) bad |= 16u;
          const int tl = key >> 6, kin = key & 63, kk = kin & 31, khi = (kk >> 2) & 1, kr_ = (kk & 3) + 4 * (kk >> 3), kpos = khi * 32 + (kin >> 5) * 16 + kr_;
          const float gt = __builtin_amdgcn_cvt_f32_fp8((int)VT8[((size_t)(b * NH + h) * 260 + tl) * 4096 + (15 * jk) * 64 + kpos], 0);
          if (gt != fp8q(gv)) bad |= 32u; }
        if (bad) atomicOr(flag, bad << (8 + 8 * l));
    }
}
#endif
__device__ __forceinline__ int perm256(int n) { const int c = n & 255; return (n & ~255) + 128 * ((c >> 3) & 1) + 32 * (c >> 6) + 16 * ((c >> 2) & 1) + 4 * ((c >> 4) & 3) + (c & 3); }
__device__ __forceinline__ void tr_item(const float* __restrict__ W, int ldS, const float* __restrict__ rs, bf16_t* __restrict__ WT, int ldD, int col0D, int nblk, int rowmode, LAS float* scr, int item, int lane, float f8scale = 0.f) {
    const int kb = item / nblk, nb = item % nblk, k0 = 64 * kb, n0 = 32 * nb;
#pragma unroll
    for (int i = 0; i < 32; ++i) { const int kk = 2 * i + (lane >> 5); float v = W[(size_t)(k0 + kk) * ldS + n0 + (lane & 31)]; if (rs) v *= rs[k0 + kk]; scr[kk * 33 + (lane & 31)] = v; }
    LDS_WAIT(); asm volatile("" ::: "memory");
    const int c = lane & 7;
#pragma unroll
    for (int j = 0; j < 4; ++j) { const int n = (lane >> 3) + 8 * j; const LAS float* s = scr + (8 * c) * 33 + n;
        u32x4 o; o.x = cvt_pk_bf16(s[0 * 33], s[1 * 33]); o.y = cvt_pk_bf16(s[2 * 33], s[3 * 33]); o.z = cvt_pk_bf16(s[4 * 33], s[5 * 33]); o.w = cvt_pk_bf16(s[6 * 33], s[7 * 33]);
        const int ns = n0 + n; const int nd = rowmode == 0 ? ns : (rowmode == 3 ? perm256(ns) : (8 * (ns >> 2) + (ns & 3) + (rowmode == 2 ? 4 : 0)));
        if (f8scale != 0.f) { u32x2 o8; o8.x = pk4_fp8(s[0 * 33] * f8scale, s[1 * 33] * f8scale, s[2 * 33] * f8scale, s[3 * 33] * f8scale); o8.y = pk4_fp8(s[4 * 33] * f8scale, s[5 * 33] * f8scale, s[6 * 33] * f8scale, s[7 * 33] * f8scale);
            *(u32x2*)((unsigned char*)WT + (size_t)nd * ldD + col0D + k0 + 8 * c) = o8; }
        else *(u32x4*)(WT + (size_t)nd * ldD + col0D + k0 + 8 * c) = o; }
    LDS_WAIT(); asm volatile("" ::: "memory");
}

struct TrDesc { const float* W; unsigned char* WT; int ldS, ldD, rowmode, k0, n0; float sc; };
__device__ __forceinline__ void tr8_load(const TrDesc& d, float (&v)[32], int lane) {
    unsigned off = (unsigned)((d.k0 + (lane >> 5)) * d.ldS + d.n0 + (lane & 31)) * 4u; const unsigned step = (unsigned)d.ldS * 8u;
#pragma unroll
    for (int i = 0; i < 32; ++i) { v[i] = __builtin_nontemporal_load((const float*)((const char*)d.W + off)); off += step; }
}
__device__ __forceinline__ void tr8_store(const TrDesc& d, const float (&v)[32], LAS float* scr, int lane) {
#pragma unroll
    for (int i = 0; i < 32; ++i) scr[(2 * i + (lane >> 5)) * 33 + (lane & 31)] = v[i];
    LDS_WAIT(); asm volatile("" ::: "memory");
    const int c = lane & 7;
#pragma unroll
    for (int j = 0; j < 4; ++j) { const int n = (lane >> 3) + 8 * j; const LAS float* s = scr + (8 * c) * 33 + n;
        const int ns = d.n0 + n; int nd;
        if (d.rowmode == 0) { const int c = ns & 255; nd = (ns & ~255) + 128 * ((c >> 3) & 1) + 32 * (c >> 6) + 16 * ((c >> 2) & 1) + 4 * ((c >> 4) & 3) + (c & 3); }
        else { const int a = ns & 127; nd = 256 * (ns >> 7) + 128 * ((a >> 2) & 1) + 32 * (a >> 5) + (d.rowmode == 2 ? 16 : 0) + 4 * ((a >> 3) & 3) + (a & 3); }
        u32x2 o8; o8.x = pk4_fp8(s[0 * 33] * d.sc, s[1 * 33] * d.sc, s[2 * 33] * d.sc, s[3 * 33] * d.sc); o8.y = pk4_fp8(s[4 * 33] * d.sc, s[5 * 33] * d.sc, s[6 * 33] * d.sc, s[7 * 33] * d.sc);
        *(u32x2*)(d.WT + (unsigned)(nd * d.ldD + d.k0 + 8 * c)) = o8; }
    LDS_WAIT(); asm volatile("" ::: "memory");
}

struct Params { const float* in[26]; float* out; unsigned char* ws; int ph_lo, ph_hi, use_bar, pad; };
constexpr int NPH_L = 15, NPHASE = 2 + 2 * NPH_L;

template <bool XB16 = false, bool WB = true>
__device__ __forceinline__ void norm_rows(const void* __restrict__ xin_, bf16_t* __restrict__ hout, const float* __restrict__ g, const float* __restrict__ sh, const float* __restrict__ sc, int nrows, int lane, unsigned char* __restrict__ h8 = nullptr, float* __restrict__ rs = nullptr) {
    f32x4 gm[4], sv[4];
#pragma unroll
    for (int j = 0; j < 4; ++j) { const f32x4 gv = *(const f32x4*)(g + 4 * lane + 256 * j), s1 = *(const f32x4*)(sc + 4 * lane + 256 * j); gm[j] = gv * (s1 + 1.0f); sv[j] = *(const f32x4*)(sh + 4 * lane + 256 * j); }
    for (int r = 0; r < nrows; r += 2) {
        f32x4 v0[4], v1[4]; float s0 = 0.f, s1 = 0.f;
        if constexpr (XB16) { const u32x2* xr0 = (const u32x2*)((const bf16_t*)xin_ + (size_t)r * DM) + lane; const u32x2* xr1 = xr0 + DM / 4;
#pragma unroll
            for (int j = 0; j < 4; ++j) { const u32x2 a = xr0[64 * j], b = xr1[64 * j]; v0[j] = (f32x4){bf_lo(a.x), bf_hi(a.x), bf_lo(a.y), bf_hi(a.y)}; v1[j] = (f32x4){bf_lo(b.x), bf_hi(b.x), bf_lo(b.y), bf_hi(b.y)}; } }
        else { const f32x4* xr0 = (const f32x4*)((const float*)xin_ + (size_t)r * DM) + lane; const f32x4* xr1 = xr0 + DM / 4;
#pragma unroll
            for (int j = 0; j < 4; ++j) { v0[j] = xr0[64 * j]; v1[j] = xr1[64 * j]; } }
#pragma unroll
        for (int j = 0; j < 4; ++j) { s0 += (v0[j].x * v0[j].x + v0[j].y * v0[j].y) + (v0[j].z * v0[j].z + v0[j].w * v0[j].w); s1 += (v1[j].x * v1[j].x + v1[j].y * v1[j].y) + (v1[j].z * v1[j].z + v1[j].w * v1[j].w); }
        const float rstd0 = rsqrtf(wave_sum(s0, lane) * (1.0f / DM) + EPS), rstd1 = rsqrtf(wave_sum(s1, lane) * (1.0f / DM) + EPS);
        u32x2* o0 = (u32x2*)(hout + (size_t)r * DM) + lane; u32x2* o1 = o0 + DM / 4;
        if constexpr (!WB) { if (rs && lane == 0) { rs[r] = rstd0; rs[r + 1] = rstd1; } }
#pragma unroll
        for (int j = 0; j < 4; ++j) { const f32x4 y0 = v0[j] * rstd0 * gm[j] + sv[j], y1 = v1[j] * rstd1 * gm[j] + sv[j]; if constexpr (WB) { u32x2 w0, w1; w0.x = cvt_pk_bf16(y0.x, y0.y); w0.y = cvt_pk_bf16(y0.z, y0.w); w1.x = cvt_pk_bf16(y1.x, y1.y); w1.y = cvt_pk_bf16(y1.z, y1.w); o0[64 * j] = w0; o1[64 * j] = w1; }
            if (h8) { ((unsigned*)(h8 + (size_t)r * DM))[lane + 64 * j] = pk4_fp8(y0.x, y0.y, y0.z, y0.w); ((unsigned*)(h8 + (size_t)(r + 1) * DM))[lane + 64 * j] = pk4_fp8(y1.x, y1.y, y1.z, y1.w); } }
    }
}

#define PHASE_BEGIN unsigned zo_ = 0; int z_ = 0; int tid; asm volatile("v_mbcnt_lo_u32_b32 %0, -1, 0\n\tv_mbcnt_hi_u32_b32 %0, -1, %0" : "=v"(tid)); tid += wave0_ * 64; int bx = blockIdx.x; int G = gridDim.x; LAS unsigned char* ldsp = lds; asm volatile("" : "+s"(zo_), "+s"(z_), "+v"(tid), "+s"(bx), "+s"(G), "+s"(ldsp)); \
    zo_ = (unsigned)__builtin_amdgcn_readfirstlane((int)zo_); z_ = __builtin_amdgcn_readfirstlane(z_); bx = __builtin_amdgcn_readfirstlane(bx); G = __builtin_amdgcn_readfirstlane(G); ldsp = (LAS unsigned char*)(unsigned)__builtin_amdgcn_readfirstlane((int)(unsigned)(uintptr_t)ldsp);     \
    (void)ldsp; unsigned char* wsp = P.ws + zo_; \
    const int lane = tid & 63, wave = __builtin_amdgcn_readfirstlane(tid >> 6); const int vcu = (G % 8 == 0) ? (bx % 8) * (G / 8) + bx / 8 : bx; const int gw = vcu * 8 + wave, NGW = G * 8; (void)lane; (void)wave; (void)vcu; (void)gw; (void)NGW
#define INP(k) (P.in[(k) + z_])
#define CV_NIT (NEX * 384)
#define CV_ON (G == 256)
#define CV_Q6 8
#define CV_Q8 7
#define CV_A (CV_ON ? 248 * 8 * CV_Q6 : 0)
#define CV_B (CV_ON ? CV_NIT - 126 * 8 * CV_Q8 : CV_NIT)
#define TR_DESC(D, it_) do { const int e_ = (it_) / 384, r_ = (it_) % 384, q_ = r_ & 127; \
                if (r_ < 128) { D.W = e_ < NE ? INP(19) + ((size_t)l * NE + e_) * DM * DE : INP(22) + (size_t)l * DM * DE; D.WT = P_EWGU8 + (size_t)e_ * 512 * 1024; D.ldS = DE; D.ldD = DM; D.rowmode = 1; D.k0 = 64 * (q_ >> 3); D.n0 = 32 * (q_ & 7); D.sc = 32.0f; } \
                else if (r_ < 256) { D.W = e_ < NE ? INP(20) + ((size_t)l * NE + e_) * DM * DE : INP(23) + (size_t)l * DM * DE; D.WT = P_EWGU8 + (size_t)e_ * 512 * 1024; D.ldS = DE; D.ldD = DM; D.rowmode = 2; D.k0 = 64 * (q_ >> 3); D.n0 = 32 * (q_ & 7); D.sc = 32.0f; } \
                else { D.W = e_ < NE ? INP(21) + ((size_t)l * NE + e_) * DE * DM : INP(24) + (size_t)l * DE * DM; D.WT = (unsigned char*)P_EWD + (size_t)e_ * 1024 * 256; D.ldS = DM; D.ldD = DE; D.rowmode = 0; D.k0 = 64 * (q_ >> 5); D.n0 = 32 * (q_ & 31); D.sc = 16.0f; } } while (0)
#define CONVERT_ITEMS(first_, step_, end_) do { int it = (first_); const int st_ = (step_), en_ = (end_);     \
                if (it < en_) { TrDesc d0, d1; float va[32], vb[32]; TR_DESC(d0, it); d1 = d0; \
                    { const float zf_ = (float)z_;                  \
                      _Pragma("unroll") for (int i = 0; i < 32; ++i) vb[i] = zf_; } \
                    tr8_load(d0, va, lane); \
                    for (;;) { \
                        const int it1 = it + st_; const bool h1 = it1 < en_; if (h1) { TR_DESC(d1, it1); tr8_load(d1, vb, lane); } \
                        tr8_store(d0, va, scr, lane); if (!h1) break; \
                        const int it2 = it1 + st_; const bool h2 = it2 < en_; if (h2) { TR_DESC(d0, it2); tr8_load(d0, va, lane); } \
                        tr8_store(d1, vb, scr, lane); if (!h2) break; \
                        it = it2; } } } while (0)
#define P_MODS ((float*)(wsp + WS_MODS))
#define P_XS ((bf16_t*)(wsp + WS_XS))
#define P_HQ ((bf16_t*)(wsp + WS_HQ))
#define P_U ((bf16_t*)(wsp + WS_U))
#define P_KB ((bf16_t*)(wsp + WS_KB))
#define P_VB ((bf16_t*)(wsp + WS_VB))
#define P_YA ((bf16_t*)(wsp + WS_YA))
#define P_YP ((bf16_t*)(wsp + WS_YP))
#define P_K8 ((unsigned char*)(wsp + WS_KB))
#define P_VT8 ((unsigned char*)(wsp + WS_VT8))
#define P_EWGU ((bf16_t*)(wsp + WS_EW))
#define P_EWD ((bf16_t*)(wsp + WS_EW + EW_GU_BYTES))
#define P_EWGU8 ((unsigned char*)(wsp + WS_EW))
#define P_H2F8 ((unsigned char*)(wsp + WS_EW + EW_GU_BYTES / 2))
#define P_ACT ((bf16_t*)(wsp + WS_ACT))
#define P_TOKL ((int*)(wsp + WS_TOKL))
#define P_TPOS ((int*)(wsp + WS_TPOS))
#define P_TW ((float*)(wsp + WS_TW))
#define P_LOG ((float*)(wsp + WS_LOG))
#define P_YB ((bf16_t*)(wsp + WS_YB))
#define P_RSTD ((float*)(wsp + WS_YB))
#define P_PB ((float*)(wsp + WS_PB))
#define P_F1 ((bf16_t*)(wsp + WS_F1))
#define P_F2 ((bf16_t*)(wsp + WS_F2))
#define P_FC ((bf16_t*)(wsp + WS_FC))
#define P_WCS ((float*)(wsp + WS_WCS))
#define P_DW(l) (wsp + WS_DW + (size_t)(l) * DW_LAYER)
#define P_GCNT(l) ((unsigned*)(wsp + WS_CTL) + CW_CNT + (l) * 64)

__global__ void __launch_bounds__(512, 2) mk_fwd(Params P) {
    extern __shared__ __attribute__((aligned(16))) unsigned char lds_raw[];
    LAS unsigned char* lds = (LAS unsigned char*)lds_raw;
    const int wave0_ = __builtin_amdgcn_readfirstlane((int)threadIdx.x >> 6);
    volatile LAS unsigned* MISC = (volatile LAS unsigned*)(lds + MISC_OFF);
    for (int u = threadIdx.x; u < 128; u += 512) MISC[u] = 0u;
    __syncthreads();
    XcdBarrier bar; bar.bar = (unsigned*)(P.ws + WS_CTL) + CW_BAR; bar.x = 0; bar.st = nullptr;
    if (P.use_bar) bar = xcd_barrier_post((unsigned*)(P.ws + WS_CTL) + CW_BAR, MISC + 8);
    const int lo = P.ph_lo, hi = P.ph_hi;
#define IN(k) ({ int lo_ = lo; asm volatile("" : "+s"(lo_)); lo_ = __builtin_amdgcn_readfirstlane(lo_); (lo_ <= (k) && (k) < hi); })
#define SEAM(k) do { if (IN(k) && IN((k) + 1)) { XcdBarrier bb_ = bar; unsigned zb_ = 0; int t0_; asm volatile("v_mbcnt_lo_u32_b32 %0, -1, 0\n\tv_mbcnt_hi_u32_b32 %0, -1, %0" : "=v"(t0_)); t0_ += wave0_ * 64; asm volatile("" : "+s"(zb_), "+s"(bb_.x)); zb_ = (unsigned)__builtin_amdgcn_readfirstlane((int)zb_); bb_.x = (unsigned)__builtin_amdgcn_readfirstlane((int)bb_.x); bb_.bar = (unsigned*)(P.ws + WS_CTL + zb_) + CW_BAR; for (int rb_ = 0; rb_ < REP_BAR; ++rb_) xcd_barrier(bb_, t0_); } } while (0)

    if (IN(0)) for (int rep_ = 0; rep_ < REP_PRO; ++rep_) {
        PHASE_BEGIN;
        {
            LAS float* sl = (LAS float*)lds;
            const float* c_in = INP(1); const float* cctx_in = INP(3);
            for (int i = tid; i < 3 * DM; i += 512) { const int v = i >> 10, d = i & 1023; const float cv = v < 2 ? c_in[v * DM + d] : cctx_in[d]; sl[i] = silu_f(cv); }
            __syncthreads();
            LAS float* red = sl + 3 * DM;
            for (int it = vcu; it < 192; it += G) {
                const int l = it / 96, n = (it % 96) * 64 + lane; const float* w = INP(4) + (size_t)l * DM * 6144 + n;
                float a0 = 0.f, a1 = 0.f, a2 = 0.f;
#pragma unroll 32
                for (int d = wave * 128; d < wave * 128 + 128; ++d) { const float wv = __builtin_nontemporal_load(w + (size_t)d * 6144); a0 += sl[d] * wv; a1 += sl[DM + d] * wv; a2 += sl[2 * DM + d] * wv; }
                red[(wave * 3 + 0) * 64 + lane] = a0; red[(wave * 3 + 1) * 64 + lane] = a1; red[(wave * 3 + 2) * 64 + lane] = a2;
                __syncthreads();
                if (wave < 3) { float s = 0.f;
#pragma unroll
                    for (int w8 = 0; w8 < 8; ++w8) s += red[(w8 * 3 + wave) * 64 + lane];
                    P_MODS[(l * 3 + wave) * 6144 + n] = s + INP(5)[l * 6144 + n]; }
                __syncthreads();
            }
            __syncthreads();
        }
        {
            LAS float* scr = (LAS float*)(lds + wave * 16384);
            constexpr int I_IN = 16 * 37, I_UQ = 6 * 24, I_UKV = 4 * 32, I_OUT = 8 * 32, I_L = I_IN + I_UQ + I_UKV + I_OUT;
            for (int it = gw; it < 2 * I_L; it += NGW) {
                const int l = it / I_L; int r = it % I_L; unsigned char* dw = P_DW(l);
                if (r < I_IN) { tr_item(INP(8) + (size_t)l * DM * 1184, 1184, nullptr, (bf16_t*)(dw + DW_WIN), DM, 0, 37, 0, scr, r, lane, 64.0f); continue; } r -= I_IN;
                if (r < I_UQ) { tr_item(INP(13) + (size_t)l * 384 * 768, 768, INP(12) + l * 384, (bf16_t*)(dw + DW_WUQ), 384, 0, 24, 0, scr, r, lane); continue; } r -= I_UQ;
                if (r < I_UKV) { tr_item(INP(15) + (size_t)l * 256 * 1024, 1024, INP(14) + l * 256, (bf16_t*)(dw + DW_WUKV), 256, 0, 32, 0, scr, r, lane); continue; } r -= I_UKV;
                tr_item(INP(16) + (size_t)l * DM * DM + (size_t)512 * DM, DM, nullptr, (bf16_t*)(dw + DW_WCOMB), NINP, 768, 32, 3, scr, r, lane, 64.0f);
            }
            for (int l = 0; l < 2; ++l) {
                u32x4* z1 = (u32x4*)(P_DW(l) + DW_WIN + (size_t)1184 * DM); const int n1 = 96 * DM / 16;
                for (int i = bx * 512 + tid; i < n1; i += G * 512) z1[i] = (u32x4){(unsigned)z_, (unsigned)z_, (unsigned)z_, (unsigned)z_};
            }
        }
        { bf16_t* F1 = P_F1; bf16_t* F2 = P_F2; bf16_t* FC = P_FC;
        for (int i = bx * 512 + tid; i < 256 * 128; i += G * 512) { const int m = i >> 7, l1 = i & 127, w = m >> 5, rho = m & 31, part = (rho >> 3) & 1, k1 = 16 * w + (((rho >> 4) << 3) | (rho & 7));
            float sn, cs; sincospif((float)((k1 * l1) & 127) * (1.0f / 64.0f), &sn, &cs); const float v = (part ? -sn : cs) * (1.0f / 128.0f); F1[i] = (bf16_t)(cvt_pk_bf16(v, 0.f) & 0xffffu); }
        for (int i = bx * 512 + tid; i < 256 * 256; i += G * 512) { const int m = i >> 8, j = i & 255, zp = m >> 7, k2 = m & 127, l2 = j >> 1, part = j & 1;
            float sn, cs; sincospif((float)((k2 * l2) & 127) * (1.0f / 64.0f), &sn, &cs); const float v = zp == 0 ? (part ? sn : cs) : (part ? cs : -sn); F2[i] = (bf16_t)(cvt_pk_bf16(v, 0.f) & 0xffffu); }
        for (int i = bx * 512 + tid; i < 512 * 256; i += G * 512) { const int m = i >> 8, l = i & 255, zp = m >> 8, k = m & 255;
            float sn, cs; sincospif((float)((k * l) & 255) * (1.0f / 128.0f), &sn, &cs); const float v = (zp ? -sn : cs) * (1.0f / 16.0f); FC[i] = (bf16_t)(cvt_pk_bf16(v, 0.f) & 0xffffu); } }
        { LAS float* tb = (LAS float*)lds;
          __syncthreads();
          if (tid < 64) { float sn, cs; sincospif((float)tid * (1.0f / 32.0f), &sn, &cs); tb[tid] = cs; tb[64 + tid] = sn; }
          __syncthreads();
          for (int i = bx * 512 + tid; i < 2 * 2 * 4 * 64 * 64; i += G * 512) { const int d = i & 63, c = (i >> 6) & 63, g = (i >> 12) & 3, cs_ = (i >> 14) & 1, l = i >> 15;
            const float* wf = INP(11) + (size_t)(l * 4 + g) * 4096 + d; const LAS float* tq = tb + (cs_ ? 64 : 0); float a = 0.f;
#pragma unroll 16
            for (int m = 0; m < 64; ++m) a += tq[(m * c) & 63] * wf[m * 64];
            P_WCS[i] = a * 0.125f; }
          __syncthreads(); }
    }
    SEAM(0);

#pragma unroll 1
    for (int l = 0; l < 2; ++l) {
        const int pb = 1 + l * NPH_L;
        const int RL = l == 0 ? RT : TL;

        for (int grp_ = 0; grp_ < GRP_MIX; ++grp_) {
        if (IN(pb + 0)) for (int rep_ = 0; rep_ < REP_NORM; ++rep_) {
            PHASE_BEGIN;
            const float* mods = P_MODS + (size_t)l * 3 * 6144;
            const float* xlat = INP(0); const float* xctx = INP(2);
            if (l == 0)
            for (int it = gw; it < TL / 16 + (RT - TL) / 2; it += NGW) {
                const int r0 = it < TL / 16 ? it * 16 : TL + (it - TL / 16) * 2, nr = it < TL / 16 ? 16 : 2; const int vec = r0 < SEQ ? 0 : (r0 < TL ? 1 : 2);
                const float* xi = r0 < TL ? xlat + (size_t)r0 * DM : xctx + (size_t)(r0 - TL) * DM;
                norm_rows<false, false>(xi, nullptr, INP(6) + l * DM, mods + vec * 6144 + 0, mods + vec * 6144 + DM, nr, lane, (unsigned char*)P_HQ + (size_t)r0 * DM); }
            if (l == 0) {
                for (int it = gw; it < 2 * 96 * 16; it += NGW) {
                    const int itu = __builtin_amdgcn_readfirstlane(it); const int nch = itu & 15, kb = (itu >> 4) % 96, ll = itu / (96 * 16), k0 = kb * 8, n = nch * 64 + lane;
                    const bool pool = k0 < 256; const int kk = pool ? k0 : k0 - 256, cs_ = pool ? 0 : (kk >> 8), g = (kk >> 6) & 3, c0 = kk & 63;
                    const float* wo = INP(16) + (size_t)ll * DM * DM + (size_t)((pool ? 0 : 256) + g * 64) * DM + n;
                    const float* arow = pool ? INP(9) + (size_t)(ll * 4 + g) * 4096 + c0 * 64 : P_WCS + ((size_t)((ll * 2 + cs_) * 4 + g) * 64 + c0) * 64;
                    const float* ps = INP(10) + ll * 256 + g * 64;
                    float acc[8];
#pragma unroll
                    for (int j = 0; j < 8; ++j) acc[j] = 0.f;
#pragma unroll 8
                    for (int d = 0; d < 64; ++d) { const float wv = wo[(size_t)d * DM]; const float sc_ = pool ? ps[d] : 1.0f;
#pragma unroll
                        for (int j = 0; j < 8; ++j) acc[j] += arow[j * 64 + d] * sc_ * wv; }
                    u32x2 w; w.x = pk4_fp8(acc[0] * 64.0f, acc[1] * 64.0f, acc[2] * 64.0f, acc[3] * 64.0f); w.y = pk4_fp8(acc[4] * 64.0f, acc[5] * 64.0f, acc[6] * 64.0f, acc[7] * 64.0f);
                    *(u32x2*)((unsigned char*)(P_DW(ll) + DW_WCOMB) + (size_t)perm256(n) * NINP + k0) = w;
                }
                for (int it = NGW - 1 - gw; it < 96; it += NGW) {
                    const int itu = __builtin_amdgcn_readfirstlane(it); const int kb = itu & 15, v = (itu >> 4) % 3, ll = itu / 48, k0 = kb * 64;
                    const float* wr = INP(17) + (size_t)ll * DM * NE + (size_t)k0 * NE + lane;
                    const float* mv = P_MODS + (size_t)ll * 3 * 6144 + v * 6144 + k0; const float* g2 = INP(7) + ll * DM + k0;
                    float pbs = 0.f; bf16_t* dst = (bf16_t*)(P_DW(ll) + DW_WR) + (size_t)(v * 64 + lane) * DM + k0;
#pragma unroll 1
                    for (int q = 0; q < 8; ++q) { unsigned wp[4];
#pragma unroll
                        for (int j = 0; j < 4; ++j) { const int kk = q * 8 + 2 * j; const float w0 = wr[(size_t)kk * NE], w1 = wr[(size_t)(kk + 1) * NE];
                            pbs += mv[3 * DM + kk] * w0; pbs += mv[3 * DM + kk + 1] * w1;
                            wp[j] = cvt_pk_bf16(w0 * (g2[kk] * (mv[4 * DM + kk] + 1.0f)), w1 * (g2[kk + 1] * (mv[4 * DM + kk + 1] + 1.0f))); }
                        *(u32x4*)(dst + q * 8) = (u32x4){wp[0], wp[1], wp[2], wp[3]}; }
                    P_PB[(size_t)((ll * 3 + v) * 16 + kb) * 64 + lane] = pbs;
                }
            }
        }
        if (l == 0 || GRP_MOE > 1 || REP_COMB > 1 || GRP_MIX > 1) SEAM(pb + 0);

        if (IN(pb + 1)) for (int rep_ = 0; rep_ < REP_DENSE; ++rep_) {
            PHASE_BEGIN;
            pg8::DenseSched8 S; S.init(RT, NINP, G, bx, P_HQ, DM / 2, P_DW(l) + DW_WIN, DM);
            pg8::EpiBf16 E{P_U, NINP, 0, 1.0f / 64.0f};
            pg8::gemm_phase<pg8::EpiBf16, pg8::DenseSched8, true>(lds, DM, S, E, tid);
        }
        SEAM(pb + 1);

        if (IN(pb + 2)) for (int rep_ = 0; rep_ < REP_ROWS; ++rep_) {
            PHASE_BEGIN;
            bf16_t* Ub = P_U; bf16_t* YA = P_YA;
            const int nit_ = TL / 16 + 64 + (l == 0 ? 32 : 0);
            for (int it = gw; it < nit_; it += NGW) {
                int ch = it, rb0 = 0, rb1 = 16; bool dopool = true;
                if (it >= TL / 16) { const int e_ = it - TL / 16; if (e_ < 64) { ch = TL / 16 + (e_ >> 1); rb0 = 8 * (e_ & 1); rb1 = rb0 + 8; dopool = false; } else { ch = TL / 16 + (e_ - 64); rb1 = 0; } }
                const int r0 = ch * 16; const bool isc = r0 >= TL; const int b = isc ? (r0 - TL) >> 8 : r0 >> 14; const int t0 = isc ? (r0 - TL) & (CTXL - 1) : r0 & (SEQ - 1); const int Ls = isc ? CTXL : SEQ;
                const bf16_t* useq = Ub + (size_t)(r0 - t0) * NINP;
                if ((l == 0 || !isc) && dopool) {
                    u32x2 x[32];
#pragma unroll
                    for (int j = 0; j < 32; ++j) { const int tt = t0 - 8 + j; const int tc = tt < 0 ? 0 : (tt >= Ls ? Ls - 1 : tt); x[j] = *(const u32x2*)(useq + (size_t)tc * NINP + lane * 4); if (tt < 0 || tt >= Ls) x[j] = (u32x2){(unsigned)z_, (unsigned)z_}; }
                    const int g = lane >> 4, hw = 1 << g;
                    float res[16][4];
#pragma unroll
                    for (int half = 0; half < 2; ++half) {
                        float p0[33], p1[33]; p0[0] = 0.f; p1[0] = 0.f;
#pragma unroll
                        for (int j = 0; j < 32; ++j) { const unsigned w = half ? x[j].y : x[j].x; p0[j + 1] = p0[j] + bf_lo(w); p1[j + 1] = p1[j] + bf_hi(w); }
#pragma unroll
                        for (int i = 0; i < 16; ++i) { const int c = i + 8;
                            const float a1 = p0[c + 1] - p0[c - 1], a2 = p0[c + 2] - p0[c - 2], a4 = p0[c + 4] - p0[c - 4], a8 = p0[c + 8] - p0[c - 8];
                            const float b1 = p1[c + 1] - p1[c - 1], b2 = p1[c + 2] - p1[c - 2], b4 = p1[c + 4] - p1[c - 4], b8 = p1[c + 8] - p1[c - 8];
                            res[i][2 * half] = g == 0 ? a1 : (g == 1 ? a2 : (g == 2 ? a4 : a8)); res[i][2 * half + 1] = g == 0 ? b1 : (g == 1 ? b2 : (g == 2 ? b4 : b8)); }
                    }
#pragma unroll
                    for (int i = 0; i < 16; ++i) { const int t = t0 + i; const int lo_ = (t - hw) < 0 ? 0 : t - hw, hi_ = (t + hw) > Ls ? Ls : t + hw; const float ic = 1.0f / (float)(hi_ - lo_);
                        const u32x2 me = x[i + 8];
                        *(unsigned*)((unsigned char*)YA + (size_t)(r0 + i) * NINP + lane * 4) = pk4_fp8(res[i][0] * ic - bf_lo(me.x), res[i][1] * ic - bf_hi(me.x), res[i][2] * ic - bf_lo(me.y), res[i][3] * ic - bf_hi(me.y)); }
                }
#pragma unroll 1
                for (int rb = rb0; rb < rb1; rb += 8) {
                    u32x4 qv[8], kv[8], kr[8]; const int cpc = lane & 3;
#pragma unroll
                    for (int k = 0; k < 8; ++k) { bf16_t* ur = Ub + (size_t)(r0 + rb + k) * NINP;
                        qv[k] = (u32x4){(unsigned)z_, (unsigned)z_, (unsigned)z_, (unsigned)z_}; kv[k] = qv[k];
                        if (lane < 48) qv[k] = *(const u32x4*)(ur + COL_Q + lane * 8);
                        if (lane < 32) kv[k] = *(const u32x4*)(ur + COL_KV + lane * 8);
                        kr[k] = *(const u32x4*)(ur + COL_KR + cpc * 8); }
#pragma unroll
                    for (int k = 0; k < 8; ++k) { const int row = r0 + rb + k, t = t0 + rb + k; bf16_t* ur = Ub + (size_t)row * NINP;
                        float sq = 0.f, sk = 0.f;
#pragma unroll
                        for (int j = 0; j < 4; ++j) { const float a = bf_lo(qv[k][j]), c2 = bf_hi(qv[k][j]); sq += a * a + c2 * c2; const float a2 = bf_lo(kv[k][j]), c3 = bf_hi(kv[k][j]); sk += a2 * a2 + c3 * c3; }
                        const float rq = rsqrtf(wave_sum(sq, lane) * (1.0f / 384.0f) + EPS), rk = rsqrtf(wave_sum(sk, lane) * (1.0f / 256.0f) + EPS);
                        if (lane < 48) { u32x4 w;
#pragma unroll
                            for (int j = 0; j < 4; ++j) w[j] = cvt_pk_bf16(bf_lo(qv[k][j]) * rq, bf_hi(qv[k][j]) * rq);
                            *(u32x4*)(ur + COL_Q + lane * 8) = w; }
                        if (lane < 32) { u32x4 w;
#pragma unroll
                            for (int j = 0; j < 4; ++j) w[j] = cvt_pk_bf16(bf_lo(kv[k][j]) * rk, bf_hi(kv[k][j]) * rk);
                            *(u32x4*)(ur + COL_KV + lane * 8) = w; }
                        const u32x4 mine = kr[k]; u32x4 oth;
#pragma unroll
                        for (int j = 0; j < 4; ++j) oth[j] = (unsigned)shxi((int)mine[j], 1, lane);
                        float f[8];
#pragma unroll
                        for (int j = 0; j < 4; ++j) { f[2 * j] = bf_lo(mine[j]); f[2 * j + 1] = bf_hi(mine[j]); }
                        if (!isc) { const float pos = (float)((cpc >> 1) == 0 ? (t >> 6) : (t & 63)); const bool second = cpc & 1;
#pragma unroll
                            for (int j = 0; j < 4; ++j) {
#pragma unroll
                                for (int q = 0; q < 2; ++q) { const float ang = pos * __powf(10000.0f, -(float)(2 * j + q) * 0.125f); const float sn = __sinf(ang), cs = __cosf(ang);
                                    const float m0 = q ? bf_hi(mine[j]) : bf_lo(mine[j]), o0 = q ? bf_hi(oth[j]) : bf_lo(oth[j]);
                                    f[2 * j + q] = second ? m0 * cs + o0 * sn : m0 * cs - o0 * sn; } } }
                        const int h = (lane >> 2) & 7; const int key = isc ? t : CTXL + t;
                        unsigned char* kd = P_K8 + ((size_t)(b * NH + h) * LK + key) * 128;
                        u32x2 w; w.x = pk4_fp8(f[0], f[1], f[2], f[3]); w.y = pk4_fp8(f[4], f[5], f[6], f[7]);
                        if (lane < 32) *(u32x2*)(kd + 64 + cpc * 8) = w; else *(u32x2*)(kd + 96 + cpc * 8) = (u32x2){(unsigned)z_ + (cpc == 0 ? 0x38u : 0u), (unsigned)z_}; }
                }
            }
        }
        SEAM(pb + 2);

        if (IN(pb + 3)) {
            for (int rep_ = 0; rep_ < REP_DENSE; ++rep_) { PHASE_BEGIN; pg8::DenseSched S; S.init(RL, 768, G, bx, P_U + COL_Q, NINP, P_DW(l) + DW_WUQ, 384);
              pg8::EpiBf16 E{P_HQ, 768, 0, 1.0f};
              pg8::gemm_phase<pg8::EpiBf16, pg8::DenseSched>(lds, 384, S, E, tid); }
            for (int rep_ = 0; rep_ < REP_DENSE; ++rep_) { PHASE_BEGIN; pg8::DenseSched S; S.init(RT, 1024, G, (G == 256) ? ((bx + 120) & 255) : bx, P_U + COL_KV, NINP, P_DW(l) + DW_WUKV, 256);
              if ((__builtin_amdgcn_readfirstlane(tid >> 6) & 3) >= 2) { pg8::EpiKV<true> E{P_K8, P_VT8}; pg8::gemm_phase<pg8::EpiKV<true>, pg8::DenseSched>(lds, 256, S, E, tid); }
              else { pg8::EpiKV<false> E{P_K8, P_VT8}; pg8::gemm_phase<pg8::EpiKV<false>, pg8::DenseSched>(lds, 256, S, E, tid); } }
            for (int rep_ = 0; rep_ < REP_FFT; ++rep_) { PHASE_BEGIN;
              for (int u = vcu; u < 256; u += G) { const int b = u >> 7, l2 = u & 127;
                dft::unit<0, 128>((LAS char*)lds, P_F1, (const char*)(P_U + (size_t)(b * SEQ + l2) * NINP + COL_FNO), (size_t)128 * NINP * 2, (char*)P_YP, b, l2, tid); } }
            if (l == 0) { PHASE_BEGIN;
              for (int u = vcu; u < 4; u += G) { const int b = u >> 1, zp = u & 1;
                dft::unit<2, 256>((LAS char*)lds, P_FC + (size_t)zp * 256 * 256, (const char*)(P_U + (size_t)(TL + b * CTXL) * NINP + COL_FNO), (size_t)NINP * 2, (char*)P_YA, b, zp, tid); } }
        }
        SEAM(pb + 3);


        if (IN(pb + 5)) {
            for (int rep_ = 0; rep_ < REP_FFT; ++rep_) { PHASE_BEGIN;
              for (int u = vcu; u < 256; u += G) { const int b = u >> 7, k1 = u & 127;
                dft::unit<1, 256>((LAS char*)lds, P_F2, (const char*)(P_YP + (size_t)(b * 128 + k1) * 256 * 256), (size_t)512, (char*)P_YA, b, k1, tid); } }
            if (l == 0) { PHASE_BEGIN;
              for (int u = vcu; u < 16; u += G) { const int b = u >> 3, h = u & 7;
                att8::attn_unit(P_HQ + (size_t)(TL + b * CTXL) * 768 + h * DQK, P_K8 + (size_t)(b * NH + h) * LK * 128, P_VT8 + (size_t)(b * NH + h) * 260 * 4096,
                                (bf16_t*)((unsigned char*)P_YA + (size_t)(TL + b * CTXL) * NINP + 768 + h * DV), NINP, CTXL / 64, false, 0, CTXL, (LAS char*)lds, tid); } }
            for (int rep_ = 0; rep_ < REP_ATT; ++rep_) { PHASE_BEGIN;
              for (int u = vcu; u < 512; u += G) { const int bh = u >> 5, qb = u & 31, b = bh >> 3, h = bh & 7; int tidu = tid; asm volatile("" : "+v"(tidu));
#if ATT_VAR
                if (rep_ + 1 < REP_ATT) att8::attn_unit_p<ATT_VAR>(P_HQ + (size_t)(b * SEQ + qb * 512) * 768 + h * DQK, P_K8 + (size_t)bh * LK * 128, P_VT8 + (size_t)bh * 260 * 4096,
                                (bf16_t*)((unsigned char*)P_YA + (size_t)(b * SEQ + qb * 512) * NINP + 768 + h * DV), NINP, LK / 64, true, qb * 512, 512, (LAS char*)lds, tidu); else
#endif
                att8::attn_unit_p<0>(P_HQ + (size_t)(b * SEQ + qb * 512) * 768 + h * DQK, P_K8 + (size_t)bh * LK * 128, P_VT8 + (size_t)bh * 260 * 4096,
                                (bf16_t*)((unsigned char*)P_YA + (size_t)(b * SEQ + qb * 512) * NINP + 768 + h * DV), NINP, LK / 64, true, qb * 512, 512, (LAS char*)lds, tidu); } }
        }
        SEAM(pb + 5);
        }

        if (IN(pb + 6)) for (int rep_ = 0; rep_ < REP_OUT; ++rep_) {
            PHASE_BEGIN;
#if SELFCHECK
            if (gw < 64) selfcheck_attn(l, P_HQ, P_K8, P_VB, P_VT8, P_YA, P_U, (const bf16_t*)(P_DW(l) + DW_WUQ), (const bf16_t*)(P_DW(l) + DW_WUKV), (unsigned*)(wsp + WS_CTL) + CW_CHK, (LAS float*)(ldsp + wave * 1024), gw, lane);
            __syncthreads();
#endif
            const float* xlat = INP(0); const float* xctx = INP(2); const bf16_t* xsin = (l == 0 && rep_ == 0) ? nullptr : P_XS;
            pg8::DenseSched8 S; S.init(RL, DM, G, bx, P_YA, NINP / 2, P_DW(l) + DW_WCOMB, NINP);
            pg8::EpiResid E{xlat, xctx, xsin, P_XS, P_MODS + (size_t)l * 3 * 6144, (REP_OUT > 1 && rep_ > 0) ? 0.f : 1.0f / 64.0f};
            pg8::gemm_phase<pg8::EpiResid, pg8::DenseSched8, true>(lds, NINP, S, E, tid);
            if (CV_ON && bx >= 8 && rep_ == 0) { LAS float* scr = (LAS float*)(lds + wave * 16384);
                CONVERT_ITEMS((bx - 8) * 8 + wave, 248 * 8, CV_A); }
        }
        SEAM(pb + 6);

        for (int grp2_ = 0; grp2_ < GRP_MOE; ++grp2_) {
        if (IN(pb + 7)) for (int rep_ = 0; rep_ < REP_NORM * REP_P7; ++rep_) {
            PHASE_BEGIN;
            if (rep_ == 0) {
                pg8::RouterSched S; S.init(RL, 256, G, bx, P_XS, DM, P_DW(l) + DW_WR, DM);
                pg8::EpiLogits E{P_LOG};
                pg8::gemm_phase<pg8::EpiLogits, pg8::RouterSched>(lds, DM, S, E, tid);
            }
            const float* mods = P_MODS + (size_t)l * 3 * 6144;
            for (int it = gw; it < TL / 16 + (RL - TL) / 2; it += NGW) {
                const int r0 = it < TL / 16 ? it * 16 : TL + (it - TL / 16) * 2, nr = it < TL / 16 ? 16 : 2; const int vec = r0 < SEQ ? 0 : (r0 < TL ? 1 : 2);
                norm_rows<true, false>(P_XS + (size_t)r0 * DM, nullptr, INP(7) + l * DM, mods + vec * 6144 + 3 * DM, mods + vec * 6144 + 4 * DM, nr, lane, P_H2F8 + (size_t)r0 * DM, P_RSTD + r0); }
            LAS float* scr = (LAS float*)(lds + wave * 16384);
            CONVERT_ITEMS(CV_A + gw, NGW, CV_B);
            if (CV_ON && bx >= 130 && rep_ == 0) { CONVERT_ITEMS(CV_B + (bx - 130) * 8 + wave, 126 * 8, CV_NIT); }
        }
        SEAM(pb + 7);

        if (IN(pb + 9)) for (int rep_ = 0; rep_ < REP_ROUTE; ++rep_) {
            PHASE_BEGIN;
            LAS int* lcnt = (LAS int*)lds; LAS int* lbase = lcnt + 64; LAS int* rec = lbase + 64;
            if (tid < 64) lcnt[tid] = 0;
            __syncthreads();
            const int per = (RL + G - 1) / G; const int t0 = vcu * per; const int t1 = (t0 + per) < RL ? (t0 + per) : RL;
            const float bias = INP(18)[l * NE + lane]; const float* LOGITS = P_LOG; const float* RSTD = P_RSTD;
            LAS float* b2s = (LAS float*)(ldsp + 32768);
            if (tid < 192) { const float* pb = P_PB + (size_t)((l * 3 + (tid >> 6)) * 16) * 64 + lane; float a = 0.f;
#pragma unroll
                for (int kb = 0; kb < 16; ++kb) a += pb[kb * 64];
                b2s[tid] = a; }
            __syncthreads();
            for (int t = t0 + wave; t < t1; t += 8) {
                const float lg = LOGITS[(size_t)t * NE + lane] * RSTD[t] + b2s[(t < SEQ ? 0 : (t < TL ? 64 : 128)) + lane]; const float s = 1.0f / (1.0f + __expf(-lg)); const float sel = s + bias;
                float v1 = sel; int i1 = lane;
#pragma unroll
                for (int off = 1; off < 8; off <<= 1) { const float ov = shx(v1, off, lane); const int oi = shxi(i1, off, lane); if (ov > v1 || (ov == v1 && oi < i1)) { v1 = ov; i1 = oi; } }
                float v2 = (lane == i1) ? -INFINITY : sel;
#pragma unroll
                for (int off = 1; off < 8; off <<= 1) v2 = fmaxf(v2, shx(v2, off, lane));
                const float gs = v1 + v2; const int g = lane >> 3; int grank = 0;
#pragma unroll
                for (int gg = 0; gg < 8; ++gg) { const float og = __uint_as_float(__builtin_amdgcn_readlane(__float_as_uint(gs), gg * 8)); grank += (og > gs || (og == gs && gg < g)) ? 1 : 0; }
                const bool gsel = grank < 4; const float msel = gsel ? sel : -INFINITY; int rank = 0;
                unsigned long long gm = __ballot(gsel && (lane & 7) == 0);
#pragma unroll 1
                for (int gi = 0; gi < 4; ++gi) { const int gb = __builtin_amdgcn_readfirstlane((int)__builtin_ctzll(gm | (1ull << 63))); gm &= gm - 1ull;
#pragma unroll
                    for (int j = 0; j < 8; ++j) { const int e2 = gb + j; const float ov = __uint_as_float(__builtin_amdgcn_readlane(__float_as_uint(msel), e2)); rank += (ov > msel || (ov == msel && e2 < lane)) ? 1 : 0; } }
                const bool chosen = gsel && rank < 8;
                const float ssum = wave_sum(chosen ? s : 0.f, lane);
                if (chosen) { const int lp = __hip_atomic_fetch_add(lcnt + lane, 1, __ATOMIC_RELAXED, __HIP_MEMORY_SCOPE_WORKGROUP); LAS int* rr = rec + ((t - t0) * 8 + rank) * 3; rr[0] = lane; rr[1] = lp; rr[2] = (int)__float_as_uint(s / ssum * 2.5f); }
            }
            __syncthreads();
            if (tid < 64) lbase[tid] = (int)__hip_atomic_fetch_add(P_GCNT(l) + 256 * rep_ + 512 * grp2_ + tid, (unsigned)lcnt[tid], __ATOMIC_RELAXED, __HIP_MEMORY_SCOPE_AGENT);
            __syncthreads();
            int* TOKL = P_TOKL; int* TPOS = P_TPOS; float* TW = P_TW;
            if (REP_ROUTE > 1 && rep_ > 0) { TOKL = (int*)(wsp + WS_YB + 70 * MiB); TPOS = (int*)(wsp + WS_YB + 80 * MiB); TW = (float*)(wsp + WS_YB + 82 * MiB); }
            for (int i = tid; i < (t1 - t0) * 8; i += 512) { const LAS int* rr = rec + i * 3; const int e = rr[0], pos = lbase[e] + rr[1], t = t0 + (i >> 3);
                TOKL[(size_t)e * RT + pos] = t; TPOS[(size_t)t * 8 + (i & 7)] = (e << 20) | pos; TW[(size_t)t * 8 + (i & 7)] = __uint_as_float((unsigned)rr[2]); }
            __syncthreads();
        }
        SEAM(pb + 9);

#define tstart ((LAS int*)(ldsp + TAB_OFF))
#define ecnt ((LAS int*)(ldsp + TAB_OFF + 288))
#define ulist ((LAS int*)(ldsp + ULIST_OFF))
#define uidx ((LAS int*)(ldsp + IDX_OFF))
        const bool need_tab = (hi > pb + 10) && (lo <= pb + 14);
        if (need_tab) {
            PHASE_BEGIN;
            if (tid < 64) {
                const int c = (int)__hip_atomic_load(P_GCNT(l) + 512 * grp2_ + tid, __ATOMIC_RELAXED, __HIP_MEMORY_SCOPE_AGENT); const int nt_ = (c + 255) >> 8; int inc = nt_;
#pragma unroll
                for (int o = 1; o < 64; o <<= 1) { const int v = __builtin_amdgcn_ds_bpermute(((lane - o) & 63) << 2, inc); if (lane >= o) inc += v; }
                ecnt[tid] = c; tstart[tid] = inc - nt_;
                if (tid == 63) { ecnt[NE] = RL; tstart[NE] = inc; tstart[NEX] = inc + RL / 256; } }
            __syncthreads();
        }
        int ntile = 0; if (need_tab) { PHASE_BEGIN; ntile = tstart[NEX]; }

        if (IN(pb + 10)) for (int rep_ = 0; rep_ < REP_MOE; ++rep_) {
            PHASE_BEGIN;
            const int nunits = ntile * 2; int nu = 0;
            for (int i = 0; ; ++i) { const int u = i * G + vcu; if (u >= nunits || i >= MAXU) break; nu = i + 1; }
            if (tid < nu) { const int u = tid * G + vcu, tile = u >> 1; int e = 0;
_Pragma("unroll 13")
                for (int q = 0; q < NEX; ++q) if (tstart[q] <= tile) e = q;
                ulist[tid * 4 + 0] = e; ulist[tid * 4 + 1] = tile; ulist[tid * 4 + 2] = u & 1; ulist[tid * 4 + 3] = tile - tstart[e]; }
            __syncthreads();
            const int* TOKL = P_TOKL;
            for (int i = 0; i < nu; ++i) { const int e = ulist[i * 4 + 0], rt = ulist[i * 4 + 3], cnt = ecnt[e];
                if (tid < 256) { const int pos = rt * 256 + tid; const int pc = pos < cnt ? pos : cnt - 1; uidx[i * 256 + tid] = e < NE ? TOKL[(size_t)e * RT + pc] : pc; } }
            __syncthreads();
            pg8::MoeSched S{ulist, uidx, nu, (const char*)P_H2F8, (const char*)P_EWGU8, 0, 0};
            pg8::EpiSwiGLU E{P_ACT, 1.0f / 32.0f};
            pg8::gemm_phase<pg8::EpiSwiGLU, pg8::MoeSched, true>(lds, DM, S, E, tid);
        }
        SEAM(pb + 10);

#pragma unroll 1
        for (int qd = 0; qd < 2; ++qd) {
            if (IN(pb + 11 + 2 * qd)) for (int rep_ = 0; rep_ < REP_MOE * REP_DOWN; ++rep_) {
                PHASE_BEGIN;
                const int nunits = ntile * 2; int nu = 0;
                for (int i = 0; ; ++i) { const int u = i * G + vcu; if (u >= nunits || i >= MAXU) break; nu = i + 1; }
                __syncthreads();
                if (tid < nu) { const int u = tid * G + vcu, tile = u >> 1; int e = 0;
_Pragma("unroll 13")
                    for (int q = 0; q < NEX; ++q) if (tstart[q] <= tile) e = q;
                    ulist[tid * 4 + 0] = e; ulist[tid * 4 + 1] = tile; ulist[tid * 4 + 2] = u & 1; ulist[tid * 4 + 3] = tile - tstart[e]; }
                __syncthreads();
                pg8::MoeSched S{ulist, uidx, nu, (const char*)P_ACT, (const char*)P_EWD, 1, qd};
                pg8::EpiFp8 E{(unsigned char*)P_YB, 512, 1.0f / 16.0f};
                pg8::gemm_phase<pg8::EpiFp8, pg8::MoeSched, true>(lds, DE, S, E, tid);
            }
            SEAM(pb + 11 + 2 * qd);
            if (IN(pb + 12 + 2 * qd)) for (int rep_ = 0; rep_ < REP_COMB; ++rep_) {
                PHASE_BEGIN;
                const float* mods = P_MODS + (size_t)l * 3 * 6144; const int* TPOS = P_TPOS; const float* TW = P_TW; const unsigned char* YB8 = (const unsigned char*)P_YB; bf16_t* XS = P_XS;
                const bool fuse = (qd == 1) && (GRP_MOE == 1 || grp2_ + 1 == GRP_MOE) && (REP_COMB == 1);
                for (int it = gw; it < TL / 8 + (RL - TL) / 2; it += NGW) {
                    const int tb = it < TL / 8 ? it * 8 : TL + (it - TL / 8) * 2, ntk = it < TL / 8 ? 8 : 2; const int vec = tb < SEQ ? 0 : (tb < TL ? 1 : 2);
                    const float* gp = mods + vec * 6144 + 5 * DM + qd * 512 + lane * 8; f32x4 g0 = *(const f32x4*)gp, g1 = *(const f32x4*)(gp + 4);
                    if ((REP_COMB > 1 && rep_ > 0) || (GRP_MOE > 1 && grp2_ + 1 < GRP_MOE)) { g0 = g0 * 0.f; g1 = g1 * 0.f; }
                    f32x4 nm[4], ns[4];
                    { const float zf_ = (float)z_;
#pragma unroll
                      for (int q = 0; q < 4; ++q) { nm[q] = (f32x4){zf_, zf_, zf_, zf_}; ns[q] = nm[q]; } }
                    if (fuse) {
                        if (l == 0) { const float* m1 = P_MODS + (size_t)3 * 6144 + vec * 6144; const float* gmx = INP(6) + DM;
#pragma unroll
                            for (int q = 0; q < 4; ++q) { const int col = (q >> 1) * 512 + lane * 8 + (q & 1) * 4; const f32x4 gv = *(const f32x4*)(gmx + col), s1 = *(const f32x4*)(m1 + DM + col); nm[q] = gv * (s1 + 1.0f); ns[q] = *(const f32x4*)(m1 + col); } }
                        else { const float* gf = INP(25);
#pragma unroll
                            for (int q = 0; q < 4; ++q) { const int col = (q >> 1) * 512 + lane * 8 + (q & 1) * 4; nm[q] = *(const f32x4*)(gf + col); ns[q] = nm[q] * 0.f; } }
                    }
#pragma unroll 2
                    for (int t = tb; t < tb + ntk; ++t) {
                        int tp = 0; float tw = 0.f; if (lane < 8) { tp = TPOS[(size_t)t * 8 + lane]; tw = TW[(size_t)t * 8 + lane]; }
                        u32x2 v[9];
#pragma unroll
                        for (int k = 0; k < 8; ++k) { const int tpk = __builtin_amdgcn_readlane(tp, k); const int slot = tstart[tpk >> 20] * 256 + (tpk & 0xfffff); v[k] = __builtin_nontemporal_load((const u32x2*)(YB8 + (size_t)slot * 512 + lane * 8)); }
                        v[8] = __builtin_nontemporal_load((const u32x2*)(YB8 + (size_t)(tstart[NE] * 256 + t) * 512 + lane * 8));
                        u32x4* xp = (u32x4*)(XS + (size_t)t * DM + qd * 512 + lane * 8); const u32x4 xw = *xp;
                        f32x4 x0 = {bf_lo(xw.x), bf_hi(xw.x), bf_lo(xw.y), bf_hi(xw.y)}, x1 = {bf_lo(xw.z), bf_hi(xw.z), bf_lo(xw.w), bf_hi(xw.w)};
                        f32x4 y0 = x0, y1 = x1; if (fuse) { const u32x4 yw = *(const u32x4*)(XS + (size_t)t * DM + lane * 8); y0 = (f32x4){bf_lo(yw.x), bf_hi(yw.x), bf_lo(yw.y), bf_hi(yw.y)}; y1 = (f32x4){bf_lo(yw.z), bf_hi(yw.z), bf_lo(yw.w), bf_hi(yw.w)}; }
                        float a[8];
#pragma unroll
                        for (int j = 0; j < 8; ++j) a[j] = 0.f;
#pragma unroll
                        for (int k = 0; k < 9; ++k) { const float w = k < 8 ? __uint_as_float(__builtin_amdgcn_readlane(__float_as_uint(tw), k < 8 ? k : 0)) : 1.0f;
                            a[0] += w * __builtin_amdgcn_cvt_f32_fp8((int)v[k].x, 0); a[1] += w * __builtin_amdgcn_cvt_f32_fp8((int)v[k].x, 1); a[2] += w * __builtin_amdgcn_cvt_f32_fp8((int)v[k].x, 2); a[3] += w * __builtin_amdgcn_cvt_f32_fp8((int)v[k].x, 3);
                            a[4] += w * __builtin_amdgcn_cvt_f32_fp8((int)v[k].y, 0); a[5] += w * __builtin_amdgcn_cvt_f32_fp8((int)v[k].y, 1); a[6] += w * __builtin_amdgcn_cvt_f32_fp8((int)v[k].y, 2); a[7] += w * __builtin_amdgcn_cvt_f32_fp8((int)v[k].y, 3); }
                        x0.x += g0.x * a[0]; x0.y += g0.y * a[1]; x0.z += g0.z * a[2]; x0.w += g0.w * a[3]; x1.x += g1.x * a[4]; x1.y += g1.y * a[5]; x1.z += g1.z * a[6]; x1.w += g1.w * a[7];
                        if (!(fuse && l == 1)) { u32x4 ow; ow.x = cvt_pk_bf16(x0.x, x0.y); ow.y = cvt_pk_bf16(x0.z, x0.w); ow.z = cvt_pk_bf16(x1.x, x1.y); ow.w = cvt_pk_bf16(x1.z, x1.w); *xp = ow; }
                        if (fuse) {
                            float s = (x0.x * x0.x + x0.y * x0.y) + (x0.z * x0.z + x0.w * x0.w) + (x1.x * x1.x + x1.y * x1.y) + (x1.z * x1.z + x1.w * x1.w)
                                    + (y0.x * y0.x + y0.y * y0.y) + (y0.z * y0.z + y0.w * y0.w) + (y1.x * y1.x + y1.y * y1.y) + (y1.z * y1.z + y1.w * y1.w);
                            const float rstd = rsqrtf(wave_sum(s, lane) * (1.0f / DM) + EPS);
                            const f32x4 o0 = y0 * rstd * nm[0] + ns[0], o1 = y1 * rstd * nm[1] + ns[1], o2 = x0 * rstd * nm[2] + ns[2], o3 = x1 * rstd * nm[3] + ns[3];
                            if (l == 1) { f32x4* op = (f32x4*)(P.out + (size_t)t * DM + lane * 8); __builtin_nontemporal_store(o0, op); __builtin_nontemporal_store(o1, op + 1); __builtin_nontemporal_store(o2, op + 128); __builtin_nontemporal_store(o3, op + 129); }
                            else { u32x2 w0, w1; w0.x = pk4_fp8(o0.x, o0.y, o0.z, o0.w); w0.y = pk4_fp8(o1.x, o1.y, o1.z, o1.w); w1.x = pk4_fp8(o2.x, o2.y, o2.z, o2.w); w1.y = pk4_fp8(o3.x, o3.y, o3.z, o3.w);
                                unsigned char* hp = (unsigned char*)P_HQ + (size_t)t * DM + lane * 8; *(u32x2*)hp = w0; *(u32x2*)(hp + 512) = w1; }
                        }
                    }
                }
            }
            if (!(l == 1 && qd == 1) || SELFCHECK || REP_COMB > 1 || GRP_MOE > 1) SEAM(pb + 12 + 2 * qd);
        }
        }
    }

    if (IN(NPHASE - 1)) for (int rep_ = 0; rep_ < REP_PRO; ++rep_) {
        PHASE_BEGIN;
#if SELFCHECK
        const unsigned chk_code = __hip_atomic_load((unsigned*)(wsp + WS_CTL) + CW_CHK, __ATOMIC_RELAXED, __HIP_MEMORY_SCOPE_AGENT);
#endif
        const float* gf = INP(25); f32x4 gm[4]; const bf16_t* XS = P_XS;
#pragma unroll
        for (int j = 0; j < 4; ++j) gm[j] = *(const f32x4*)(gf + 4 * lane + 256 * j);
        for (int r = gw; r < ((REP_COMB > 1) ? TL : (SELFCHECK ? 1 : 0)); r += NGW) {
            const u32x2* xr = (const u32x2*)(XS + (size_t)r * DM) + lane; f32x4 v[4]; float s = 0.f;
#pragma unroll
            for (int j = 0; j < 4; ++j) { const u32x2 a = xr[64 * j]; v[j] = (f32x4){bf_lo(a.x), bf_hi(a.x), bf_lo(a.y), bf_hi(a.y)}; s += (v[j].x * v[j].x + v[j].y * v[j].y) + (v[j].z * v[j].z + v[j].w * v[j].w); }
            const float rstd = rsqrtf(wave_sum(s, lane) * (1.0f / DM) + EPS);
            f32x4* o = (f32x4*)(P.out + (size_t)r * DM) + lane;
#pragma unroll
            for (int j = 0; j < 4; ++j) if (!SELFCHECK) o[64 * j] = v[j] * rstd * gm[j];
#if SELFCHECK
            if (r == 0 && lane == 0) { const unsigned w1 = __hip_atomic_load((unsigned*)(wsp + WS_CTL) + CW_CHK + 1 + SELFCHECK_REPORT, __ATOMIC_RELAXED, __HIP_MEMORY_SCOPE_AGENT); P.out[0] = (float)w1; (void)chk_code; }
#endif
        }
    }
#undef IN
#undef SEAM
#undef tstart
#undef ecnt
#undef ulist
#undef uidx
}

extern "C" void kernel_launch(void* const* d_in, const int* in_sizes, int n_in, void* d_out, int out_size, void* d_ws, size_t ws_size, hipStream_t stream) {
    static int grid = 0;
    if (grid == 0) {
        if (n_in != 26 || out_size != TL * DM || ws_size < WS_END) { fprintf(stderr, "kernel_launch: unexpected problem: n_in %d out %d ws %zu (need %zu)\n", n_in, out_size, ws_size, (size_t)WS_END); grid = -1; return; }
        int dev = 0, cus = 0, per_cu = 0;
        if (hipGetDevice(&dev) != hipSuccess || hipDeviceGetAttribute(&cus, hipDeviceAttributeMultiprocessorCount, dev) != hipSuccess) { grid = -1; return; }
        if (hipFuncSetAttribute((const void*)mk_fwd, hipFuncAttributeMaxDynamicSharedMemorySize, LDS_BYTES) != hipSuccess) { fprintf(stderr, "kernel_launch: hipFuncSetAttribute failed\n"); grid = -1; return; }
        if (hipOccupancyMaxActiveBlocksPerMultiprocessor(&per_cu, (const void*)mk_fwd, 512, LDS_BYTES) != hipSuccess || per_cu < 1) { fprintf(stderr, "kernel_launch: occupancy query says %d\n", per_cu); (void)hipGetLastError(); }
        grid = cus;
    }
    if (grid < 0) return;
    (void)hipMemsetAsync((char*)d_ws + WS_CTL, 0, CTL_ZERO_BYTES, stream);
    Params p{};
    for (int i = 0; i < 26; ++i) p.in[i] = (const float*)d_in[i];
    p.out = (float*)d_out; p.ws = (unsigned char*)d_ws; p.pad = 0;
#if MK_N_LAUNCHES == 1
    p.ph_lo = 0; p.ph_hi = NPHASE; p.use_bar = 1;
    hipLaunchKernelGGL(mk_fwd, dim3(grid), dim3(512), LDS_BYTES, stream, p);
#else
    for (int ph = 0; ph < NPHASE; ++ph) { p.ph_lo = ph; p.ph_hi = ph + 1; p.use_bar = 0; hipLaunchKernelGGL(mk_fwd, dim3(grid), dim3(512), LDS_BYTES, stream, p); }
#endif
}
```
